# Optimizing an MI355X kernel written in HIP

```python
import math
import jax, jax.numpy as jnp
from jax import lax
import numpy as np

D_MODEL = 1024
BATCH = 16
SEQ = 4096
DEPTH = 2
DEC_BATCH = 8
DEC_SEQ = 64
PAST_LEN = 1024

CHUNK = 64
N_MIXERS = 2
N_SSD_LAYERS = (DEPTH + 1) // 2
N_ATTN_LAYERS = DEPTH // 2
NORM_EPS = 1e-6

SSD_EXPAND = 2
D_INNER = SSD_EXPAND * D_MODEL
SSD_HEAD_DIM = 64
SSD_HEADS = D_INNER // SSD_HEAD_DIM
SSD_GROUPS = 4
SSD_HPG = SSD_HEADS // SSD_GROUPS
D_STATE = 128
CONV_W = 4
CONV_DIM = D_INNER + 2 * SSD_GROUPS * D_STATE
SSD_IN_DIM = D_INNER + CONV_DIM + SSD_HEADS

ATT_HEADS = 8
ATT_HEAD_DIM = D_MODEL // ATT_HEADS // 2
ATT_QK_DIM = ATT_HEADS * 2 * ATT_HEAD_DIM
ATT_V_DIM = ATT_HEADS * 2 * ATT_HEAD_DIM
ATT_QKV_DIM = 2 * ATT_QK_DIM + ATT_V_DIM
ROPE_THETA = 10000.0
Q_BLOCK = 128

D_FF = ((-(-8 * D_MODEL // 3)) + 255) // 256 * 256

kernel_name = "hybrid_ssd_diffattn_streaming_step"


def rmsnorm(x, w):
    xf = x.astype(jnp.float32)
    y = xf * lax.rsqrt(jnp.mean(xf * xf, axis=-1, keepdims=True) + NORM_EPS)
    return (y * w.astype(jnp.float32)).astype(x.dtype)


def swiglu(x, w_gate, w_up, w_down):
    return (jax.nn.silu(x @ w_gate) * (x @ w_up)) @ w_down


def rope(x, pos):
    d = x.shape[-1]
    half = d // 2
    inv = 1.0 / (ROPE_THETA ** (jnp.arange(half, dtype=jnp.float32) / half))
    ang = pos.astype(jnp.float32)[:, None] * inv[None, :]
    cos = jnp.cos(ang)[None, :, None, None, :]
    sin = jnp.sin(ang)[None, :, None, None, :]
    xf = x.astype(jnp.float32)
    x1, x2 = xf[..., :half], xf[..., half:]
    return jnp.concatenate([x1 * cos - x2 * sin, x2 * cos + x1 * sin], axis=-1).astype(x.dtype)


def causal_conv(xbc, hist, w, b):
    L = xbc.shape[1]
    xp = jnp.concatenate([hist.astype(xbc.dtype), xbc], axis=1)
    y = b + xp[:, 0:L] * w[0]
    for tap in range(1, CONV_W):
        y = y + xp[:, tap:tap + L] * w[tap]
    return jax.nn.silu(y), xp[:, -(CONV_W - 1):]


def ssd_scan(x, dt, A, Bm, Cm, h0):
    b, L = x.shape[0], x.shape[1]
    q = min(CHUNK, L)
    nc = L // q

    def to_chunks(t):
        return jnp.moveaxis(t.reshape((b, nc, q) + t.shape[2:]), 1, 0)

    mask = jnp.tril(jnp.ones((q, q), dtype=bool))[None, :, :, None, None]

    def step(h, inp):
        xc, dtc, bc, cc = inp
        xc = xc.astype(jnp.float32)
        bc = bc.astype(jnp.float32)
        cc = cc.astype(jnp.float32)
        acum = jnp.cumsum(dtc * A, axis=1)
        seg = acum[:, :, None] - acum[:, None, :]
        lmat = jnp.exp(jnp.where(mask, seg, -jnp.inf))
        dx = dtc[..., None] * xc
        cb = jnp.einsum('bign,bjgn->bgij', cc, bc)
        y_diag = jnp.einsum('bgij,bijgr,bjgrp->bigrp', cb, lmat, dx)
        y_off = jnp.einsum('bign,bgrpn->bigrp', cc, h) * jnp.exp(acum)[..., None]
        wdec = jnp.exp(acum[:, -1:] - acum)[..., None] * dx
        h_new = h * jnp.exp(acum[:, -1])[..., None, None] + jnp.einsum('bjgn,bjgrp->bgrpn', bc, wdec)
        return h_new, y_diag + y_off

    hT, ys = lax.scan(step, h0, (to_chunks(x), to_chunks(dt), to_chunks(Bm), to_chunks(Cm)))
    y = jnp.moveaxis(ys, 0, 1).reshape(x.shape)
    return y, hT


def ssd_mixer(xn, conv_hist, h0, in_proj, conv_w, conv_b, dt_bias, a_log, d_skip, norm_w, out_proj):
    b, L, _ = xn.shape
    zxbcdt = xn @ in_proj
    z = zxbcdt[..., :D_INNER]
    xbc = zxbcdt[..., D_INNER:D_INNER + CONV_DIM]
    dt = zxbcdt[..., D_INNER + CONV_DIM:]
    xbc, new_hist = causal_conv(xbc, conv_hist, conv_w, conv_b)
    xs = xbc[..., :D_INNER].reshape(b, L, SSD_GROUPS, SSD_HPG, SSD_HEAD_DIM)
    Bm = xbc[..., D_INNER:D_INNER + SSD_GROUPS * D_STATE].reshape(b, L, SSD_GROUPS, D_STATE)
    Cm = xbc[..., D_INNER + SSD_GROUPS * D_STATE:].reshape(b, L, SSD_GROUPS, D_STATE)
    dt = jax.nn.softplus(dt.astype(jnp.float32) + dt_bias.astype(jnp.float32)).reshape(b, L, SSD_GROUPS, SSD_HPG)
    A = -jnp.exp(a_log.astype(jnp.float32)).reshape(SSD_GROUPS, SSD_HPG)
    y, hT = ssd_scan(xs, dt, A, Bm, Cm, h0)
    y = y + d_skip.astype(jnp.float32).reshape(SSD_GROUPS, SSD_HPG)[..., None] * xs.astype(jnp.float32)
    y = y.reshape(b, L, D_INNER) * jax.nn.silu(z.astype(jnp.float32))
    y = rmsnorm(y, norm_w).astype(xn.dtype)
    return y @ out_proj, new_hist, hT


def diff_qkv(xn, pos, w_qkv):
    b, L, _ = xn.shape
    qkv = xn @ w_qkv
    q = rope(qkv[..., :ATT_QK_DIM].reshape(b, L, ATT_HEADS, 2, ATT_HEAD_DIM), pos)
    k = rope(qkv[..., ATT_QK_DIM:2 * ATT_QK_DIM].reshape(b, L, ATT_HEADS, 2, ATT_HEAD_DIM), pos)
    v = qkv[..., 2 * ATT_QK_DIM:].reshape(b, L, ATT_HEADS, 2 * ATT_HEAD_DIM)
    return q, k, v


def diff_core(q, k, v, q_pos, k_pos, lam):
    scale = ATT_HEAD_DIM ** -0.5
    s = jnp.einsum('bqhcd,bkhcd->bhcqk', q, k).astype(jnp.float32) * scale
    mask = (k_pos[None, :] // CHUNK) <= (q_pos[:, None] // CHUNK)
    s = jnp.where(mask, s, -jnp.inf)
    p = jax.nn.softmax(s, axis=-1)
    a = p[:, :, 0] - lam * p[:, :, 1]
    return jnp.einsum('bhqk,bkhe->bqhe', a, v.astype(jnp.float32))


def diff_out(o, subln_w, lambda_init, w_o, dtype):
    b, L = o.shape[0], o.shape[1]
    o = rmsnorm(o, subln_w) * (1.0 - lambda_init)
    return o.reshape(b, L, ATT_V_DIM).astype(dtype) @ w_o


def setup_inputs(seed: int = 0) -> dict:
    key = jax.random.key(seed)
    ks = jax.random.split(key, 32)
    f32 = jnp.float32
    nrm = lambda k, shape, s: jax.random.normal(k, shape, f32) * s
    dt0 = jnp.exp(jax.random.uniform(ks[10], (N_SSD_LAYERS, SSD_HEADS), f32, math.log(1e-3), math.log(1e-1)))
    return {
        "x_prompt": nrm(ks[0], (BATCH, SEQ, D_MODEL), 1.0),
        "x_sample": nrm(ks[1], (DEC_BATCH, DEC_SEQ, D_MODEL), 1.0),
        "state_conv": nrm(ks[2], (N_SSD_LAYERS, DEC_BATCH, CONV_W - 1, CONV_DIM), 1.0),
        "state_ssm": nrm(ks[3], (N_SSD_LAYERS, DEC_BATCH, SSD_HEADS, SSD_HEAD_DIM, D_STATE), 0.5),
        "cache_k": nrm(ks[4], (N_ATTN_LAYERS, DEC_BATCH, PAST_LEN, ATT_HEADS, 2, ATT_HEAD_DIM), 1.0),
        "cache_v": nrm(ks[5], (N_ATTN_LAYERS, DEC_BATCH, PAST_LEN, ATT_HEADS, 2 * ATT_HEAD_DIM), 1.0),
        "norm_mix": 1.0 + nrm(ks[6], (DEPTH, D_MODEL), 0.02),
        "norm_ffn": 1.0 + nrm(ks[7], (DEPTH, D_MODEL), 0.02),
        "norm_final": 1.0 + nrm(ks[8], (D_MODEL,), 0.02),
        "ssd_in_proj": nrm(ks[9], (N_SSD_LAYERS, D_MODEL, SSD_IN_DIM), D_MODEL ** -0.5),
        "ssd_conv_w": nrm(ks[11], (N_SSD_LAYERS, CONV_W, CONV_DIM), CONV_W ** -0.5),
        "ssd_conv_b": nrm(ks[12], (N_SSD_LAYERS, CONV_DIM), 0.02),
        "ssd_dt_bias": dt0 + jnp.log(-jnp.expm1(-dt0)),
        "ssd_a_log": jnp.log(jax.random.uniform(ks[13], (N_SSD_LAYERS, SSD_HEADS), f32, 1.0, 16.0)),
        "ssd_d": 1.0 + nrm(ks[14], (N_SSD_LAYERS, SSD_HEADS), 0.02),
        "ssd_norm": 1.0 + nrm(ks[15], (N_SSD_LAYERS, D_INNER), 0.02),
        "ssd_out_proj": nrm(ks[16], (N_SSD_LAYERS, D_INNER, D_MODEL), D_INNER ** -0.5),
        "attn_qkv": nrm(ks[17], (N_ATTN_LAYERS, D_MODEL, ATT_QKV_DIM), D_MODEL ** -0.5),
        "attn_lambda_q1": nrm(ks[18], (N_ATTN_LAYERS, ATT_HEAD_DIM), 0.1),
        "attn_lambda_k1": nrm(ks[19], (N_ATTN_LAYERS, ATT_HEAD_DIM), 0.1),
        "attn_lambda_q2": nrm(ks[20], (N_ATTN_LAYERS, ATT_HEAD_DIM), 0.1),
        "attn_lambda_k2": nrm(ks[21], (N_ATTN_LAYERS, ATT_HEAD_DIM), 0.1),
        "attn_subln": 1.0 + nrm(ks[22], (N_ATTN_LAYERS, 2 * ATT_HEAD_DIM), 0.02),
        "attn_out": nrm(ks[23], (N_ATTN_LAYERS, ATT_V_DIM, D_MODEL), ATT_V_DIM ** -0.5),
        "ffn_gate": nrm(ks[24], (DEPTH, D_MODEL, D_FF), D_MODEL ** -0.5),
        "ffn_up": nrm(ks[25], (DEPTH, D_MODEL, D_FF), D_MODEL ** -0.5),
        "ffn_down": nrm(ks[26], (DEPTH, D_FF, D_MODEL), D_FF ** -0.5),
    }


def reference(x_prompt, x_sample, state_conv, state_ssm, cache_k, cache_v,
              norm_mix, norm_ffn, norm_final,
              ssd_in_proj, ssd_conv_w, ssd_conv_b, ssd_dt_bias, ssd_a_log, ssd_d, ssd_norm, ssd_out_proj,
              attn_qkv, attn_lambda_q1, attn_lambda_k1, attn_lambda_q2, attn_lambda_k2, attn_subln, attn_out,
              ffn_gate, ffn_up, ffn_down):
    bp, lp = x_prompt.shape[0], x_prompt.shape[1]
    bs, ls = x_sample.shape[0], x_sample.shape[1]
    past = cache_k.shape[2]
    pos_p = jnp.arange(lp)
    pos_s = past + jnp.arange(ls)
    kpos_s = jnp.arange(past + ls)
    xp, xs = x_prompt, x_sample
    conv_p, ssm_p, k_p, v_p = [], [], [], []
    conv_s, ssm_s, k_s, v_s = [], [], [], []

    for i in range(DEPTH):
        hp = rmsnorm(xp, norm_mix[i])
        hs = rmsnorm(xs, norm_mix[i])
        j = i // N_MIXERS
        if i % N_MIXERS == 0:
            params = (ssd_in_proj[j], ssd_conv_w[j], ssd_conv_b[j], ssd_dt_bias[j], ssd_a_log[j],
                      ssd_d[j], ssd_norm[j], ssd_out_proj[j])
            hist0 = jnp.zeros((bp, CONV_W - 1, CONV_DIM), xp.dtype)
            h0 = jnp.zeros((bp, SSD_GROUPS, SSD_HPG, SSD_HEAD_DIM, D_STATE), jnp.float32)
            yp, hist_p, hT_p = ssd_mixer(hp, hist0, h0, *params)
            h0s = state_ssm[j].astype(jnp.float32).reshape(bs, SSD_GROUPS, SSD_HPG, SSD_HEAD_DIM, D_STATE)
            ys, hist_s, hT_s = ssd_mixer(hs, state_conv[j], h0s, *params)
            conv_p.append(hist_p)
            ssm_p.append(hT_p.reshape(bp, SSD_HEADS, SSD_HEAD_DIM, D_STATE))
            conv_s.append(hist_s)
            ssm_s.append(hT_s.reshape(bs, SSD_HEADS, SSD_HEAD_DIM, D_STATE))
        else:
            lambda_init = 0.8 - 0.6 * math.exp(-0.3 * i)
            lam = (jnp.exp(jnp.sum(attn_lambda_q1[j].astype(jnp.float32) * attn_lambda_k1[j].astype(jnp.float32)))
                   - jnp.exp(jnp.sum(attn_lambda_q2[j].astype(jnp.float32) * attn_lambda_k2[j].astype(jnp.float32)))
                   + lambda_init)
            qp, kp, vp = diff_qkv(hp, pos_p, attn_qkv[j])
            nb = lp // Q_BLOCK
            qb = jnp.moveaxis(qp.reshape(bp, nb, Q_BLOCK, ATT_HEADS, 2, ATT_HEAD_DIM), 1, 0)
            pb = pos_p.reshape(nb, Q_BLOCK)
            ob = lax.map(lambda a: diff_core(a[0], kp, vp, a[1], pos_p, lam), (qb, pb))
            op = jnp.moveaxis(ob, 0, 1).reshape(bp, lp, ATT_HEADS, 2 * ATT_HEAD_DIM)
            yp = diff_out(op, attn_subln[j], lambda_init, attn_out[j], xp.dtype)
            qs, ks_new, vs_new = diff_qkv(hs, pos_s, attn_qkv[j])
            k_all = jnp.concatenate([cache_k[j].astype(ks_new.dtype), ks_new], axis=1)
            v_all = jnp.concatenate([cache_v[j].astype(vs_new.dtype), vs_new], axis=1)
            os_ = diff_core(qs, k_all, v_all, pos_s, kpos_s, lam)
            ys = diff_out(os_, attn_subln[j], lambda_init, attn_out[j], xs.dtype)
            k_p.append(kp)
            v_p.append(vp)
            k_s.append(ks_new)
            v_s.append(vs_new)
        xp = xp + yp
        xs = xs + ys
        xp = xp + swiglu(rmsnorm(xp, norm_ffn[i]), ffn_gate[i], ffn_up[i], ffn_down[i])
        xs = xs + swiglu(rmsnorm(xs, norm_ffn[i]), ffn_gate[i], ffn_up[i], ffn_down[i])

    y_prompt = rmsnorm(xp, norm_final)
    y_sample = rmsnorm(xs, norm_final)
    new_conv_prompt = jnp.stack(conv_p)
    new_ssm_prompt = jnp.stack(ssm_p)
    new_k_prompt = jnp.stack(k_p)
    new_v_prompt = jnp.stack(v_p)
    new_conv_sample = jnp.stack(conv_s)
    new_ssm_sample = jnp.stack(ssm_s)
    new_k_sample = jnp.stack(k_s)
    new_v_sample = jnp.stack(v_s)
    return (y_prompt, y_sample, new_conv_prompt, new_ssm_prompt, new_k_prompt, new_v_prompt,
            new_conv_sample, new_ssm_sample, new_k_sample, new_v_sample)
```

```cpp
#include <hip/hip_runtime.h>
#include <hip/hip_cooperative_groups.h>
#include <cmath>
#include <cstdio>
namespace cg = cooperative_groups;

#ifndef COOP
#define COOP 1
#endif

typedef unsigned short bfu;
using bf16x8 = __attribute__((ext_vector_type(8))) short;
using f32x4 = __attribute__((ext_vector_type(4))) float;
using u32x4 = __attribute__((ext_vector_type(4))) unsigned;

constexpr int D = 1024;
constexpr int MP = 65536;
constexpr int MS = 512;
constexpr int MT = MP + MS;
constexpr int DI = 2048;
constexpr int CONVD = 3072;
constexpr int ZXW = 5120;
constexpr int INP_N = 5152;
constexpr int INP_NP = 5376;
constexpr int DFF = 2816;
constexpr int SKV = 1088;
constexpr float EPS = 1e-6f;
constexpr float LAMBDA_INIT = 0.35550906759f;
constexpr float QSCALE = 0.125f * 1.4426950408889634f;

constexpr size_t O_Y = 0;
constexpr size_t O_CONVP = 67633152;
constexpr size_t O_SSMP = 67780608;
constexpr size_t O_KP = 71974912;
constexpr size_t O_VP = 139083776;
constexpr size_t O_CONVS = 206192640;
constexpr size_t O_SSMS = 206266368;
constexpr size_t O_KS = 208363520;
constexpr size_t O_VS = 208887808;

constexpr size_t WS_W_INP = 0;
constexpr size_t WS_W_OUTP = WS_W_INP + (size_t)INP_NP * 1024 * 2;
constexpr size_t WS_W_GU0 = WS_W_OUTP + (size_t)1024 * 2048 * 2;
constexpr size_t WS_W_DN0 = WS_W_GU0 + (size_t)5632 * 1024 * 2;
constexpr size_t WS_W_QKV = WS_W_DN0 + (size_t)1024 * 2816 * 2;
constexpr size_t WS_W_AO = WS_W_QKV + (size_t)3072 * 1024 * 2;
constexpr size_t WS_W_GU1 = WS_W_AO + (size_t)1024 * 1024 * 2;
constexpr size_t WS_W_DN1 = WS_W_GU1 + (size_t)5632 * 1024 * 2;
constexpr size_t WS_XN = WS_W_DN1 + (size_t)1024 * 2816 * 2;
constexpr size_t WS_DT = WS_XN + (size_t)MT * 1024 * 2;
constexpr size_t WS_SSQ = WS_DT + (size_t)MT * 32 * 4;
constexpr size_t WS_BIG = WS_SSQ + (size_t)MT * 16 * 4;
constexpr size_t WS_BAR = WS_BIG + (size_t)MT * ZXW * 2;
constexpr size_t WS_XR = WS_BAR + 16384;
constexpr size_t WS_END = WS_XR + (size_t)MT * 1024 * 2;
constexpr size_t WS_Q = WS_BIG;
constexpr size_t WS_KP = WS_Q + (size_t)MT * 1024 * 2;
constexpr size_t WS_VTP = WS_KP + (size_t)MP * 1024 * 2;
constexpr size_t WS_KSM = WS_VTP + (size_t)MP * 1024 * 2;
constexpr size_t WS_VTS = WS_KSM + (size_t)8 * SKV * 1024 * 2;
constexpr size_t WS_AO = WS_VTS + (size_t)8 * SKV * 1024 * 2;
static_assert(WS_AO + (size_t)MT * 1024 * 2 <= WS_BAR, "layer-1 aliases overflow");
static_assert((size_t)MT * DFF * 2 <= WS_KSM - WS_BIG, "ffn h overlaps sample K");

constexpr int LDS_BYTES = 157696;
constexpr int NPH = 15;

struct Params {
  const float* in[27];
  float* out;
  unsigned char* ws;
  int ph_lo, ph_hi;
};
typedef const __attribute__((address_space(4))) Params* KP;

__device__ __forceinline__ bfu f2bf(float f) {
  unsigned u = __float_as_uint(f);
  u += 0x7fffu + ((u >> 16) & 1u);
  return (bfu)(u >> 16);
}
__device__ __forceinline__ float bf2f(bfu h) { return __uint_as_float(((unsigned)h) << 16); }
__device__ __forceinline__ unsigned pack2(float a, float b) { return (unsigned)f2bf(a) | ((unsigned)f2bf(b) << 16); }
__device__ __forceinline__ unsigned cvt_pk_bf16(float lo, float hi) {
  unsigned r;
  asm volatile("v_cvt_pk_bf16_f32 %0, %1, %2" : "=v"(r) : "v"(lo), "v"(hi));
  return r;
}
__device__ __forceinline__ float silu_f(float x) { return x * __builtin_amdgcn_rcpf(1.f + __expf(-x)); }
__device__ __forceinline__ float shx(float v, int mask, int lane) {
  return __int_as_float(__builtin_amdgcn_ds_bpermute((lane ^ mask) << 2, __float_as_int(v)));
}
__device__ __forceinline__ float shup(float v, int d, int lane) {
  return __int_as_float(__builtin_amdgcn_ds_bpermute((lane - d) << 2, __float_as_int(v)));
}
__device__ __forceinline__ float shidx(float v, int src) {
  return __int_as_float(__builtin_amdgcn_ds_bpermute(src << 2, __float_as_int(v)));
}
__device__ __forceinline__ float wave_sum(float v, int lane) {
#pragma unroll
  for (int o = 32; o >= 1; o >>= 1) v += shx(v, o, lane);
  return v;
}
__device__ __forceinline__ f32x4 mfma16(bf16x8 a, bf16x8 b, f32x4 c) {
  return __builtin_amdgcn_mfma_f32_16x16x32_bf16(a, b, c, 0, 0, 0);
}
__device__ __forceinline__ int opaque_tid(int wv) {
  int lane;
  asm volatile("v_mbcnt_lo_u32_b32 %0, -1, 0\n\tv_mbcnt_hi_u32_b32 %0, -1, %0" : "=v"(lane));
  return wv * 64 + lane;
}
__device__ __forceinline__ float xmax_16_32(float v) {
  auto a = __builtin_amdgcn_permlane16_swap(__float_as_uint(v), __float_as_uint(v), false, false);
  v = fmaxf(__uint_as_float(a[0]), __uint_as_float(a[1]));
  auto b = __builtin_amdgcn_permlane32_swap(__float_as_uint(v), __float_as_uint(v), false, false);
  return fmaxf(__uint_as_float(b[0]), __uint_as_float(b[1]));
}
__device__ __forceinline__ float xsum_16_32(float v) {
  auto a = __builtin_amdgcn_permlane16_swap(__float_as_uint(v), __float_as_uint(v), false, false);
  v = __uint_as_float(a[0]) + __uint_as_float(a[1]);
  auto b = __builtin_amdgcn_permlane32_swap(__float_as_uint(v), __float_as_uint(v), false, false);
  return __uint_as_float(b[0]) + __uint_as_float(b[1]);
}
__device__ __forceinline__ float row16_sum(float v) {
  v += __int_as_float(__builtin_amdgcn_update_dpp(0, __float_as_int(v), 0xB1, 0xf, 0xf, true));
  v += __int_as_float(__builtin_amdgcn_update_dpp(0, __float_as_int(v), 0x4E, 0xf, 0xf, true));
  v += __int_as_float(__builtin_amdgcn_update_dpp(0, __float_as_int(v), 0x141, 0xf, 0xf, true));
  v += __int_as_float(__builtin_amdgcn_update_dpp(0, __float_as_int(v), 0x140, 0xf, 0xf, true));
  return v;
}
__device__ __forceinline__ f32x4 bf4_to_f32(uint2 u) {
  return f32x4{__uint_as_float(u.x << 16), __uint_as_float(u.x & 0xffff0000u), __uint_as_float(u.y << 16), __uint_as_float(u.y & 0xffff0000u)};
}
__device__ __forceinline__ void lds_barrier() {
  asm volatile("s_waitcnt lgkmcnt(0)" ::: "memory");
  __builtin_amdgcn_s_barrier();
  asm volatile("" ::: "memory");
}
__device__ __forceinline__ bf16x8 lds_b128(const bfu* p) { return *reinterpret_cast<const bf16x8*>(p); }

__device__ __forceinline__ void conv_tile(const float* __restrict__ src, const float* __restrict__ src2, const float* __restrict__ scale,
                                          bfu* __restrict__ dst, int Nsrc, int mode, int dstStride, int kt, int nt, float* sT, const int tid) {
  __syncthreads();
#pragma unroll
  for (int i = 0; i < 8; ++i) {
    int idx = tid + i * 512;
    int kk = idx >> 6, rr = idx & 63;
    int r = nt * 64 + rr;
    size_t k = (size_t)(kt * 64 + kk);
    float v = 0.f;
    if (mode == 0) {
      if (r < Nsrc) v = src[k * Nsrc + r];
    } else if (mode == 1) {
      int blk = r >> 5, w = r & 31;
      int sc = blk * 16 + (w & 15);
      v = (w < 16 ? src : src2)[k * Nsrc + sc];
    } else {
      int sc = r;
      if (r < 2048) {
        int pos = r & 63, pb = pos >> 4;
        int tb = (pb == 1) ? 2 : ((pb == 2) ? 1 : pb);
        sc = (r & ~63) + tb * 16 + (pos & 15);
      }
      v = src[k * Nsrc + sc];
    }
    sT[kk * 65 + rr] = v;
  }
  __syncthreads();
#pragma unroll
  for (int i = 0; i < 8; ++i) {
    int idx = tid + i * 512;
    int rr = idx >> 6, kk = idx & 63;
    float v = sT[kk * 65 + rr];
    if (scale) v *= scale[kt * 64 + kk];
    dst[(size_t)(nt * 64 + rr) * dstStride + kt * 64 + kk] = f2bf(v);
  }
}

__device__ __forceinline__ void phase_convert_weights(KP P, char* smem, const int wv) {
  float* sT = (float*)smem;
  const int tid = opaque_tid(wv);
  for (int t = blockIdx.x; t < 7104; t += gridDim.x) {
    const float *src, *src2 = nullptr, *scale = nullptr;
    bfu* dst;
    int K, Nsrc, mode = 0, lt;
    if (t < 1344) { lt = t; src = P->in[9]; dst = (bfu*)(P->ws + WS_W_INP); K = 1024; Nsrc = INP_N; }
    else if (t < 1856) { lt = t - 1344; src = P->in[16]; scale = P->in[15]; dst = (bfu*)(P->ws + WS_W_OUTP); K = 2048; Nsrc = 1024; }
    else if (t < 3264) { lt = t - 1856; src = P->in[24]; src2 = P->in[25]; dst = (bfu*)(P->ws + WS_W_GU0); K = 1024; Nsrc = DFF; mode = 1; }
    else if (t < 3968) { lt = t - 3264; src = P->in[26]; dst = (bfu*)(P->ws + WS_W_DN0); K = 2816; Nsrc = 1024; }
    else if (t < 4736) { lt = t - 3968; src = P->in[17]; dst = (bfu*)(P->ws + WS_W_QKV); K = 1024; Nsrc = 3072; mode = 2; }
    else if (t < 4992) { lt = t - 4736; src = P->in[23]; dst = (bfu*)(P->ws + WS_W_AO); K = 1024; Nsrc = 1024; }
    else if (t < 6400) { lt = t - 4992; src = P->in[24] + (size_t)1024 * DFF; src2 = P->in[25] + (size_t)1024 * DFF; dst = (bfu*)(P->ws + WS_W_GU1); K = 1024; Nsrc = DFF; mode = 1; }
    else { lt = t - 6400; src = P->in[26] + (size_t)DFF * 1024; dst = (bfu*)(P->ws + WS_W_DN1); K = 2816; Nsrc = 1024; }
    int nkt = K / 64;
    int kt = lt % nkt, nt = lt / nkt;
    conv_tile(src, src2, scale, dst, Nsrc, mode, K, kt, nt, sT, tid);
  }
}

__device__ __forceinline__ void phase_convert_cache(KP P, char* smem, const int wv) {
  float* sT = (float*)smem;
  const int tid = opaque_tid(wv);
  bfu* ks = (bfu*)(P->ws + WS_KSM);
  bfu* vts = (bfu*)(P->ws + WS_VTS);
  const float* ck = P->in[4];
  const float* cv = P->in[5];
  for (size_t i = (size_t)blockIdx.x * 512 + tid; i < (size_t)8 * 1024 * 256; i += (size_t)gridDim.x * 512) {
    size_t e = i * 4;
    int b = (int)(e >> 20);
    size_t rem = e & ((1u << 20) - 1);
    float4 v = *(const float4*)(ck + e);
    uint2 o; o.x = pack2(v.x, v.y); o.y = pack2(v.z, v.w);
    *(uint2*)(ks + (size_t)b * SKV * 1024 + rem) = o;
  }
  for (int t = blockIdx.x; t < 8 * 256; t += gridDim.x) {
    int b = t >> 8, lt = t & 255;
    int kt = lt & 15, nt = lt >> 4;
    conv_tile(cv + (size_t)b * 1024 * 1024, nullptr, nullptr, vts + (size_t)b * 1024 * SKV, 1024, 0, SKV, kt, nt, sT, tid);
  }
}

template <bool FINAL, bool SRCB>
__device__ __forceinline__ void phase_norm(const float* xa, const float* xb, const bfu* xr, const float* w, bfu* dst, float* fdst, const int wv) {
  const int tid_ = opaque_tid(wv);
  const int lane = tid_ & 63, wid = tid_ >> 6;
  f32x4 w4[4];
#pragma unroll
  for (int i = 0; i < 4; ++i) w4[i] = ((const f32x4*)w)[i * 64 + lane];
  for (int row = blockIdx.x * 8 + wid; row < MT / 2; row += gridDim.x * 8) {
    f32x4 v[2][4];
    float ss[2] = {0.f, 0.f};
#pragma unroll
    for (int h = 0; h < 2; ++h) {
      const int r = row + h * (MT / 2);
      if (SRCB) {
#pragma unroll
        for (int i = 0; i < 4; ++i) v[h][i] = bf4_to_f32(((const uint2*)(xr + (size_t)r * D))[i * 64 + lane]);
      } else {
        const float* x = r < MP ? xa + (size_t)r * D : xb + (size_t)(r - MP) * D;
#pragma unroll
        for (int i = 0; i < 4; ++i) v[h][i] = ((const f32x4*)x)[i * 64 + lane];
      }
    }
#pragma unroll
    for (int h = 0; h < 2; ++h) {
#pragma unroll
      for (int i = 0; i < 4; ++i) ss[h] += v[h][i][0] * v[h][i][0] + v[h][i][1] * v[h][i][1] + v[h][i][2] * v[h][i][2] + v[h][i][3] * v[h][i][3];
      ss[h] = wave_sum(ss[h], lane);
    }
#pragma unroll
    for (int h = 0; h < 2; ++h) {
      const int r = row + h * (MT / 2);
      const float rstd = rsqrtf(ss[h] * (1.f / D) + EPS);
#pragma unroll
      for (int i = 0; i < 4; ++i) {
        f32x4 o = v[h][i] * rstd * w4[i];
        if (FINAL) {
          ((f32x4*)(fdst + (size_t)r * D))[i * 64 + lane] = o;
        } else {
          uint2 pk; pk.x = cvt_pk_bf16(o[0], o[1]); pk.y = cvt_pk_bf16(o[2], o[3]);
          ((uint2*)(dst + (size_t)r * D))[i * 64 + lane] = pk;
        }
      }
    }
  }
}

enum { EPI_INPROJ = 0, EPI_OUTPROJ = 1, EPI_RES = 2, EPI_GU = 3, EPI_QKV = 4 };
#define LAS __attribute__((address_space(3)))
constexpr int HT_B = 128 * 64 * 2;
__device__ __forceinline__ int lds_byte(int r, int c) {
  int st = (r >> 4) * 2 + (c >> 5), rr = r & 15, cc = c & 31, ob = rr * 64 + cc * 2;
  return st * 1024 + (ob ^ (((ob >> 9) & 1) << 5));
}
__device__ __forceinline__ void stage_rc(int b, int& R, int& C) {
  int st = b / 1024, sb = b % 1024, swz = sb ^ (((sb >> 9) & 1) << 5);
  R = (st >> 1) * 16 + swz / 64;
  C = (st & 1) * 32 + (swz % 64) / 2;
}
__device__ __forceinline__ float softplus_f(float x) { return x > 20.f ? x : log1pf(__expf(x)); }

__device__ __forceinline__ float ssd_rstd(const float* __restrict__ ssq, int row) {
  const f32x4* p = (const f32x4*)(ssq + (size_t)row * 16);
  f32x4 a = p[0], b = p[1], c = p[2], d = p[3];
  float sm = (a[0] + a[1]) + (a[2] + a[3]) + (b[0] + b[1]) + (b[2] + b[3]) + (c[0] + c[1]) + (c[2] + c[3]) + (d[0] + d[1]) + (d[2] + d[3]);
  return rsqrtf(sm * (1.f / DI) + EPS);
}

template <int EPI>
__device__ __forceinline__ void gemm_acc_init(KP P, f32x4 (&acc)[2][2][4][2], int brow, int bcol, int wr, int wc, int fr_, int fq_, const float* sRu) {
  if (EPI == EPI_OUTPROJ || EPI == EPI_RES) {
    int fr = fr_, fq = fq_;
    asm volatile("" : "+v"(fr), "+v"(fq));
    const float* xin = (brow < MP ? P->in[0] + (size_t)brow * D : P->in[1] + (size_t)(brow - MP) * D) + bcol;
    const bfu* xrb = (const bfu*)(P->ws + WS_XR) + (size_t)brow * D + bcol;
#pragma unroll
    for (int ai = 0; ai < 2; ++ai)
#pragma unroll
      for (int m = 0; m < 4; ++m) {
        __builtin_amdgcn_sched_barrier(0);
        unsigned lr = ai * 128 + wr * 64 + m * 16 + fr;
        unsigned o = lr * D + wc * 32 + fq * 4;
        float sc = 1.f;
        if (EPI == EPI_OUTPROJ) sc = 1.f / sRu[lr];
#pragma unroll
        for (int bj = 0; bj < 2; ++bj)
#pragma unroll
          for (int n = 0; n < 2; ++n) {
            if (EPI == EPI_RES) acc[ai][bj][m][n] = bf4_to_f32(*(const uint2*)(xrb + o + bj * 128 + n * 16));
            else acc[ai][bj][m][n] = *(const f32x4*)(xin + o + bj * 128 + n * 16) * sc;
          }
      }
  } else {
#pragma unroll
    for (int ai = 0; ai < 2; ++ai)
#pragma unroll
      for (int bj = 0; bj < 2; ++bj)
#pragma unroll
        for (int m = 0; m < 4; ++m)
#pragma unroll
          for (int n = 0; n < 2; ++n) acc[ai][bj][m][n] = f32x4{0.f, 0.f, 0.f, 0.f};
  }
}

template <int EPI>
__device__ __forceinline__ void gemm_epilogue(KP P, f32x4 (&acc)[2][2][4][2], int brow, int bcol, int wr, int wc, int fr_, int fq_, const float* sRu) {
  int fr = fr_, fq = fq_;
  asm volatile("" : "+v"(fr), "+v"(fq));
  const unsigned lrow0 = wr * 64 + fr;
  const unsigned lcol0 = wc * 32 + fq * 4;
  if (EPI == EPI_INPROJ) {
    if (bcol < ZXW) {
      bfu* zxb = (bfu*)(P->ws + WS_BIG) + (size_t)brow * ZXW + bcol;
#pragma unroll
      for (int ai = 0; ai < 2; ++ai)
#pragma unroll
        for (int m = 0; m < 4; ++m) {
          __builtin_amdgcn_sched_barrier(0);
          unsigned o = (lrow0 + ai * 128 + m * 16) * ZXW + lcol0;
#pragma unroll
          for (int bj = 0; bj < 2; ++bj)
#pragma unroll
            for (int n = 0; n < 2; ++n) {
              f32x4 v = acc[ai][bj][m][n];
              uint2 pk; pk.x = cvt_pk_bf16(v[0], v[1]); pk.y = cvt_pk_bf16(v[2], v[3]);
              *(uint2*)(zxb + o + bj * 128 + n * 16) = pk;
            }
        }
      const bool has_tail = (brow >= MP) || (((brow + 256) & 4095) == 0);
      if (has_tail && bcol >= DI) {
#pragma unroll
        for (int ai = 0; ai < 2; ++ai)
#pragma unroll
          for (int m = 0; m < 4; ++m) {
            __builtin_amdgcn_sched_barrier(0);
            int row = brow + lrow0 + ai * 128 + m * 16;
            float* dst = nullptr;
            if (row < MP) {
              int t = row & 4095;
              if (t >= 4093) dst = P->out + O_CONVP + ((size_t)(row >> 12) * 3 + (t - 4093)) * CONVD;
            } else {
              int rs = row - MP, t = rs & 63;
              if (t >= 61) dst = P->out + O_CONVS + ((size_t)(rs >> 6) * 3 + (t - 61)) * CONVD;
            }
            if (dst) {
              unsigned o = bcol - DI + lcol0;
#pragma unroll
              for (int bj = 0; bj < 2; ++bj)
#pragma unroll
                for (int n = 0; n < 2; ++n) *(f32x4*)(dst + o + bj * 128 + n * 16) = acc[ai][bj][m][n];
            }
          }
      }
    } else {
      if (wc == 0) {
        float* dtb = (float*)(P->ws + WS_DT) + (size_t)brow * 32;
        const float* dtbias = P->in[12];
        const f32x4 b0 = *(const f32x4*)(dtbias + fq * 4), b1 = *(const f32x4*)(dtbias + 16 + fq * 4);
#pragma unroll
        for (int ai = 0; ai < 2; ++ai)
#pragma unroll
          for (int m = 0; m < 4; ++m) {
            __builtin_amdgcn_sched_barrier(0);
            unsigned o = (lrow0 + ai * 128 + m * 16) * 32 + fq * 4;
            f32x4 x0 = acc[ai][0][m][0] + b0, x1 = acc[ai][0][m][1] + b1;
            f32x4 d0, d1;
#pragma unroll
            for (int j = 0; j < 4; ++j) { d0[j] = softplus_f(x0[j]); d1[j] = softplus_f(x1[j]); }
            *(f32x4*)(dtb + o) = d0;
            *(f32x4*)(dtb + o + 16) = d1;
          }
      }
    }
  } else if (EPI == EPI_OUTPROJ || EPI == EPI_RES) {
    bfu* xo = (bfu*)(P->ws + WS_XR) + (size_t)brow * D + bcol;
#pragma unroll
    for (int ai = 0; ai < 2; ++ai)
#pragma unroll
      for (int m = 0; m < 4; ++m) {
        __builtin_amdgcn_sched_barrier(0);
        unsigned lr = lrow0 + ai * 128 + m * 16;
        unsigned o = lr * D + lcol0;
        float rsd = 1.f;
        if (EPI == EPI_OUTPROJ) rsd = sRu[lr];
#pragma unroll
        for (int bj = 0; bj < 2; ++bj)
#pragma unroll
          for (int n = 0; n < 2; ++n) {
            f32x4 v = acc[ai][bj][m][n] * rsd;
            uint2 pk; pk.x = cvt_pk_bf16(v[0], v[1]); pk.y = cvt_pk_bf16(v[2], v[3]);
            *(uint2*)(xo + o + bj * 128 + n * 16) = pk;
          }
      }
  } else if (EPI == EPI_GU) {
    bfu* hb = (bfu*)(P->ws + WS_BIG) + (size_t)brow * DFF + (bcol >> 1);
#pragma unroll
    for (int ai = 0; ai < 2; ++ai)
#pragma unroll
      for (int m = 0; m < 4; ++m) {
        __builtin_amdgcn_sched_barrier(0);
        unsigned o = (lrow0 + ai * 128 + m * 16) * DFF + wc * 16 + fq * 4;
#pragma unroll
        for (int bj = 0; bj < 2; ++bj) {
          f32x4 g = acc[ai][bj][m][0], u = acc[ai][bj][m][1];
          uint2 pk;
          pk.x = cvt_pk_bf16(silu_f(g[0]) * u[0], silu_f(g[1]) * u[1]);
          pk.y = cvt_pk_bf16(silu_f(g[2]) * u[2], silu_f(g[3]) * u[3]);
          *(uint2*)(hb + o + bj * 64) = pk;
        }
      }
  } else if (EPI == EPI_QKV) {
    const bool prompt = brow < MP;
    if (bcol < 2048) {
      const bool isq = bcol < 1024;
#pragma unroll
      for (int bj = 0; bj < 2; ++bj) {
        const int col32 = bcol + bj * 128 + wc * 32;
        int frb = fr, fqb = fq;
        asm volatile("" : "+v"(frb), "+v"(fqb));
        const unsigned lrow0b = wr * 64 + frb;
        const int d0 = ((col32 >> 5) & 1) * 16 + fqb * 4;
        float inv[4];
#pragma unroll
        for (int j = 0; j < 4; ++j) inv[j] = exp2f(-(float)(d0 + j) * (13.287712379549449f / 32.f)) * 0.15915494309189535f;
        const unsigned c1 = (col32 & ~63 & 1023) + d0;
        bfu* bdst;
        float* fdst = nullptr;
        if (isq) bdst = (bfu*)(P->ws + WS_Q) + (size_t)brow * 1024;
        else if (prompt) { bdst = (bfu*)(P->ws + WS_KP) + (size_t)brow * 1024; fdst = P->out + O_KP + (size_t)brow * 1024; }
        else { bdst = (bfu*)(P->ws + WS_KSM); fdst = P->out + O_KS + (size_t)(brow - MP) * 1024; }
#pragma unroll
        for (int ai = 0; ai < 2; ++ai)
#pragma unroll
          for (int m = 0; m < 4; ++m) {
            __builtin_amdgcn_sched_barrier(0);
            unsigned lr = lrow0b + ai * 128 + m * 16;
            int row = brow + lr;
            int pos = prompt ? (row & 4095) : 1024 + ((row - MP) & 63);
            f32x4 x1 = acc[ai][bj][m][0], x2 = acc[ai][bj][m][1], o1, o2;
#pragma unroll
            for (int j = 0; j < 4; ++j) {
              float rev = (float)pos * inv[j];
              rev -= floorf(rev);
              float sn = __builtin_amdgcn_sinf(rev), cs = __builtin_amdgcn_cosf(rev);
              o1[j] = x1[j] * cs - x2[j] * sn;
              o2[j] = x2[j] * cs + x1[j] * sn;
            }
            if (isq) {
              uint2 p1, p2;
              p1.x = cvt_pk_bf16(o1[0] * QSCALE, o1[1] * QSCALE); p1.y = cvt_pk_bf16(o1[2] * QSCALE, o1[3] * QSCALE);
              p2.x = cvt_pk_bf16(o2[0] * QSCALE, o2[1] * QSCALE); p2.y = cvt_pk_bf16(o2[2] * QSCALE, o2[3] * QSCALE);
              *(uint2*)(bdst + lr * 1024 + c1) = p1;
              *(uint2*)(bdst + lr * 1024 + c1 + 32) = p2;
            } else {
              *(f32x4*)(fdst + lr * 1024 + c1) = o1;
              *(f32x4*)(fdst + lr * 1024 + c1 + 32) = o2;
              unsigned bo;
              if (prompt) bo = lr * 1024 + c1;
              else { int rs = row - MP; bo = ((rs >> 6) * SKV + 1024 + (rs & 63)) * 1024 + c1; }
              uint2 p1, p2;
              p1.x = cvt_pk_bf16(o1[0], o1[1]); p1.y = cvt_pk_bf16(o1[2], o1[3]);
              p2.x = cvt_pk_bf16(o2[0], o2[1]); p2.y = cvt_pk_bf16(o2[2], o2[3]);
              *(uint2*)(bdst + bo) = p1;
              *(uint2*)(bdst + bo + 32) = p2;
            }
          }
      }
    } else {
      float* fdst = prompt ? P->out + O_VP + (size_t)brow * 1024 + (bcol - 2048) : P->out + O_VS + (size_t)(brow - MP) * 1024 + (bcol - 2048);
      bfu* vt = prompt ? (bfu*)(P->ws + WS_VTP) : (bfu*)(P->ws + WS_VTS);
#pragma unroll
      for (int ai = 0; ai < 2; ++ai)
#pragma unroll
        for (int m = 0; m < 4; ++m) {
          __builtin_amdgcn_sched_barrier(0);
          unsigned lr = lrow0 + ai * 128 + m * 16;
          int row = brow + lr;
          size_t tb;
          unsigned tstr;
          if (prompt) { tb = (size_t)(row >> 12) * 1024 * 4096 + (row & 4095); tstr = 4096; }
          else { int rs = row - MP; tb = (size_t)(rs >> 6) * 1024 * SKV + 1024 + (rs & 63); tstr = SKV; }
#pragma unroll
          for (int bj = 0; bj < 2; ++bj)
#pragma unroll
            for (int n = 0; n < 2; ++n) {
              f32x4 v = acc[ai][bj][m][n];
              unsigned lc = lcol0 + bj * 128 + n * 16;
              *(f32x4*)(fdst + lr * 1024 + lc) = v;
              unsigned c = bcol - 2048 + lc;
#pragma unroll
              for (int j = 0; j < 4; ++j) vt[tb + (size_t)(c + j) * tstr] = f2bf(v[j]);
            }
        }
    }
  }
}

template <int EPI>
__device__ __forceinline__ void gemm_phase(KP P, const bfu* __restrict__ A, const bfu* __restrict__ Bt, int K, int ntn, char* smem, const int wv) {
  const int tid = opaque_tid(wv), wid = wv, lane = tid & 63, wr = wid >> 2, wc = wid & 3, fr = lane & 15, fq = lane >> 4;
  LAS unsigned char* lds = (LAS unsigned char*)smem;
  constexpr bool SPLIT_SAMPLE = (EPI == EPI_OUTPROJ || EPI == EPI_RES);
  const int ntm = SPLIT_SAMPLE ? MP / 256 : MT / 256;
  const int ntiles = ntm * ntn;
  const int nig = 8 * ntn;
  const int nt = K / 64;
  const int G = gridDim.x, xper = G >> 3;
  const int vb = ((G & 7) == 0) ? (int)(blockIdx.x & 7) * xper + (int)(blockIdx.x >> 3) : (int)blockIdx.x;
  if (!SPLIT_SAMPLE && vb >= ntiles) return;
  unsigned voff[2];
#pragma unroll
  for (int i = 0; i < 2; ++i) { int R, C; stage_rc(tid * 16 + i * 8192, R, C); voff[i] = (unsigned)(R * K + C) * 2u; }
  const size_t kstep = (size_t)(64 * 2);
  const size_t hstep = (size_t)128 * K * 2;
  const size_t tstep = 2 * hstep;
  const unsigned ldsw = (unsigned)wid * 1024u;
  const int aoff = lds_byte(wr * 64 + fr, fq * 8), boff = lds_byte(wc * 32 + fr, fq * 8);
#define PG8_SA(b, h) (((b) * 2 + (h)) * HT_B)
#define PG8_SB(b, h) ((4 + (b) * 2 + (h)) * HT_B)
#define PG8_STAGE(bufoff, gbase) do { _Pragma("unroll") for (int _i = 0; _i < 2; ++_i) \
    __builtin_amdgcn_global_load_lds((const unsigned*)((const char*)(gbase) + voff[_i]), (LAS unsigned*)(lds + (bufoff) + ldsw + _i * 8192), 16, 0, 0); } while (0)
#define PG8_LDA(dst, b, h) do { _Pragma("unroll") for (int m = 0; m < 4; ++m) _Pragma("unroll") for (int k = 0; k < 2; ++k) dst[m][k] = *(const LAS bf16x8*)(lds + PG8_SA(b, h) + aoff + m * 2048 + k * 1024); } while (0)
#define PG8_LDB(dst, b, h) do { _Pragma("unroll") for (int n = 0; n < 2; ++n) _Pragma("unroll") for (int k = 0; k < 2; ++k) dst[n][k] = *(const LAS bf16x8*)(lds + PG8_SB(b, h) + boff + n * 2048 + k * 1024); } while (0)
#define PG8_MMA(ai, bj, At, Bt_) do { __builtin_amdgcn_s_setprio(1); _Pragma("unroll") for (int m = 0; m < 4; ++m) _Pragma("unroll") for (int n = 0; n < 2; ++n) _Pragma("unroll") for (int k = 0; k < 2; ++k) \
    acc[ai][bj][m][n] = __builtin_amdgcn_mfma_f32_16x16x32_bf16(Bt_[n][k], At[m][k], acc[ai][bj][m][n], 0, 0, 0); __builtin_amdgcn_s_setprio(0); } while (0)
#define PG8_WAIT_V(n) asm volatile("s_waitcnt vmcnt(" #n ")" ::: "memory")
#define PG8_WAIT_L(n) asm volatile("s_waitcnt lgkmcnt(" #n ")" ::: "memory")
#define PG8_BAR __builtin_amdgcn_s_barrier()
#define PG8_SCHED __builtin_amdgcn_sched_barrier(0)
#define TILE_PMPN(t, pm, pn) do { int gid_ = (t) / nig, fm_ = gid_ * 8, gsz_ = min(ntm - fm_, 8); pm = fm_ + ((t) % nig) % gsz_; pn = ((t) % nig) / gsz_; } while (0)
  int ctile = vb, cpm, cpn;
  TILE_PMPN(ctile, cpm, cpn);
  f32x4 acc[2][2][4][2];
  __syncthreads();
  const float* sRu = (const float*)(smem + 131072);
  if (EPI == EPI_OUTPROJ) {
    float* sR = (float*)(smem + 131072);
    const float* ssq = (const float*)(P->ws + WS_SSQ);
    int ui = 0;
    for (int t = vb; t < ntiles && ui < 8; t += G, ++ui) {
      int pm, pn;
      TILE_PMPN(t, pm, pn);
      if (tid < 256) sR[ui * 256 + tid] = ssd_rstd(ssq, pm * 256 + tid);
    }
    __syncthreads();
  }
  gemm_acc_init<EPI>(P, acc, cpm * 256, cpn * 256, wr, wc, fr, fq, sRu);
  bf16x8 At[4][2], B0[2][2], B1[2][2];
  const char* cA = (const char*)A + (size_t)cpm * tstep;
  const char* cB = (const char*)Bt + (size_t)cpn * tstep;
  PG8_STAGE(PG8_SB(0, 0), cB); PG8_STAGE(PG8_SA(0, 0), cA); PG8_STAGE(PG8_SB(0, 1), cB + hstep); PG8_STAGE(PG8_SA(0, 1), cA + hstep);
  if (wr == 1) PG8_BAR;
  PG8_WAIT_V(4); PG8_BAR;
  PG8_STAGE(PG8_SB(1, 0), cB + kstep); PG8_STAGE(PG8_SA(1, 0), cA + kstep); PG8_STAGE(PG8_SB(1, 1), cB + hstep + kstep);
  PG8_WAIT_V(6); PG8_BAR;
  for (;;) {
    const int ntile = ctile + G;
    const bool has_next = ntile < ntiles;
    int npm = cpm, npn = cpn;
    if (has_next) TILE_PMPN(ntile, npm, npn);
    const char* nA = (const char*)A + (size_t)npm * tstep;
    const char* nB = (const char*)Bt + (size_t)npn * tstep;
    for (int t = 0; t < nt; t += 2) {
      const bool last = (t == nt - 2);
      const char* a1 = cA + (size_t)(t + 1) * kstep;
      const char* a2 = last ? nA : cA + (size_t)(t + 2) * kstep;
      const char* b2 = last ? nB : cB + (size_t)(t + 2) * kstep;
      const char* a3 = a2 + kstep;
      const char* b3 = b2 + kstep;
      PG8_LDB(B0, 0, 0); PG8_SCHED; PG8_LDA(At, 0, 0); PG8_STAGE(PG8_SA(1, 1), a1 + hstep);
      PG8_WAIT_L(8); PG8_BAR; PG8_WAIT_L(0); PG8_MMA(0, 0, At, B0); PG8_BAR; PG8_SCHED;
      PG8_LDB(B1, 0, 1); PG8_STAGE(PG8_SB(0, 0), b2);
      PG8_BAR; PG8_WAIT_L(0); PG8_MMA(0, 1, At, B1); PG8_BAR;
      PG8_LDA(At, 0, 1); PG8_STAGE(PG8_SA(0, 0), a2);
      PG8_BAR; PG8_WAIT_L(0); PG8_MMA(1, 0, At, B0); PG8_BAR; PG8_SCHED;
      PG8_STAGE(PG8_SB(0, 1), b2 + hstep);
      PG8_WAIT_V(6); PG8_BAR; PG8_MMA(1, 1, At, B1); PG8_BAR;
      PG8_LDB(B0, 1, 0); PG8_SCHED; PG8_LDA(At, 1, 0); PG8_STAGE(PG8_SA(0, 1), a2 + hstep);
      PG8_WAIT_L(8); PG8_BAR; PG8_WAIT_L(0); PG8_MMA(0, 0, At, B0); PG8_BAR; PG8_SCHED;
      PG8_LDB(B1, 1, 1); PG8_STAGE(PG8_SB(1, 0), b3);
      PG8_BAR; PG8_WAIT_L(0); PG8_MMA(0, 1, At, B1); PG8_BAR;
      PG8_LDA(At, 1, 1); PG8_STAGE(PG8_SA(1, 0), a3);
      PG8_BAR; PG8_WAIT_L(0); PG8_MMA(1, 0, At, B0); PG8_BAR; PG8_SCHED;
      PG8_STAGE(PG8_SB(1, 1), b3 + hstep);
      PG8_WAIT_V(6); PG8_BAR; PG8_MMA(1, 1, At, B1); PG8_BAR;
    }
    gemm_epilogue<EPI>(P, acc, cpm * 256, cpn * 256, wr, wc, fr, fq, sRu);
    if (!has_next) break;
    sRu += 256;
    gemm_acc_init<EPI>(P, acc, npm * 256, npn * 256, wr, wc, fr, fq, sRu);
    ctile = ntile; cpm = npm; cpn = npn; cA = nA; cB = nB;
  }
  PG8_WAIT_V(0);
  if (wr == 0) PG8_BAR;
  PG8_BAR;
  if (SPLIT_SAMPLE) {
    float* sRed = (float*)smem;
    const int kw = K >> 3;
    for (int task = blockIdx.x; task < 256; task += G) {
      const int rb = task >> 4, cb = task & 15;
      const bfu* ap = A + (size_t)(MP + rb * 32 + fr) * K + wid * kw + fq * 8;
      const bfu* bp = Bt + (size_t)(cb * 64 + fr) * K + wid * kw + fq * 8;
      f32x4 pacc[2][4];
#pragma unroll
      for (int rt = 0; rt < 2; ++rt)
#pragma unroll
        for (int ct = 0; ct < 4; ++ct) pacc[rt][ct] = f32x4{0.f, 0.f, 0.f, 0.f};
      for (int ks = 0; ks < kw; ks += 32) {
        bf16x8 af[2], bf[4];
#pragma unroll
        for (int rt = 0; rt < 2; ++rt) af[rt] = *(const bf16x8*)(ap + (size_t)rt * 16 * K + ks);
#pragma unroll
        for (int ct = 0; ct < 4; ++ct) bf[ct] = *(const bf16x8*)(bp + (size_t)ct * 16 * K + ks);
#pragma unroll
        for (int rt = 0; rt < 2; ++rt)
#pragma unroll
          for (int ct = 0; ct < 4; ++ct) pacc[rt][ct] = mfma16(af[rt], bf[ct], pacc[rt][ct]);
      }
      __syncthreads();
#pragma unroll
      for (int rt = 0; rt < 2; ++rt)
#pragma unroll
        for (int ct = 0; ct < 4; ++ct) *(f32x4*)(sRed + ((wid * 8 + rt * 4 + ct) * 64 + lane) * 4) = pacc[rt][ct];
      __syncthreads();
      {
        f32x4 sum = {0.f, 0.f, 0.f, 0.f};
#pragma unroll
        for (int ww = 0; ww < 8; ++ww) sum += *(const f32x4*)(sRed + ((ww * 8 + wid) * 64 + lane) * 4);
        const int col = cb * 64 + (wid & 3) * 16 + fr;
#pragma unroll
        for (int j = 0; j < 4; ++j) {
          const int srow = rb * 32 + (wid >> 2) * 16 + fq * 4 + j;
          bfu* op = (bfu*)(P->ws + WS_XR) + (size_t)(MP + srow) * D + col;
          if (EPI == EPI_OUTPROJ) {
            const float rs = ssd_rstd((const float*)(P->ws + WS_SSQ), MP + srow);
            *op = f2bf(P->in[1][(size_t)srow * D + col] + rs * sum[j]);
          } else {
            *op = f2bf(bf2f(*op) + sum[j]);
          }
        }
      }
    }
  }
#undef PG8_SA
#undef PG8_SB
#undef PG8_STAGE
#undef PG8_LDA
#undef PG8_LDB
#undef PG8_MMA
#undef PG8_WAIT_V
#undef PG8_WAIT_L
#undef PG8_BAR
#undef PG8_SCHED
#undef TILE_PMPN
}

constexpr int S_LDB = 136;
constexpr int S_LDT = 72;
constexpr int S_LDCB = 68;
__device__ __forceinline__ void phase_ssd(KP P, char* smem, const int wv) {
  bfu* sB = (bfu*)smem;
  bfu* sC = sB + 64 * S_LDB;
  bfu* sBT = sC + 64 * S_LDB;
  bfu* sXT = sBT + 128 * S_LDT;
  float* sCB = (float*)(sXT + 128 * S_LDT);
  bfu* sH = (bfu*)(sCB + 64 * S_LDCB);
  float* sAc = (float*)(sH + 8 * 16 * S_LDB);
  float* sDt = sAc + 512;
  float* sW = sDt + 512;
  float* sSq = sW + 512;
  bfu* sZ = (bfu*)(sSq + 512);
  float* sWc = (float*)(sZ + 64 * S_LDB);
  const int tid = opaque_tid(wv), w = wv, lane = tid & 63, fr = lane & 15, fq = lane >> 4;
  const int hl = w >> 2, ps = w & 3;
  const bfu* zx = (const bfu*)(P->ws + WS_BIG);
  const float* dtb = (const float*)(P->ws + WS_DT);
  float* ssqp = (float*)(P->ws + WS_SSQ);
  bfu* yg = (bfu*)(P->out + O_KP);
  const float* convw = P->in[10];
  const float* convb = P->in[11];
  bfu* myH = sH + w * 16 * S_LDB;
  float* myAc = sAc + w * 64;
  float* myDt = sDt + w * 64;
  float* myW = sW + w * 64;
  float* mySq = sSq + w * 64;
  const bool conv_role = w < 6;

  for (int unit = blockIdx.x; unit < 384; unit += gridDim.x) {
    int seq, g, hp, row0, nch;
    const float* hist = nullptr;
    const float* h0 = nullptr;
    float* hT;
    if (unit < 256) {
      seq = unit >> 4; g = (unit >> 2) & 3; hp = unit & 3;
      row0 = seq * 4096; nch = 64;
      hT = P->out + O_SSMP + (size_t)seq * 32 * 8192;
    } else {
      int u = unit - 256;
      seq = u >> 4; g = (u >> 2) & 3; hp = u & 3;
      row0 = MP + seq * 64; nch = 1;
      hist = P->in[2] + (size_t)seq * 3 * CONVD;
      h0 = P->in[3] + (size_t)seq * 32 * 8192;
      hT = P->out + O_SSMS + (size_t)seq * 32 * 8192;
    }
    const int head = g * 8 + hp * 2 + hl;
    const float A_h = -__expf(P->in[13][head]);
    const float D_h = P->in[14][head];
    f32x4 hacc[8];
    if (h0) {
#pragma unroll
      for (int nt = 0; nt < 8; ++nt)
#pragma unroll
        for (int j = 0; j < 4; ++j) hacc[nt][j] = h0[((size_t)head * 64 + ps * 16 + fq * 4 + j) * 128 + nt * 16 + fr];
    } else {
#pragma unroll
      for (int nt = 0; nt < 8; ++nt) hacc[nt] = f32x4{0.f, 0.f, 0.f, 0.f};
    }
    __syncthreads();
#pragma unroll
    for (int nt = 0; nt < 8; ++nt)
#pragma unroll
      for (int j = 0; j < 4; ++j) myH[(fq * 4 + j) * S_LDB + nt * 16 + fr] = f2bf(hacc[nt][j]);
    const int cgp = tid % 48, rs = tid / 48;
    int cc;
    if (cgp < 16) cc = (g * 8 + hp * 2) * 64 + cgp * 8;
    else if (cgp < 32) cc = DI + g * 128 + (cgp - 16) * 8;
    else cc = DI + 512 + g * 128 + (cgp - 32) * 8;
    if (tid < 384) {
      if (rs < 5) {
        const float* src = (rs < 4) ? convw + rs * CONVD + cc : convb + cc;
        f32x4 a = *(const f32x4*)src, bq = *(const f32x4*)(src + 4);
        *(f32x4*)(sWc + rs * 384 + cgp * 8) = a;
        *(f32x4*)(sWc + rs * 384 + cgp * 8 + 4) = bq;
      }
    }
    const int zt = tid - 384;
    const int zrow = (zt >> 1) & 63, zhalf = zt & 1;

    u32x4 pre[11];
    float dtv;
    {
      const int r0 = row0;
      if (conv_role) {
        const bfu* zxc = zx + ((size_t)r0 - 3) * ZXW + DI;
#pragma unroll
        for (int k = 0; k < 11; ++k) {
          int rr = rs * 8 - 3 + k;
          if (rr < 0) {
            if (hist) {
              f32x4 a = *(const f32x4*)(hist + (3 + rr) * CONVD + cc), bq = *(const f32x4*)(hist + (3 + rr) * CONVD + cc + 4);
              pre[k] = u32x4{pack2(a[0], a[1]), pack2(a[2], a[3]), pack2(bq[0], bq[1]), pack2(bq[2], bq[3])};
            } else {
              pre[k] = u32x4{0u, 0u, 0u, 0u};
            }
          } else {
            pre[k] = *(const u32x4*)(zxc + (unsigned)((rs * 8 + k) * ZXW + cc));
          }
        }
      } else {
        const bfu* zsrc = zx + (size_t)(r0 + zrow) * ZXW + (g * 8 + hp * 2) * 64 + zhalf * 64;
#pragma unroll
        for (int k = 0; k < 8; ++k) pre[k] = *(const u32x4*)(zsrc + k * 8);
#pragma unroll
        for (int k = 8; k < 11; ++k) pre[k] = u32x4{0u, 0u, 0u, 0u};
      }
      dtv = dtb[(size_t)(r0 + lane) * 32 + head];
    }

    for (int c = 0; c < nch; ++c) {
      const int r0 = row0 + c * 64;
      lds_barrier();
      if (conv_role) {
        const float* wcol = sWc + cgp * 8;
        u32x4 ovr[8];
#pragma unroll
        for (int e2 = 0; e2 < 4; ++e2) {
          __builtin_amdgcn_sched_barrier(0);
          float w0[4], w1[4];
#pragma unroll
          for (int tap = 0; tap < 4; ++tap) { w0[tap] = wcol[tap * 384 + 2 * e2]; w1[tap] = wcol[tap * 384 + 2 * e2 + 1]; }
          const float bl = wcol[4 * 384 + 2 * e2], bh = wcol[4 * 384 + 2 * e2 + 1];
#pragma unroll
          for (int i = 0; i < 8; ++i) {
            float ylo = bl, yhi = bh;
#pragma unroll
            for (int tap = 0; tap < 4; ++tap) {
              unsigned rw = pre[i + tap][e2];
              ylo += w0[tap] * __uint_as_float(rw << 16);
              yhi += w1[tap] * __uint_as_float(rw & 0xffff0000u);
            }
            ovr[i][e2] = cvt_pk_bf16(silu_f(ylo), silu_f(yhi));
          }
        }
        if (cgp >= 16) {
          bfu* rowdst = (cgp < 32) ? (sB + (cgp - 16) * 8) : (sC + (cgp - 32) * 8);
#pragma unroll
          for (int i = 0; i < 8; ++i) *(u32x4*)(rowdst + (rs * 8 + i) * S_LDB) = ovr[i];
        }
        if (cgp < 32) {
          bfu* coldst = (cgp < 16) ? (sXT + (cgp * 8) * S_LDT + rs * 8) : (sBT + ((cgp - 16) * 8) * S_LDT + rs * 8);
#pragma unroll
          for (int e = 0; e < 8; ++e) {
            const int e2 = e >> 1, sh = (e & 1) * 16;
            u32x4 o;
            o[0] = ((ovr[0][e2] >> sh) & 0xffffu) | ((ovr[1][e2] >> sh) << 16);
            o[1] = ((ovr[2][e2] >> sh) & 0xffffu) | ((ovr[3][e2] >> sh) << 16);
            o[2] = ((ovr[4][e2] >> sh) & 0xffffu) | ((ovr[5][e2] >> sh) << 16);
            o[3] = ((ovr[6][e2] >> sh) & 0xffffu) | ((ovr[7][e2] >> sh) << 16);
            *(u32x4*)(coldst + e * S_LDT) = o;
          }
        }
      } else {
#pragma unroll
        for (int k = 0; k < 8; ++k) *(u32x4*)(sZ + zrow * S_LDB + zhalf * 64 + k * 8) = pre[k];
      }
      float a63;
      {
        float ac = dtv * A_h;
#pragma unroll
        for (int o = 1; o < 64; o <<= 1) {
          float t = shup(ac, o, lane);
          if (lane >= o) ac += t;
        }
        a63 = shidx(ac, 63);
        myAc[lane] = ac;
        myDt[lane] = dtv;
        myW[lane] = __expf(a63 - ac) * dtv;
      }
      lds_barrier();
      if (c + 1 < nch) {
        const int r1 = r0 + 64;
        int rsl = rs;
        asm volatile("" : "+v"(rsl));
        if (conv_role) {
          const bfu* zxc = zx + ((size_t)r1 - 3) * ZXW + DI;
#pragma unroll
          for (int k = 0; k < 11; ++k) pre[k] = *(const u32x4*)(zxc + (unsigned)((rsl * 8 + k) * ZXW + cc));
        } else {
          const bfu* zsrc = zx + (size_t)(r1 + zrow) * ZXW + (g * 8 + hp * 2) * 64 + zhalf * 64;
#pragma unroll
          for (int k = 0; k < 8; ++k) pre[k] = *(const u32x4*)(zsrc + k * 8);
        }
        dtv = dtb[(size_t)(r1 + lane) * 32 + head];
      }
      int frc = fr, fqc = fq;
      asm volatile("" : "+v"(frc), "+v"(fqc));
      {
        int it = w >> 1, jt0 = (w & 1) * 2;
        f32x4 cb0 = {0.f, 0.f, 0.f, 0.f}, cb1 = {0.f, 0.f, 0.f, 0.f};
#pragma unroll
        for (int ks = 0; ks < 4; ++ks) {
          bf16x8 a = lds_b128(sC + (it * 16 + frc) * S_LDB + ks * 32 + fqc * 8);
          bf16x8 b0 = lds_b128(sB + (jt0 * 16 + frc) * S_LDB + ks * 32 + fqc * 8);
          bf16x8 b1 = lds_b128(sB + ((jt0 + 1) * 16 + frc) * S_LDB + ks * 32 + fqc * 8);
          cb0 = mfma16(a, b0, cb0);
          cb1 = mfma16(a, b1, cb1);
        }
#pragma unroll
        for (int j = 0; j < 4; ++j) {
          sCB[(it * 16 + fqc * 4 + j) * S_LDCB + jt0 * 16 + frc] = cb0[j];
          sCB[(it * 16 + fqc * 4 + j) * S_LDCB + (jt0 + 1) * 16 + frc] = cb1[j];
        }
      }
      lds_barrier();
      const bfu* xrow = sXT + (hl * 64 + ps * 16 + frc) * S_LDT;
#pragma unroll 1
      for (int it = 0; it < 4; ++it) {
        f32x4 yacc = {0.f, 0.f, 0.f, 0.f}, oacc = {0.f, 0.f, 0.f, 0.f};
        const int i = it * 16 + frc;
        const float ac_i = myAc[i];
#pragma unroll
        for (int ks = 0; ks < 2; ++ks) {
          if (ks * 32 <= it * 16 + 15) {
            const int j0 = ks * 32 + fqc * 8;
            f32x4 c0 = *(const f32x4*)(sCB + i * S_LDCB + j0), c1 = *(const f32x4*)(sCB + i * S_LDCB + j0 + 4);
            f32x4 a0 = *(const f32x4*)(myAc + j0), a1 = *(const f32x4*)(myAc + j0 + 4);
            f32x4 d0 = *(const f32x4*)(myDt + j0), d1 = *(const f32x4*)(myDt + j0 + 4);
            float g0[4], g1[4];
#pragma unroll
            for (int e = 0; e < 4; ++e) {
              g0[e] = (j0 + e <= i) ? c0[e] * __expf(ac_i - a0[e]) * d0[e] : 0.f;
              g1[e] = (j0 + 4 + e <= i) ? c1[e] * __expf(ac_i - a1[e]) * d1[e] : 0.f;
            }
            u32x4 pk;
            pk[0] = cvt_pk_bf16(g0[0], g0[1]); pk[1] = cvt_pk_bf16(g0[2], g0[3]);
            pk[2] = cvt_pk_bf16(g1[0], g1[1]); pk[3] = cvt_pk_bf16(g1[2], g1[3]);
            bf16x8 bfv = lds_b128(xrow + j0);
            yacc = mfma16(__builtin_bit_cast(bf16x8, pk), bfv, yacc);
          }
        }
#pragma unroll
        for (int ks = 0; ks < 4; ++ks) {
          bf16x8 a = lds_b128(sC + (it * 16 + frc) * S_LDB + ks * 32 + fqc * 8);
          bf16x8 b = lds_b128(myH + frc * S_LDB + ks * 32 + fqc * 8);
          oacc = mfma16(a, b, oacc);
        }
#pragma unroll
        for (int j = 0; j < 4; ++j) {
          int ii = it * 16 + fqc * 4 + j;
          float xv = bf2f(xrow[ii]);
          float y = yacc[j] + __expf(myAc[ii]) * oacc[j] + D_h * xv;
          float zv = bf2f(sZ[ii * S_LDB + hl * 64 + ps * 16 + frc]);
          float ygv = y * silu_f(zv);
          yg[(size_t)(r0 + ii) * DI + head * 64 + ps * 16 + frc] = f2bf(ygv);
          float sq = ygv * ygv;
          sq = row16_sum(sq);
          if (frc == 0) mySq[ii] = sq;
        }
      }
      {
        const float dec = __expf(a63);
#pragma unroll
        for (int nt = 0; nt < 8; ++nt) hacc[nt] *= dec;
#pragma unroll
        for (int ks = 0; ks < 2; ++ks) {
          const int j0 = ks * 32 + fqc * 8;
          bf16x8 xr = lds_b128(xrow + j0);
          f32x4 w0 = *(const f32x4*)(myW + j0), w1 = *(const f32x4*)(myW + j0 + 4);
          u32x4 xu = __builtin_bit_cast(u32x4, xr);
          u32x4 pk;
          pk[0] = cvt_pk_bf16(__uint_as_float(xu[0] << 16) * w0[0], __uint_as_float(xu[0] & 0xffff0000u) * w0[1]);
          pk[1] = cvt_pk_bf16(__uint_as_float(xu[1] << 16) * w0[2], __uint_as_float(xu[1] & 0xffff0000u) * w0[3]);
          pk[2] = cvt_pk_bf16(__uint_as_float(xu[2] << 16) * w1[0], __uint_as_float(xu[2] & 0xffff0000u) * w1[1]);
          pk[3] = cvt_pk_bf16(__uint_as_float(xu[3] << 16) * w1[2], __uint_as_float(xu[3] & 0xffff0000u) * w1[3]);
          bf16x8 af = __builtin_bit_cast(bf16x8, pk);
#pragma unroll
          for (int nt = 0; nt < 8; ++nt) {
            bf16x8 b = lds_b128(sBT + (nt * 16 + frc) * S_LDT + j0);
            hacc[nt] = mfma16(af, b, hacc[nt]);
          }
        }
#pragma unroll
        for (int nt = 0; nt < 8; ++nt)
#pragma unroll
          for (int j = 0; j < 4; ++j) myH[(fqc * 4 + j) * S_LDB + nt * 16 + frc] = f2bf(hacc[nt][j]);
      }
      lds_barrier();
      if (tid < 64) {
        float sm = 0.f;
#pragma unroll
        for (int ww = 0; ww < 8; ++ww) sm += sSq[ww * 64 + tid];
        ssqp[(size_t)(r0 + tid) * 16 + g * 4 + hp] = sm;
      }
    }
#pragma unroll
    for (int nt = 0; nt < 8; ++nt)
#pragma unroll
      for (int j = 0; j < 4; ++j) hT[((size_t)head * 64 + ps * 16 + fq * 4 + j) * 128 + nt * 16 + fr] = hacc[nt][j];
  }
}

constexpr int A_STAGE = 32768;
constexpr int A_LDO = 132;
__device__ __forceinline__ int kswz(int key) { return ((key >> 1) & 1) | (((key >> 3) & 3) << 1); }
__device__ __forceinline__ void phase_attn(KP P, char* smem, const int wv) {
  LAS unsigned char* lds = (LAS unsigned char*)smem;
  float* sO = (float*)smem;
  const int tid = opaque_tid(wv), w = wv, lane = tid & 63, fr = lane & 15, fq = lane >> 4;
  const int cm = w >> 2, rg = w & 3;
  const bfu* qb = (const bfu*)(P->ws + WS_Q);
  bfu* ao = (bfu*)(P->ws + WS_AO);
  float lam;
  {
    float a = P->in[18][lane] * P->in[19][lane];
    float b = P->in[20][lane] * P->in[21][lane];
    a = wave_sum(a, lane); b = wave_sum(b, lane);
    lam = __expf(a) - __expf(b) + LAMBDA_INIT;
  }
  const float* subln = P->in[22];
  unsigned ksrc[2], vsrc_row[2], vsrc_col[2];
#pragma unroll
  for (int i = 0; i < 2; ++i) {
    int p = (2 * w + i) * 64 + lane;
    int row = p >> 3, phys = p & 7;
    int map = row >> 6, key = row & 63;
    ksrc[i] = (unsigned)(key * 1024 + map * 64 + ((phys ^ kswz(key)) << 3));
    vsrc_row[i] = (unsigned)row;
    vsrc_col[i] = (unsigned)((phys ^ (row & 7)) << 3);
  }
  unsigned koff[4];
#pragma unroll
  for (int t4 = 0; t4 < 4; ++t4) {
    int key = (t4 >> 1) * 32 + (fr >> 2) * 8 + (t4 & 1) * 4 + (fr & 3);
    koff[t4] = (unsigned)((cm * 64 + key) * 128 + ((fq ^ kswz(key)) << 4));
  }
  const unsigned voff0 = 16384u + (unsigned)(fr * 128 + ((fq ^ (fr & 7)) << 4));
  const unsigned kb0 = koff[0], kb1 = koff[0] ^ 64u, vb0 = voff0, vb1 = voff0 ^ 64u;

  const int G = gridDim.x;
  const bool xcd_order = (G == 256);
  const int nrounds = xcd_order ? 17 : (4096 + 64 + G - 1) / G;
  for (int r = 0; r < nrounds; ++r) {
    int b, h, pc;
    bool sample = false;
    if (xcd_order) {
      int x = blockIdx.x & 7, j = blockIdx.x >> 3;
      if (r < 16) { int bh = r * 8 + x; b = bh >> 3; h = bh & 7; pc = (r & 1) ? 31 - j : j; }
      else { if (j >= 8) break; int sidx = x * 8 + j; b = sidx >> 3; h = sidx & 7; pc = 0; sample = true; }
    } else {
      int u = blockIdx.x + r * G;
      if (u >= 4096 + 64) break;
      if (u < 4096) { pc = 31 - (u >> 7); int bh = u & 127; b = bh >> 3; h = bh & 7; }
      else { int sidx = u - 4096; b = sidx >> 3; h = sidx & 7; pc = 0; sample = true; }
    }
    int qrow0, nkt, Tstr;
    const bfu* kbase;
    const bfu* vtbase;
    if (!sample) {
      qrow0 = b * 4096 + pc * 128;
      nkt = 2 * pc + 2;
      Tstr = 4096;
      kbase = (const bfu*)(P->ws + WS_KP) + (size_t)b * 4096 * 1024 + h * 128;
      vtbase = (const bfu*)(P->ws + WS_VTP) + (size_t)(b * 8 + h) * 128 * 4096;
    } else {
      qrow0 = MP + b * 64;
      nkt = 17;
      Tstr = SKV;
      kbase = (const bfu*)(P->ws + WS_KSM) + (size_t)b * SKV * 1024 + h * 128;
      vtbase = (const bfu*)(P->ws + WS_VTS) + (size_t)(b * 8 + h) * 128 * SKV;
    }
    const bool wave_valid = !sample || rg < 2;
    const int my_nkt = sample ? nkt : (rg < 2 ? nkt - 1 : nkt);
    bf16x8 qf[2][2];
    {
      const int qr = wave_valid ? (qrow0 + rg * 32 + fr) : qrow0;
      const bfu* qp = qb + (size_t)qr * 1024 + h * 128 + cm * 64 + fq * 8;
#pragma unroll
      for (int qt = 0; qt < 2; ++qt) {
        qf[qt][0] = *(const bf16x8*)(qp + (wave_valid ? qt * 16 * 1024 : 0));
        qf[qt][1] = *(const bf16x8*)(qp + (wave_valid ? qt * 16 * 1024 : 0) + 32);
      }
    }
    float mrun[2] = {-INFINITY, -INFINITY}, lrun[2] = {0.f, 0.f};
    f32x4 oacc[2][8];
#pragma unroll
    for (int qt = 0; qt < 2; ++qt)
#pragma unroll
      for (int et = 0; et < 8; ++et) oacc[qt][et] = f32x4{0.f, 0.f, 0.f, 0.f};

#define ATT_STAGE(stage, kt_) do { \
      const bfu* kt_base = kbase + (size_t)(kt_) * 64 * 1024; \
      const bfu* vt_base = vtbase + (size_t)(kt_) * 64; \
      _Pragma("unroll") for (int _i = 0; _i < 2; ++_i) \
        __builtin_amdgcn_global_load_lds((const unsigned*)(kt_base + ksrc[_i]), (LAS unsigned*)(lds + (stage) * A_STAGE + (2 * w + _i) * 1024), 16, 0, 0); \
      _Pragma("unroll") for (int _i = 0; _i < 2; ++_i) \
        __builtin_amdgcn_global_load_lds((const unsigned*)(vt_base + (size_t)vsrc_row[_i] * Tstr + vsrc_col[_i]), (LAS unsigned*)(lds + (stage) * A_STAGE + 16384 + (2 * w + _i) * 1024), 16, 0, 0); \
    } while (0)

#define ATT_S_SOFTMAX(stage_) do { \
      LAS unsigned char* sb = lds + (stage_) * A_STAGE; \
      f32x4 st[2][4]; \
      _Pragma("unroll") for (int t4 = 0; t4 < 4; ++t4) { \
        bf16x8 a0 = *(const LAS bf16x8*)(sb + kb0 + (t4 >> 1) * 4096 + (t4 & 1) * 512); \
        bf16x8 a1 = *(const LAS bf16x8*)(sb + kb1 + (t4 >> 1) * 4096 + (t4 & 1) * 512); \
        _Pragma("unroll") for (int qt = 0; qt < 2; ++qt) { \
          f32x4 z = {0.f, 0.f, 0.f, 0.f}; \
          z = mfma16(a0, qf[qt][0], z); \
          st[qt][t4] = mfma16(a1, qf[qt][1], z); \
        } \
      } \
      _Pragma("unroll") for (int qt = 0; qt < 2; ++qt) { \
        float mx = st[qt][0][0]; \
        _Pragma("unroll") for (int t4 = 0; t4 < 4; ++t4) \
          _Pragma("unroll") for (int j = 0; j < 4; ++j) mx = fmaxf(mx, st[qt][t4][j]); \
        mx = xmax_16_32(mx); \
        float mnew = fmaxf(mrun[qt], mx); \
        float alpha = __builtin_amdgcn_exp2f(mrun[qt] - mnew); \
        float ls = 0.f; \
        _Pragma("unroll") for (int t4 = 0; t4 < 4; ++t4) \
          _Pragma("unroll") for (int j = 0; j < 4; ++j) { \
            float p = __builtin_amdgcn_exp2f(st[qt][t4][j] - mnew); \
            st[qt][t4][j] = p; \
            ls += p; \
          } \
        lrun[qt] = lrun[qt] * alpha + ls; \
        mrun[qt] = mnew; \
        _Pragma("unroll") for (int et = 0; et < 8; ++et) oacc[qt][et] *= alpha; \
        _Pragma("unroll") for (int kk = 0; kk < 2; ++kk) { \
          u32x4 pk; \
          pk[0] = cvt_pk_bf16(st[qt][2 * kk][0], st[qt][2 * kk][1]); \
          pk[1] = cvt_pk_bf16(st[qt][2 * kk][2], st[qt][2 * kk][3]); \
          pk[2] = cvt_pk_bf16(st[qt][2 * kk + 1][0], st[qt][2 * kk + 1][1]); \
          pk[3] = cvt_pk_bf16(st[qt][2 * kk + 1][2], st[qt][2 * kk + 1][3]); \
          pb[qt][kk] = __builtin_bit_cast(bf16x8, pk); \
        } \
      } \
    } while (0)
#define ATT_PV(stage_) do { \
      LAS unsigned char* sb = lds + (stage_) * A_STAGE; \
      __builtin_amdgcn_s_setprio(1); \
      _Pragma("unroll") for (int kk = 0; kk < 2; ++kk) \
        _Pragma("unroll") for (int et = 0; et < 8; ++et) { \
          bf16x8 a = *(const LAS bf16x8*)(sb + (kk ? vb1 : vb0) + et * 2048); \
          oacc[0][et] = mfma16(a, pb[0][kk], oacc[0][et]); \
          oacc[1][et] = mfma16(a, pb[1][kk], oacc[1][et]); \
        } \
      __builtin_amdgcn_s_setprio(0); \
    } while (0)

    __syncthreads();
    ATT_STAGE(0, 0);
    if (nkt > 1) ATT_STAGE(1, 1);
    if (nkt > 1) asm volatile("s_waitcnt vmcnt(4)" ::: "memory");
    else asm volatile("s_waitcnt vmcnt(0)" ::: "memory");
    if (cm == 1) lds_barrier();
    bf16x8 pb[2][2];
#pragma unroll 1
    for (int kt = 0; kt < nkt; ++kt) {
      const bool act = wave_valid && kt < my_nkt;
      lds_barrier();
      if (kt + 2 < nkt) ATT_STAGE((kt + 2) & 3, kt + 2);
      if (act) ATT_S_SOFTMAX(kt & 3);
      if (kt + 1 < nkt) {
        if (kt + 2 < nkt) asm volatile("s_waitcnt vmcnt(4)" ::: "memory");
        else asm volatile("s_waitcnt vmcnt(0)" ::: "memory");
      }
      lds_barrier();
      if (act) ATT_PV(kt & 3);
    }
    if (cm == 0) lds_barrier();
#undef ATT_S_SOFTMAX
#undef ATT_PV
#undef ATT_STAGE
    lrun[0] = xsum_16_32(lrun[0]);
    lrun[1] = xsum_16_32(lrun[1]);
    __syncthreads();
    if (cm == 1 && wave_valid) {
#pragma unroll
      for (int qt = 0; qt < 2; ++qt) {
        float rl = 1.f / lrun[qt];
#pragma unroll
        for (int et = 0; et < 8; ++et) *(f32x4*)(sO + (rg * 32 + qt * 16 + fr) * A_LDO + et * 16 + fq * 4) = oacc[qt][et] * rl;
      }
    }
    __syncthreads();
    if (cm == 0 && wave_valid) {
#pragma unroll
      for (int qt = 0; qt < 2; ++qt) {
        float rl = 1.f / lrun[qt];
        float ss = 0.f;
#pragma unroll
        for (int et = 0; et < 8; ++et) {
          f32x4 o1 = *(const f32x4*)(sO + (rg * 32 + qt * 16 + fr) * A_LDO + et * 16 + fq * 4);
          f32x4 o = oacc[qt][et] * rl - o1 * lam;
          oacc[qt][et] = o;
          ss += o[0] * o[0] + o[1] * o[1] + o[2] * o[2] + o[3] * o[3];
        }
        ss = xsum_16_32(ss);
        float rstd = rsqrtf(ss * (1.f / 128.f) + EPS) * (1.f - LAMBDA_INIT);
        bfu* dst = ao + (size_t)(qrow0 + rg * 32 + qt * 16 + fr) * 1024 + h * 128;
        int fqe = fq;
        asm volatile("" : "+v"(fqe));
#pragma unroll
        for (int et = 0; et < 8; ++et) {
          int e0 = et * 16 + fqe * 4;
          f32x4 sw = *(const f32x4*)(subln + e0);
          uint2 pk;
          pk.x = cvt_pk_bf16(oacc[qt][et][0] * rstd * sw[0], oacc[qt][et][1] * rstd * sw[1]);
          pk.y = cvt_pk_bf16(oacc[qt][et][2] * rstd * sw[2], oacc[qt][et][3] * rstd * sw[3]);
          *(uint2*)(dst + e0) = pk;
        }
      }
    }
  }
}

#define XB_TMO      128
#define XB_XCNT(j)  (256  + 64 * (j))
#define XB_XSUB(j)  (1280 + 64 * (j))
#define XB_XGEN(j)  (2304 + 64 * (j))
#define XB_TOP      3328
#define XB_TOPGEN   3392
#define XCD_BAR_WORDS 3456
#define XB_SPIN_CAP (1u << 22)
__device__ __forceinline__ unsigned xb_ld(unsigned* p)              { return __hip_atomic_load(p, __ATOMIC_RELAXED, __HIP_MEMORY_SCOPE_AGENT); }
__device__ __forceinline__ unsigned xb_add(unsigned* p, unsigned v) { return __hip_atomic_fetch_add(p, v, __ATOMIC_RELAXED, __HIP_MEMORY_SCOPE_AGENT); }
__device__ __forceinline__ unsigned xb_xcc_id() { return (unsigned)__builtin_amdgcn_s_getreg((3 << 11) | 20) & 0xFu; }
#define XB_SPIN(cond, bar) do { unsigned _sp = 0; while (cond) { __builtin_amdgcn_s_sleep(1); \
    if ((++_sp & 255u) == 0u) { if (xb_ld(&(bar)[XB_TMO])) break; if (_sp > XB_SPIN_CAP) { atomicAdd(&(bar)[XB_TMO], 1u); break; } } } } while (0)
__device__ __forceinline__ void xcd_barrier_complete(unsigned* bar, unsigned x, unsigned& nloc, unsigned& nx) {
  const unsigned G = gridDim.x;
  unsigned sum, cnt, mine, sp = 0u;
  for (;;) {
    sum = 0u; cnt = 0u; mine = 0u;
#pragma unroll
    for (unsigned j = 0; j < 16; ++j) { const unsigned c = xb_ld(&bar[XB_XCNT(j)]); sum += c; cnt += (c > 0u) ? 1u : 0u; mine = (j == x) ? c : mine; }
    if (sum == G) break;
    __builtin_amdgcn_s_sleep(1);
    if ((++sp & 255u) == 0u) { if (xb_ld(&bar[XB_TMO])) break; if (sp > XB_SPIN_CAP) { atomicAdd(&bar[XB_TMO], 1u); break; } }
  }
  nloc = mine > 0u ? mine : 1u; nx = cnt > 0u ? cnt : 1u;
}
__device__ __forceinline__ void xcd_barrier(unsigned* bar, volatile __attribute__((address_space(3))) unsigned* st, const int tid) {
  asm volatile("s_waitcnt vmcnt(0)" ::: "memory");
  __syncthreads();
  if (tid == 0) {
    const unsigned x = xb_xcc_id();
    __builtin_amdgcn_s_waitcnt(0);
    unsigned nloc = st[0], nx = st[1];
    if (nloc == 0u) { xcd_barrier_complete(bar, x, nloc, nx); st[0] = nloc; st[1] = nx; }
    const unsigned old = xb_add(&bar[XB_XSUB(x)], 1u);
    const unsigned gen = old / nloc;
    if (old + 1u == (gen + 1u) * nloc) {
      __builtin_amdgcn_fence(__ATOMIC_RELEASE, "agent");
      asm volatile("s_waitcnt vmcnt(0)" ::: "memory");
      const unsigned og = xb_add(&bar[XB_TOP], 1u);
      const unsigned tg = og / nx;
      if (og + 1u == (tg + 1u) * nx) xb_add(&bar[XB_TOPGEN], 1u);
      else XB_SPIN(xb_ld(&bar[XB_TOPGEN]) == tg, bar);
      __builtin_amdgcn_fence(__ATOMIC_ACQUIRE, "agent");
      xb_add(&bar[XB_XGEN(x)], 1u);
      asm volatile("s_waitcnt vmcnt(0)" ::: "memory");
    } else {
      XB_SPIN(xb_ld(&bar[XB_XGEN(x)]) == gen, bar);
      __builtin_amdgcn_fence(__ATOMIC_ACQUIRE, "agent");
      asm volatile("s_waitcnt vmcnt(0)" ::: "memory");
    }
  }
  __syncthreads();
}

__global__ void __launch_bounds__(512) fwd_kernel(Params Pk) {
  extern __shared__ __attribute__((aligned(16))) char smem_base[];
  const int wv = __builtin_amdgcn_readfirstlane((int)(threadIdx.x >> 6));
  volatile __attribute__((address_space(3))) unsigned* xst = (volatile __attribute__((address_space(3))) unsigned*)(smem_base + LDS_BYTES - 16);
  if (threadIdx.x == 0) {
    xst[0] = 0u; xst[1] = 0u;
    (void)xb_add(&((unsigned*)(Pk.ws + WS_BAR))[XB_XCNT(xb_xcc_id())], 1u);
  }
  __syncthreads();
  for (int ph = Pk.ph_lo; ph < Pk.ph_hi; ++ph) {
    int zoff = 0;
    asm volatile("" : "+s"(zoff));
    char* smem = smem_base + zoff;
    KP P = (KP)__builtin_amdgcn_kernarg_segment_ptr();
    asm volatile("" : "+s"(P));
#ifdef PROBE_DUP
    for (int rep = 0; rep < (((PROBE_DUP >> ph) & 1) ? 2 : 1); ++rep)
#endif
    switch (ph) {
      case 0: case 4: case 7: case 11: {
        const float* w = ph == 0 ? P->in[6] : (ph == 4 ? P->in[7] : (ph == 7 ? P->in[6] + D : P->in[7] + D));
        if (ph == 0) phase_norm<false, false>(P->in[0], P->in[1], nullptr, w, (bfu*)(P->ws + WS_XN), nullptr, wv);
        else phase_norm<false, true>(nullptr, nullptr, (const bfu*)(P->ws + WS_XR), w, (bfu*)(P->ws + WS_XN), nullptr, wv);
        if (ph == 0) phase_convert_weights(P, smem, wv);
        if (ph == 7) phase_convert_cache(P, smem, wv);
      } break;
      case 1: gemm_phase<EPI_INPROJ>(P, (const bfu*)(P->ws + WS_XN), (const bfu*)(P->ws + WS_W_INP), 1024, INP_NP / 256, smem, wv); break;
      case 2: phase_ssd(P, smem, wv); break;
      case 3: gemm_phase<EPI_OUTPROJ>(P, (const bfu*)(P->out + O_KP), (const bfu*)(P->ws + WS_W_OUTP), 2048, 4, smem, wv); break;
      case 5: case 12:
        gemm_phase<EPI_GU>(P, (const bfu*)(P->ws + WS_XN), (const bfu*)(P->ws + (ph == 5 ? WS_W_GU0 : WS_W_GU1)), 1024, 22, smem, wv);
        break;
      case 6: case 10: case 13: {
        const bfu* A = (const bfu*)(P->ws + (ph == 10 ? WS_AO : WS_BIG));
        const bfu* Bt = (const bfu*)(P->ws + (ph == 6 ? WS_W_DN0 : (ph == 10 ? WS_W_AO : WS_W_DN1)));
        gemm_phase<EPI_RES>(P, A, Bt, ph == 10 ? 1024 : DFF, 4, smem, wv);
      } break;
      case 8: gemm_phase<EPI_QKV>(P, (const bfu*)(P->ws + WS_XN), (const bfu*)(P->ws + WS_W_QKV), 1024, 12, smem, wv); break;
      case 9: phase_attn(P, smem, wv); break;
      case 14: phase_norm<true, true>(nullptr, nullptr, (const bfu*)(P->ws + WS_XR), P->in[8], nullptr, P->out, wv); break;
    }
    if (ph + 1 < Pk.ph_hi) {
      if (ph == Pk.ph_lo) cg::this_grid().sync();
      else xcd_barrier((unsigned*)(P->ws + WS_BAR), xst, opaque_tid(wv));
    }
  }
}

extern "C" void kernel_launch(void* const* d_in, const int* in_sizes, int n_in, void* d_out, int out_size, void* d_ws, size_t ws_size,
                              hipStream_t stream) {
  static int grid = 0;
  if (grid == 0) {
    if (n_in != 27 || ws_size < WS_END || out_size != 209412096) {
      fprintf(stderr, "kernel_launch: unexpected sizes n_in=%d ws=%zu (need %zu) out=%d\n", n_in, ws_size, (size_t)WS_END, out_size);
    }
    int dev = 0, cus = 0, per_cu = 0;
    (void)hipGetDevice(&dev);
    (void)hipDeviceGetAttribute(&cus, hipDeviceAttributeMultiprocessorCount, dev);
    (void)hipFuncSetAttribute((const void*)fwd_kernel, hipFuncAttributeMaxDynamicSharedMemorySize, LDS_BYTES);
    (void)hipOccupancyMaxActiveBlocksPerMultiprocessor(&per_cu, (const void*)fwd_kernel, 512, LDS_BYTES);
    if (per_cu < 1) { fprintf(stderr, "kernel_launch: occupancy query returned %d\n", per_cu); per_cu = 1; }
    grid = cus * per_cu;
    fprintf(stderr, "kernel_launch: grid=%d (cus=%d per_cu=%d) ws=%zu need=%zu\n", grid, cus, per_cu, ws_size, (size_t)WS_END);
  }
  Params p{};
  for (int i = 0; i < 27; ++i) p.in[i] = (const float*)d_in[i];
  p.out = (float*)d_out;
  p.ws = (unsigned char*)d_ws;
#if COOP
  (void)hipMemsetAsync((char*)d_ws + WS_BAR, 0, 16384, stream);
  p.ph_lo = 0; p.ph_hi = NPH;
  void* args[] = {&p};
  hipError_t e = hipLaunchCooperativeKernel((const void*)fwd_kernel, dim3(grid), dim3(512), args, LDS_BYTES, stream);
  if (e != hipSuccess) fprintf(stderr, "cooperative launch failed: %s (grid %d)\n", hipGetErrorString(e), grid);
#else
  for (int ph = 0; ph < NPH; ++ph) {
    p.ph_lo = ph; p.ph_hi = ph + 1;
    hipLaunchKernelGGL(fwd_kernel, dim3(grid), dim3(512), LDS_BYTES, stream, p);
  }
#endif
}
```

```cpp
#include <hip/hip_runtime.h>
#include <hip/hip_cooperative_groups.h>
#include <cmath>
#include <cstdio>
namespace cg = cooperative_groups;

#ifndef COOP
#define COOP 1
#endif

typedef unsigned short bfu;
using bf16x8 = __attribute__((ext_vector_type(8))) short;
using f32x4 = __attribute__((ext_vector_type(4))) float;
using u32x4 = __attribute__((ext_vector_type(4))) unsigned;
using f32x2 = __attribute__((ext_vector_type(2))) float;

constexpr int D = 1024;
constexpr int MP = 65536;
constexpr int MS = 512;
constexpr int MT = MP + MS;
constexpr int DI = 2048;
constexpr int CONVD = 3072;
constexpr int ZXW = 5120;
constexpr int INP_N = 5152;
constexpr int INP_NP = 5376;
constexpr int DFF = 2816;
constexpr int SKV = 1088;
constexpr float EPS = 1e-6f;
constexpr float LAMBDA_INIT = 0.35550906759f;
constexpr float QSCALE = 0.125f * 1.4426950408889634f;

constexpr size_t O_Y = 0;
constexpr size_t O_CONVP = 67633152;
constexpr size_t O_SSMP = 67780608;
constexpr size_t O_KP = 71974912;
constexpr size_t O_VP = 139083776;
constexpr size_t O_CONVS = 206192640;
constexpr size_t O_SSMS = 206266368;
constexpr size_t O_KS = 208363520;
constexpr size_t O_VS = 208887808;

constexpr size_t WS_W_INP = 0;
constexpr size_t WS_W_OUTP = WS_W_INP + (size_t)INP_NP * 1024 * 2;
constexpr size_t WS_W_GU0 = WS_W_OUTP + (size_t)1024 * 2048 * 2;
constexpr size_t WS_W_DN0 = WS_W_GU0 + (size_t)5632 * 1024 * 2;
constexpr size_t WS_W_QKV = WS_W_DN0 + (size_t)1024 * 2816 * 2;
constexpr size_t WS_W_AO = WS_W_QKV + (size_t)3072 * 1024 * 2;
constexpr size_t WS_W_GU1 = WS_W_AO + (size_t)1024 * 1024 * 2;
constexpr size_t WS_W_DN1 = WS_W_GU1 + (size_t)5632 * 1024 * 2;
constexpr size_t WS_XN = WS_W_DN1 + (size_t)1024 * 2816 * 2;
constexpr size_t WS_DT = WS_XN + (size_t)MT * 1024 * 2;
constexpr size_t WS_SSQ = WS_DT + (size_t)MT * 32 * 4;
constexpr size_t WS_BIG = WS_SSQ + (size_t)MT * 16 * 4;
constexpr size_t WS_BAR = WS_BIG + (size_t)MT * ZXW * 2;
constexpr size_t WS_XR = WS_BAR + 16384;
constexpr size_t WS_END = WS_XR + (size_t)MT * 1024 * 2;
constexpr size_t WS_Q = WS_BIG;
constexpr size_t WS_KP = WS_Q + (size_t)MT * 1024 * 2;
constexpr size_t WS_VTP = WS_KP + (size_t)MP * 1024 * 2;
constexpr size_t WS_KSM = WS_VTP + (size_t)MP * 1024 * 2;
constexpr size_t WS_VTS = WS_KSM + (size_t)8 * SKV * 1024 * 2;
constexpr size_t WS_AO = WS_VTS + (size_t)8 * SKV * 1024 * 2;
static_assert(WS_AO + (size_t)MT * 1024 * 2 <= WS_BAR, "layer-1 aliases overflow");
static_assert((size_t)MT * DFF * 2 <= WS_KSM - WS_BIG, "ffn h overlaps sample K");

constexpr int LDS_BYTES = 157696;
constexpr int NPH = 15;

struct Params {
  const float* in[27];
  float* out;
  unsigned char* ws;
  int ph_lo, ph_hi;
};
typedef const __attribute__((address_space(4))) Params* KP;

__device__ __forceinline__ bfu f2bf(float f) {
  unsigned u = __float_as_uint(f);
  u += 0x7fffu + ((u >> 16) & 1u);
  return (bfu)(u >> 16);
}
__device__ __forceinline__ float bf2f(bfu h) { return __uint_as_float(((unsigned)h) << 16); }
__device__ __forceinline__ unsigned pack2(float a, float b) { return (unsigned)f2bf(a) | ((unsigned)f2bf(b) << 16); }
__device__ __forceinline__ unsigned cvt_pk_bf16(float lo, float hi) {
  unsigned r;
  asm volatile("v_cvt_pk_bf16_f32 %0, %1, %2" : "=v"(r) : "v"(lo), "v"(hi));
  return r;
}
__device__ __forceinline__ float silu_f(float x) { return x * __builtin_amdgcn_rcpf(1.f + __expf(-x)); }
__device__ __forceinline__ float shx(float v, int mask, int lane) {
  return __int_as_float(__builtin_amdgcn_ds_bpermute((lane ^ mask) << 2, __float_as_int(v)));
}
__device__ __forceinline__ float shup(float v, int d, int lane) {
  return __int_as_float(__builtin_amdgcn_ds_bpermute((lane - d) << 2, __float_as_int(v)));
}
__device__ __forceinline__ float shidx(float v, int src) {
  return __int_as_float(__builtin_amdgcn_ds_bpermute(src << 2, __float_as_int(v)));
}
__device__ __forceinline__ float wave_sum(float v, int lane) {
#pragma unroll
  for (int o = 32; o >= 1; o >>= 1) v += shx(v, o, lane);
  return v;
}
__device__ __forceinline__ f32x4 mfma16(bf16x8 a, bf16x8 b, f32x4 c) {
  return __builtin_amdgcn_mfma_f32_16x16x32_bf16(a, b, c, 0, 0, 0);
}
__device__ __forceinline__ int opaque_tid(int wv) {
  int lane;
  asm volatile("v_mbcnt_lo_u32_b32 %0, -1, 0\n\tv_mbcnt_hi_u32_b32 %0, -1, %0" : "=v"(lane));
  return wv * 64 + lane;
}
__device__ __forceinline__ float xmax_16_32(float v) {
  auto a = __builtin_amdgcn_permlane16_swap(__float_as_uint(v), __float_as_uint(v), false, false);
  v = fmaxf(__uint_as_float(a[0]), __uint_as_float(a[1]));
  auto b = __builtin_amdgcn_permlane32_swap(__float_as_uint(v), __float_as_uint(v), false, false);
  return fmaxf(__uint_as_float(b[0]), __uint_as_float(b[1]));
}
__device__ __forceinline__ float xsum_16_32(float v) {
  auto a = __builtin_amdgcn_permlane16_swap(__float_as_uint(v), __float_as_uint(v), false, false);
  v = __uint_as_float(a[0]) + __uint_as_float(a[1]);
  auto b = __builtin_amdgcn_permlane32_swap(__float_as_uint(v), __float_as_uint(v), false, false);
  return __uint_as_float(b[0]) + __uint_as_float(b[1]);
}
__device__ __forceinline__ float row16_sum(float v) {
  v += __int_as_float(__builtin_amdgcn_update_dpp(0, __float_as_int(v), 0xB1, 0xf, 0xf, true));
  v += __int_as_float(__builtin_amdgcn_update_dpp(0, __float_as_int(v), 0x4E, 0xf, 0xf, true));
  v += __int_as_float(__builtin_amdgcn_update_dpp(0, __float_as_int(v), 0x141, 0xf, 0xf, true));
  v += __int_as_float(__builtin_amdgcn_update_dpp(0, __float_as_int(v), 0x140, 0xf, 0xf, true));
  return v;
}
__device__ __forceinline__ f32x4 bf4_to_f32(uint2 u) {
  return f32x4{__uint_as_float(u.x << 16), __uint_as_float(u.x & 0xffff0000u), __uint_as_float(u.y << 16), __uint_as_float(u.y & 0xffff0000u)};
}
__device__ __forceinline__ void lds_barrier() {
  asm volatile("s_waitcnt lgkmcnt(0)" ::: "memory");
  __builtin_amdgcn_s_barrier();
  asm volatile("" ::: "memory");
}
__device__ __forceinline__ bf16x8 lds_b128(const bfu* p) { return *reinterpret_cast<const bf16x8*>(p); }

__device__ __forceinline__ void conv_tile(const float* __restrict__ src, const float* __restrict__ src2, const float* __restrict__ scale,
                                          bfu* __restrict__ dst, int Nsrc, int mode, int dstStride, int kt, int nt, float* sT, const int tid) {
  __syncthreads();
#pragma unroll
  for (int i = 0; i < 8; ++i) {
    int idx = tid + i * 512;
    int kk = idx >> 6, rr = idx & 63;
    int r = nt * 64 + rr;
    size_t k = (size_t)(kt * 64 + kk);
    float v = 0.f;
    if (mode == 0) {
      if (r < Nsrc) v = src[k * Nsrc + r];
    } else if (mode == 1) {
      int blk = r >> 5, w = r & 31;
      int sc = blk * 16 + (w & 15);
      v = (w < 16 ? src : src2)[k * Nsrc + sc];
    } else {
      int sc = r;
      if (r < 2048) {
        int pos = r & 63, pb = pos >> 4;
        int tb = (pb == 1) ? 2 : ((pb == 2) ? 1 : pb);
        sc = (r & ~63) + tb * 16 + (pos & 15);
      }
      v = src[k * Nsrc + sc];
    }
    sT[kk * 65 + rr] = v;
  }
  __syncthreads();
#pragma unroll
  for (int i = 0; i < 8; ++i) {
    int idx = tid + i * 512;
    int rr = idx >> 6, kk = idx & 63;
    float v = sT[kk * 65 + rr];
    if (scale) v *= scale[kt * 64 + kk];
    dst[(size_t)(nt * 64 + rr) * dstStride + kt * 64 + kk] = f2bf(v);
  }
}

__device__ __forceinline__ void phase_convert_weights(KP P, char* smem, const int wv) {
  float* sT = (float*)smem;
  const int tid = opaque_tid(wv);
  for (int t = blockIdx.x; t < 7104; t += gridDim.x) {
    const float *src, *src2 = nullptr, *scale = nullptr;
    bfu* dst;
    int K, Nsrc, mode = 0, lt;
    if (t < 1344) { lt = t; src = P->in[9]; dst = (bfu*)(P->ws + WS_W_INP); K = 1024; Nsrc = INP_N; }
    else if (t < 1856) { lt = t - 1344; src = P->in[16]; scale = P->in[15]; dst = (bfu*)(P->ws + WS_W_OUTP); K = 2048; Nsrc = 1024; }
    else if (t < 3264) { lt = t - 1856; src = P->in[24]; src2 = P->in[25]; dst = (bfu*)(P->ws + WS_W_GU0); K = 1024; Nsrc = DFF; mode = 1; }
    else if (t < 3968) { lt = t - 3264; src = P->in[26]; dst = (bfu*)(P->ws + WS_W_DN0); K = 2816; Nsrc = 1024; }
    else if (t < 4736) { lt = t - 3968; src = P->in[17]; dst = (bfu*)(P->ws + WS_W_QKV); K = 1024; Nsrc = 3072; mode = 2; }
    else if (t < 4992) { lt = t - 4736; src = P->in[23]; dst = (bfu*)(P->ws + WS_W_AO); K = 1024; Nsrc = 1024; }
    else if (t < 6400) { lt = t - 4992; src = P->in[24] + (size_t)1024 * DFF; src2 = P->in[25] + (size_t)1024 * DFF; dst = (bfu*)(P->ws + WS_W_GU1); K = 1024; Nsrc = DFF; mode = 1; }
    else { lt = t - 6400; src = P->in[26] + (size_t)DFF * 1024; dst = (bfu*)(P->ws + WS_W_DN1); K = 2816; Nsrc = 1024; }
    int nkt = K / 64;
    int kt = lt % nkt, nt = lt / nkt;
    conv_tile(src, src2, scale, dst, Nsrc, mode, K, kt, nt, sT, tid);
  }
}

__device__ __forceinline__ void phase_convert_cache(KP P, char* smem, const int wv) {
  float* sT = (float*)smem;
  const int tid = opaque_tid(wv);
  bfu* ks = (bfu*)(P->ws + WS_KSM);
  bfu* vts = (bfu*)(P->ws + WS_VTS);
  const float* ck = P->in[4];
  const float* cv = P->in[5];
  for (size_t i = (size_t)blockIdx.x * 512 + tid; i < (size_t)8 * 1024 * 256; i += (size_t)gridDim.x * 512) {
    size_t e = i * 4;
    int b = (int)(e >> 20);
    size_t rem = e & ((1u << 20) - 1);
    float4 v = *(const float4*)(ck + e);
    uint2 o; o.x = pack2(v.x, v.y); o.y = pack2(v.z, v.w);
    *(uint2*)(ks + (size_t)b * SKV * 1024 + rem) = o;
  }
  for (int t = blockIdx.x; t < 8 * 256; t += gridDim.x) {
    int b = t >> 8, lt = t & 255;
    int kt = lt & 15, nt = lt >> 4;
    conv_tile(cv + (size_t)b * 1024 * 1024, nullptr, nullptr, vts + (size_t)b * 1024 * SKV, 1024, 0, SKV, kt, nt, sT, tid);
  }
}

template <bool FINAL, bool SRCB>
__device__ __forceinline__ void phase_norm(const float* xa, const float* xb, const bfu* xr, const float* w, bfu* dst, float* fdst, const int wv) {
  const int tid_ = opaque_tid(wv);
  const int lane = tid_ & 63, wid = tid_ >> 6;
  f32x4 w4[4];
#pragma unroll
  for (int i = 0; i < 4; ++i) w4[i] = ((const f32x4*)w)[i * 64 + lane];
  for (int row = blockIdx.x * 8 + wid; row < MT / 2; row += gridDim.x * 8) {
    f32x4 v[2][4];
    float ss[2] = {0.f, 0.f};
#pragma unroll
    for (int h = 0; h < 2; ++h) {
      const int r = row + h * (MT / 2);
      if (SRCB) {
#pragma unroll
        for (int i = 0; i < 4; ++i) v[h][i] = bf4_to_f32(((const uint2*)(xr + (size_t)r * D))[i * 64 + lane]);
      } else {
        const float* x = r < MP ? xa + (size_t)r * D : xb + (size_t)(r - MP) * D;
#pragma unroll
        for (int i = 0; i < 4; ++i) v[h][i] = ((const f32x4*)x)[i * 64 + lane];
      }
    }
#pragma unroll
    for (int h = 0; h < 2; ++h) {
#pragma unroll
      for (int i = 0; i < 4; ++i) ss[h] += v[h][i][0] * v[h][i][0] + v[h][i][1] * v[h][i][1] + v[h][i][2] * v[h][i][2] + v[h][i][3] * v[h][i][3];
      ss[h] = wave_sum(ss[h], lane);
    }
#pragma unroll
    for (int h = 0; h < 2; ++h) {
      const int r = row + h * (MT / 2);
      const float rstd = rsqrtf(ss[h] * (1.f / D) + EPS);
#pragma unroll
      for (int i = 0; i < 4; ++i) {
        f32x4 o = v[h][i] * rstd * w4[i];
        if (FINAL) {
          ((f32x4*)(fdst + (size_t)r * D))[i * 64 + lane] = o;
        } else {
          uint2 pk; pk.x = cvt_pk_bf16(o[0], o[1]); pk.y = cvt_pk_bf16(o[2], o[3]);
          ((uint2*)(dst + (size_t)r * D))[i * 64 + lane] = pk;
        }
      }
    }
  }
}

enum { EPI_INPROJ = 0, EPI_OUTPROJ = 1, EPI_RES = 2, EPI_GU = 3, EPI_QKV = 4 };
#define LAS __attribute__((address_space(3)))
constexpr int HT_B = 128 * 64 * 2;
__device__ __forceinline__ int lds_byte(int r, int c) {
  int st = (r >> 4) * 2 + (c >> 5), rr = r & 15, cc = c & 31, ob = rr * 64 + cc * 2;
  return st * 1024 + (ob ^ (((ob >> 9) & 1) << 5));
}
__device__ __forceinline__ void stage_rc(int b, int& R, int& C) {
  int st = b / 1024, sb = b % 1024, swz = sb ^ (((sb >> 9) & 1) << 5);
  R = (st >> 1) * 16 + swz / 64;
  C = (st & 1) * 32 + (swz % 64) / 2;
}
__device__ __forceinline__ float softplus_f(float x) { return x > 20.f ? x : log1pf(__expf(x)); }

__device__ __forceinline__ float ssd_rstd(const float* __restrict__ ssq, int row) {
  const f32x4* p = (const f32x4*)(ssq + (size_t)row * 16);
  f32x4 a = p[0], b = p[1], c = p[2], d = p[3];
  float sm = (a[0] + a[1]) + (a[2] + a[3]) + (b[0] + b[1]) + (b[2] + b[3]) + (c[0] + c[1]) + (c[2] + c[3]) + (d[0] + d[1]) + (d[2] + d[3]);
  return rsqrtf(sm * (1.f / DI) + EPS);
}

template <int EPI>
__device__ __forceinline__ void gemm_acc_init(KP P, f32x4 (&acc)[2][2][4][2], int brow, int bcol, int wr, int wc, int fr_, int fq_, const float* sRu) {
  if (EPI == EPI_OUTPROJ || EPI == EPI_RES) {
    int fr = fr_, fq = fq_;
    asm volatile("" : "+v"(fr), "+v"(fq));
    const float* xin = (brow < MP ? P->in[0] + (size_t)brow * D : P->in[1] + (size_t)(brow - MP) * D) + bcol;
    const bfu* xrb = (const bfu*)(P->ws + WS_XR) + (size_t)brow * D + bcol;
#pragma unroll
    for (int ai = 0; ai < 2; ++ai)
#pragma unroll
      for (int m = 0; m < 4; ++m) {
        __builtin_amdgcn_sched_barrier(0);
        unsigned lr = ai * 128 + wr * 64 + m * 16 + fr;
        unsigned o = lr * D + wc * 32 + fq * 4;
        float sc = 1.f;
        if (EPI == EPI_OUTPROJ) sc = 1.f / sRu[lr];
#pragma unroll
        for (int bj = 0; bj < 2; ++bj)
#pragma unroll
          for (int n = 0; n < 2; ++n) {
            if (EPI == EPI_RES) acc[ai][bj][m][n] = bf4_to_f32(*(const uint2*)(xrb + o + bj * 128 + n * 16));
            else acc[ai][bj][m][n] = *(const f32x4*)(xin + o + bj * 128 + n * 16) * sc;
          }
      }
  } else {
#pragma unroll
    for (int ai = 0; ai < 2; ++ai)
#pragma unroll
      for (int bj = 0; bj < 2; ++bj)
#pragma unroll
        for (int m = 0; m < 4; ++m)
#pragma unroll
          for (int n = 0; n < 2; ++n) acc[ai][bj][m][n] = f32x4{0.f, 0.f, 0.f, 0.f};
  }
}

template <int EPI>
__device__ __forceinline__ void gemm_epilogue(KP P, f32x4 (&acc)[2][2][4][2], int brow, int bcol, int wr, int wc, int fr_, int fq_, const float* sRu) {
  int fr = fr_, fq = fq_;
  asm volatile("" : "+v"(fr), "+v"(fq));
  const unsigned lrow0 = wr * 64 + fr;
  const unsigned lcol0 = wc * 32 + fq * 4;
  if (EPI == EPI_INPROJ) {
    if (bcol < ZXW) {
      bfu* zxb = (bfu*)(P->ws + WS_BIG) + (size_t)brow * ZXW + bcol;
#pragma unroll
      for (int ai = 0; ai < 2; ++ai)
#pragma unroll
        for (int m = 0; m < 4; ++m) {
          __builtin_amdgcn_sched_barrier(0);
          unsigned o = (lrow0 + ai * 128 + m * 16) * ZXW + lcol0;
#pragma unroll
          for (int bj = 0; bj < 2; ++bj)
#pragma unroll
            for (int n = 0; n < 2; ++n) {
              f32x4 v = acc[ai][bj][m][n];
              uint2 pk; pk.x = cvt_pk_bf16(v[0], v[1]); pk.y = cvt_pk_bf16(v[2], v[3]);
              *(uint2*)(zxb + o + bj * 128 + n * 16) = pk;
            }
        }
      const bool has_tail = (brow >= MP) || (((brow + 256) & 4095) == 0);
      if (has_tail && bcol >= DI) {
#pragma unroll
        for (int ai = 0; ai < 2; ++ai)
#pragma unroll
          for (int m = 0; m < 4; ++m) {
            __builtin_amdgcn_sched_barrier(0);
            int row = brow + lrow0 + ai * 128 + m * 16;
            float* dst = nullptr;
            if (row < MP) {
              int t = row & 4095;
              if (t >= 4093) dst = P->out + O_CONVP + ((size_t)(row >> 12) * 3 + (t - 4093)) * CONVD;
            } else {
              int rs = row - MP, t = rs & 63;
              if (t >= 61) dst = P->out + O_CONVS + ((size_t)(rs >> 6) * 3 + (t - 61)) * CONVD;
            }
            if (dst) {
              unsigned o = bcol - DI + lcol0;
#pragma unroll
              for (int bj = 0; bj < 2; ++bj)
#pragma unroll
                for (int n = 0; n < 2; ++n) *(f32x4*)(dst + o + bj * 128 + n * 16) = acc[ai][bj][m][n];
            }
          }
      }
    } else {
      if (wc == 0) {
        float* dtb = (float*)(P->ws + WS_DT) + (size_t)brow * 32;
        const float* dtbias = P->in[12];
        const f32x4 b0 = *(const f32x4*)(dtbias + fq * 4), b1 = *(const f32x4*)(dtbias + 16 + fq * 4);
#pragma unroll
        for (int ai = 0; ai < 2; ++ai)
#pragma unroll
          for (int m = 0; m < 4; ++m) {
            __builtin_amdgcn_sched_barrier(0);
            unsigned o = (lrow0 + ai * 128 + m * 16) * 32 + fq * 4;
            f32x4 x0 = acc[ai][0][m][0] + b0, x1 = acc[ai][0][m][1] + b1;
            f32x4 d0, d1;
#pragma unroll
            for (int j = 0; j < 4; ++j) { d0[j] = softplus_f(x0[j]); d1[j] = softplus_f(x1[j]); }
            *(f32x4*)(dtb + o) = d0;
            *(f32x4*)(dtb + o + 16) = d1;
          }
      }
    }
  } else if (EPI == EPI_OUTPROJ || EPI == EPI_RES) {
    bfu* xo = (bfu*)(P->ws + WS_XR) + (size_t)brow * D + bcol;
#pragma unroll
    for (int ai = 0; ai < 2; ++ai)
#pragma unroll
      for (int m = 0; m < 4; ++m) {
        __builtin_amdgcn_sched_barrier(0);
        unsigned lr = lrow0 + ai * 128 + m * 16;
        unsigned o = lr * D + lcol0;
        float rsd = 1.f;
        if (EPI == EPI_OUTPROJ) rsd = sRu[lr];
#pragma unroll
        for (int bj = 0; bj < 2; ++bj)
#pragma unroll
          for (int n = 0; n < 2; ++n) {
            f32x4 v = acc[ai][bj][m][n] * rsd;
            uint2 pk; pk.x = cvt_pk_bf16(v[0], v[1]); pk.y = cvt_pk_bf16(v[2], v[3]);
            *(uint2*)(xo + o + bj * 128 + n * 16) = pk;
          }
      }
  } else if (EPI == EPI_GU) {
    bfu* hb = (bfu*)(P->ws + WS_BIG) + (size_t)brow * DFF + (bcol >> 1);
#pragma unroll
    for (int ai = 0; ai < 2; ++ai)
#pragma unroll
      for (int m = 0; m < 4; ++m) {
        __builtin_amdgcn_sched_barrier(0);
        unsigned o = (lrow0 + ai * 128 + m * 16) * DFF + wc * 16 + fq * 4;
#pragma unroll
        for (int bj = 0; bj < 2; ++bj) {
          f32x4 g = acc[ai][bj][m][0], u = acc[ai][bj][m][1];
          uint2 pk;
          pk.x = cvt_pk_bf16(silu_f(g[0]) * u[0], silu_f(g[1]) * u[1]);
          pk.y = cvt_pk_bf16(silu_f(g[2]) * u[2], silu_f(g[3]) * u[3]);
          *(uint2*)(hb + o + bj * 64) = pk;
        }
      }
  } else if (EPI == EPI_QKV) {
    const bool prompt = brow < MP;
    if (bcol < 2048) {
      const bool isq = bcol < 1024;
#pragma unroll
      for (int bj = 0; bj < 2; ++bj) {
        const int col32 = bcol + bj * 128 + wc * 32;
        int frb = fr, fqb = fq;
        asm volatile("" : "+v"(frb), "+v"(fqb));
        const unsigned lrow0b = wr * 64 + frb;
        const int d0 = ((col32 >> 5) & 1) * 16 + fqb * 4;
        float inv[4];
#pragma unroll
        for (int j = 0; j < 4; ++j) inv[j] = exp2f(-(float)(d0 + j) * (13.287712379549449f / 32.f)) * 0.15915494309189535f;
        const unsigned c1 = (col32 & ~63 & 1023) + d0;
        bfu* bdst;
        float* fdst = nullptr;
        if (isq) bdst = (bfu*)(P->ws + WS_Q) + (size_t)brow * 1024;
        else if (prompt) { bdst = (bfu*)(P->ws + WS_KP) + (size_t)brow * 1024; fdst = P->out + O_KP + (size_t)brow * 1024; }
        else { bdst = (bfu*)(P->ws + WS_KSM); fdst = P->out + O_KS + (size_t)(brow - MP) * 1024; }
#pragma unroll
        for (int ai = 0; ai < 2; ++ai)
#pragma unroll
          for (int m = 0; m < 4; ++m) {
            __builtin_amdgcn_sched_barrier(0);
            unsigned lr = lrow0b + ai * 128 + m * 16;
            int row = brow + lr;
            int pos = prompt ? (row & 4095) : 1024 + ((row - MP) & 63);
            f32x4 x1 = acc[ai][bj][m][0], x2 = acc[ai][bj][m][1], o1, o2;
#pragma unroll
            for (int j = 0; j < 4; ++j) {
              float rev = (float)pos * inv[j];
              rev -= floorf(rev);
              float sn = __builtin_amdgcn_sinf(rev), cs = __builtin_amdgcn_cosf(rev);
              o1[j] = x1[j] * cs - x2[j] * sn;
              o2[j] = x2[j] * cs + x1[j] * sn;
            }
            if (isq) {
              uint2 p1, p2;
              p1.x = cvt_pk_bf16(o1[0] * QSCALE, o1[1] * QSCALE); p1.y = cvt_pk_bf16(o1[2] * QSCALE, o1[3] * QSCALE);
              p2.x = cvt_pk_bf16(o2[0] * QSCALE, o2[1] * QSCALE); p2.y = cvt_pk_bf16(o2[2] * QSCALE, o2[3] * QSCALE);
              *(uint2*)(bdst + lr * 1024 + c1) = p1;
              *(uint2*)(bdst + lr * 1024 + c1 + 32) = p2;
            } else {
              *(f32x4*)(fdst + lr * 1024 + c1) = o1;
              *(f32x4*)(fdst + lr * 1024 + c1 + 32) = o2;
              unsigned bo;
              if (prompt) bo = lr * 1024 + c1;
              else { int rs = row - MP; bo = ((rs >> 6) * SKV + 1024 + (rs & 63)) * 1024 + c1; }
              uint2 p1, p2;
              p1.x = cvt_pk_bf16(o1[0], o1[1]); p1.y = cvt_pk_bf16(o1[2], o1[3]);
              p2.x = cvt_pk_bf16(o2[0], o2[1]); p2.y = cvt_pk_bf16(o2[2], o2[3]);
              *(uint2*)(bdst + bo) = p1;
              *(uint2*)(bdst + bo + 32) = p2;
            }
          }
      }
    } else {
      float* fdst = prompt ? P->out + O_VP + (size_t)brow * 1024 + (bcol - 2048) : P->out + O_VS + (size_t)(brow - MP) * 1024 + (bcol - 2048);
      bfu* vt = prompt ? (bfu*)(P->ws + WS_VTP) : (bfu*)(P->ws + WS_VTS);
#pragma unroll
      for (int ai = 0; ai < 2; ++ai)
#pragma unroll
        for (int m = 0; m < 4; ++m) {
          __builtin_amdgcn_sched_barrier(0);
          unsigned lr = lrow0 + ai * 128 + m * 16;
          int row = brow + lr;
          size_t tb;
          unsigned tstr;
          if (prompt) { tb = (size_t)(row >> 12) * 1024 * 4096 + (row & 4095); tstr = 4096; }
          else { int rs = row - MP; tb = (size_t)(rs >> 6) * 1024 * SKV + 1024 + (rs & 63); tstr = SKV; }
#pragma unroll
          for (int bj = 0; bj < 2; ++bj)
#pragma unroll
            for (int n = 0; n < 2; ++n) {
              f32x4 v = acc[ai][bj][m][n];
              unsigned lc = lcol0 + bj * 128 + n * 16;
              *(f32x4*)(fdst + lr * 1024 + lc) = v;
              unsigned c = bcol - 2048 + lc;
#pragma unroll
              for (int j = 0; j < 4; ++j) vt[tb + (size_t)(c + j) * tstr] = f2bf(v[j]);
            }
        }
    }
  }
}

template <int EPI>
__device__ __forceinline__ void gemm_phase(KP P, const bfu* __restrict__ A, const bfu* __restrict__ Bt, int K, int ntn, char* smem, const int wv) {
  const int tid = opaque_tid(wv), wid = wv, lane = tid & 63, wr = wid >> 2, wc = wid & 3, fr = lane & 15, fq = lane >> 4;
  LAS unsigned char* lds = (LAS unsigned char*)smem;
  constexpr bool SPLIT_SAMPLE = (EPI == EPI_OUTPROJ || EPI == EPI_RES);
  const int ntm = SPLIT_SAMPLE ? MP / 256 : MT / 256;
  const int ntiles = ntm * ntn;
  const int nig = 8 * ntn;
  const int nt = K / 64;
  const int G = gridDim.x, xper = G >> 3;
  const int vb = ((G & 7) == 0) ? (int)(blockIdx.x & 7) * xper + (int)(blockIdx.x >> 3) : (int)blockIdx.x;
  if (!SPLIT_SAMPLE && vb >= ntiles) return;
  unsigned voff[2];
#pragma unroll
  for (int i = 0; i < 2; ++i) { int R, C; stage_rc(tid * 16 + i * 8192, R, C); voff[i] = (unsigned)(R * K + C) * 2u; }
  const size_t kstep = (size_t)(64 * 2);
  const size_t hstep = (size_t)128 * K * 2;
  const size_t tstep = 2 * hstep;
  const unsigned ldsw = (unsigned)wid * 1024u;
  const int aoff = lds_byte(wr * 64 + fr, fq * 8), boff = lds_byte(wc * 32 + fr, fq * 8);
#define PG8_SA(b, h) (((b) * 2 + (h)) * HT_B)
#define PG8_SB(b, h) ((4 + (b) * 2 + (h)) * HT_B)
#define PG8_STAGE(bufoff, gbase) do { _Pragma("unroll") for (int _i = 0; _i < 2; ++_i) \
    __builtin_amdgcn_global_load_lds((const unsigned*)((const char*)(gbase) + voff[_i]), (LAS unsigned*)(lds + (bufoff) + ldsw + _i * 8192), 16, 0, 0); } while (0)
#define PG8_LDA(dst, b, h) do { _Pragma("unroll") for (int m = 0; m < 4; ++m) _Pragma("unroll") for (int k = 0; k < 2; ++k) dst[m][k] = *(const LAS bf16x8*)(lds + PG8_SA(b, h) + aoff + m * 2048 + k * 1024); } while (0)
#define PG8_LDB(dst, b, h) do { _Pragma("unroll") for (int n = 0; n < 2; ++n) _Pragma("unroll") for (int k = 0; k < 2; ++k) dst[n][k] = *(const LAS bf16x8*)(lds + PG8_SB(b, h) + boff + n * 2048 + k * 1024); } while (0)
#define PG8_MMA(ai, bj, At, Bt_) do { __builtin_amdgcn_s_setprio(1); _Pragma("unroll") for (int m = 0; m < 4; ++m) _Pragma("unroll") for (int n = 0; n < 2; ++n) _Pragma("unroll") for (int k = 0; k < 2; ++k) \
    acc[ai][bj][m][n] = __builtin_amdgcn_mfma_f32_16x16x32_bf16(Bt_[n][k], At[m][k], acc[ai][bj][m][n], 0, 0, 0); __builtin_amdgcn_s_setprio(0); } while (0)
#define PG8_WAIT_V(n) asm volatile("s_waitcnt vmcnt(" #n ")" ::: "memory")
#define PG8_WAIT_L(n) asm volatile("s_waitcnt lgkmcnt(" #n ")" ::: "memory")
#define PG8_BAR __builtin_amdgcn_s_barrier()
#define PG8_SCHED __builtin_amdgcn_sched_barrier(0)
#define TILE_PMPN(t, pm, pn) do { int gid_ = (t) / nig, fm_ = gid_ * 8, gsz_ = min(ntm - fm_, 8); pm = fm_ + ((t) % nig) % gsz_; pn = ((t) % nig) / gsz_; } while (0)
  int ctile = vb, cpm, cpn;
  TILE_PMPN(ctile, cpm, cpn);
  f32x4 acc[2][2][4][2];
  __syncthreads();
  const float* sRu = (const float*)(smem + 131072);
  if (EPI == EPI_OUTPROJ) {
    float* sR = (float*)(smem + 131072);
    const float* ssq = (const float*)(P->ws + WS_SSQ);
    int ui = 0;
    for (int t = vb; t < ntiles && ui < 8; t += G, ++ui) {
      int pm, pn;
      TILE_PMPN(t, pm, pn);
      if (tid < 256) sR[ui * 256 + tid] = ssd_rstd(ssq, pm * 256 + tid);
    }
    __syncthreads();
  }
  gemm_acc_init<EPI>(P, acc, cpm * 256, cpn * 256, wr, wc, fr, fq, sRu);
  bf16x8 At[4][2], B0[2][2], B1[2][2];
  const char* cA = (const char*)A + (size_t)cpm * tstep;
  const char* cB = (const char*)Bt + (size_t)cpn * tstep;
  PG8_STAGE(PG8_SB(0, 0), cB); PG8_STAGE(PG8_SA(0, 0), cA); PG8_STAGE(PG8_SB(0, 1), cB + hstep); PG8_STAGE(PG8_SA(0, 1), cA + hstep);
  if (wr == 1) PG8_BAR;
  PG8_WAIT_V(4); PG8_BAR;
  PG8_STAGE(PG8_SB(1, 0), cB + kstep); PG8_STAGE(PG8_SA(1, 0), cA + kstep); PG8_STAGE(PG8_SB(1, 1), cB + hstep + kstep);
  PG8_WAIT_V(6); PG8_BAR;
  for (;;) {
    const int ntile = ctile + G;
    const bool has_next = ntile < ntiles;
    int npm = cpm, npn = cpn;
    if (has_next) TILE_PMPN(ntile, npm, npn);
    const char* nA = (const char*)A + (size_t)npm * tstep;
    const char* nB = (const char*)Bt + (size_t)npn * tstep;
    for (int t = 0; t < nt; t += 2) {
      const bool last = (t == nt - 2);
      const char* a1 = cA + (size_t)(t + 1) * kstep;
      const char* a2 = last ? nA : cA + (size_t)(t + 2) * kstep;
      const char* b2 = last ? nB : cB + (size_t)(t + 2) * kstep;
      const char* a3 = a2 + kstep;
      const char* b3 = b2 + kstep;
      PG8_LDB(B0, 0, 0); PG8_SCHED; PG8_LDA(At, 0, 0); PG8_STAGE(PG8_SA(1, 1), a1 + hstep);
      PG8_WAIT_L(8); PG8_BAR; PG8_WAIT_L(0); PG8_MMA(0, 0, At, B0); PG8_BAR; PG8_SCHED;
      PG8_LDB(B1, 0, 1); PG8_STAGE(PG8_SB(0, 0), b2);
      PG8_BAR; PG8_WAIT_L(0); PG8_MMA(0, 1, At, B1); PG8_BAR;
      PG8_LDA(At, 0, 1); PG8_STAGE(PG8_SA(0, 0), a2);
      PG8_BAR; PG8_WAIT_L(0); PG8_MMA(1, 0, At, B0); PG8_BAR; PG8_SCHED;
      PG8_STAGE(PG8_SB(0, 1), b2 + hstep);
      PG8_WAIT_V(6); PG8_BAR; PG8_MMA(1, 1, At, B1); PG8_BAR;
      PG8_LDB(B0, 1, 0); PG8_SCHED; PG8_LDA(At, 1, 0); PG8_STAGE(PG8_SA(0, 1), a2 + hstep);
      PG8_WAIT_L(8); PG8_BAR; PG8_WAIT_L(0); PG8_MMA(0, 0, At, B0); PG8_BAR; PG8_SCHED;
      PG8_LDB(B1, 1, 1); PG8_STAGE(PG8_SB(1, 0), b3);
      PG8_BAR; PG8_WAIT_L(0); PG8_MMA(0, 1, At, B1); PG8_BAR;
      PG8_LDA(At, 1, 1); PG8_STAGE(PG8_SA(1, 0), a3);
      PG8_BAR; PG8_WAIT_L(0); PG8_MMA(1, 0, At, B0); PG8_BAR; PG8_SCHED;
      PG8_STAGE(PG8_SB(1, 1), b3 + hstep);
      PG8_WAIT_V(6); PG8_BAR; PG8_MMA(1, 1, At, B1); PG8_BAR;
    }
    gemm_epilogue<EPI>(P, acc, cpm * 256, cpn * 256, wr, wc, fr, fq, sRu);
    if (!has_next) break;
    sRu += 256;
    gemm_acc_init<EPI>(P, acc, npm * 256, npn * 256, wr, wc, fr, fq, sRu);
    ctile = ntile; cpm = npm; cpn = npn; cA = nA; cB = nB;
  }
  PG8_WAIT_V(0);
  if (wr == 0) PG8_BAR;
  PG8_BAR;
  if (SPLIT_SAMPLE) {
    float* sRed = (float*)smem;
    const int kw = K >> 3;
    for (int task = blockIdx.x; task < 256; task += G) {
      const int rb = task >> 4, cb = task & 15;
      const bfu* ap = A + (size_t)(MP + rb * 32 + fr) * K + wid * kw + fq * 8;
      const bfu* bp = Bt + (size_t)(cb * 64 + fr) * K + wid * kw + fq * 8;
      f32x4 pacc[2][4];
#pragma unroll
      for (int rt = 0; rt < 2; ++rt)
#pragma unroll
        for (int ct = 0; ct < 4; ++ct) pacc[rt][ct] = f32x4{0.f, 0.f, 0.f, 0.f};
      for (int ks = 0; ks < kw; ks += 32) {
        bf16x8 af[2], bf[4];
#pragma unroll
        for (int rt = 0; rt < 2; ++rt) af[rt] = *(const bf16x8*)(ap + (size_t)rt * 16 * K + ks);
#pragma unroll
        for (int ct = 0; ct < 4; ++ct) bf[ct] = *(const bf16x8*)(bp + (size_t)ct * 16 * K + ks);
#pragma unroll
        for (int rt = 0; rt < 2; ++rt)
#pragma unroll
          for (int ct = 0; ct < 4; ++ct) pacc[rt][ct] = mfma16(af[rt], bf[ct], pacc[rt][ct]);
      }
      __syncthreads();
#pragma unroll
      for (int rt = 0; rt < 2; ++rt)
#pragma unroll
        for (int ct = 0; ct < 4; ++ct) *(f32x4*)(sRed + ((wid * 8 + rt * 4 + ct) * 64 + lane) * 4) = pacc[rt][ct];
      __syncthreads();
      {
        f32x4 sum = {0.f, 0.f, 0.f, 0.f};
#pragma unroll
        for (int ww = 0; ww < 8; ++ww) sum += *(const f32x4*)(sRed + ((ww * 8 + wid) * 64 + lane) * 4);
        const int col = cb * 64 + (wid & 3) * 16 + fr;
#pragma unroll
        for (int j = 0; j < 4; ++j) {
          const int srow = rb * 32 + (wid >> 2) * 16 + fq * 4 + j;
          bfu* op = (bfu*)(P->ws + WS_XR) + (size_t)(MP + srow) * D + col;
          if (EPI == EPI_OUTPROJ) {
            const float rs = ssd_rstd((const float*)(P->ws + WS_SSQ), MP + srow);
            *op = f2bf(P->in[1][(size_t)srow * D + col] + rs * sum[j]);
          } else {
            *op = f2bf(bf2f(*op) + sum[j]);
          }
        }
      }
    }
  }
#undef PG8_SA
#undef PG8_SB
#undef PG8_STAGE
#undef PG8_LDA
#undef PG8_LDB
#undef PG8_MMA
#undef PG8_WAIT_V
#undef PG8_WAIT_L
#undef PG8_BAR
#undef PG8_SCHED
#undef TILE_PMPN
}

constexpr int S_LDB = 136;
constexpr int S_LDT = 72;
constexpr int S_LDCB = 68;
__device__ __forceinline__ void phase_ssd(KP P, char* smem, const int wv) {
  bfu* sB = (bfu*)smem;
  bfu* sC = sB + 64 * S_LDB;
  bfu* sBT = sC + 64 * S_LDB;
  bfu* sXT = sBT + 128 * S_LDT;
  float* sCB = (float*)(sXT + 128 * S_LDT);
  bfu* sH = (bfu*)(sCB + 64 * S_LDCB);
  float* sAc = (float*)(sH + 8 * 16 * S_LDB);
  float* sDt = sAc + 512;
  float* sW = sDt + 512;
  float* sSq = sW + 512;
  bfu* sZ = (bfu*)(sSq + 512);
  float* sWc = (float*)(sZ + 64 * S_LDB);
  const int tid = opaque_tid(wv), w = wv, lane = tid & 63, fr = lane & 15, fq = lane >> 4;
  const int hl = w >> 2, ps = w & 3;
  const bfu* zx = (const bfu*)(P->ws + WS_BIG);
  const float* dtb = (const float*)(P->ws + WS_DT);
  float* ssqp = (float*)(P->ws + WS_SSQ);
  bfu* yg = (bfu*)(P->out + O_KP);
  const float* convw = P->in[10];
  const float* convb = P->in[11];
  bfu* myH = sH + w * 16 * S_LDB;
  float* myAc = sAc + w * 64;
  float* myDt = sDt + w * 64;
  float* myW = sW + w * 64;
  float* mySq = sSq + w * 64;
  const bool conv_role = w < 6;

  for (int unit = blockIdx.x; unit < 384; unit += gridDim.x) {
    int seq, g, hp, row0, nch;
    const float* hist = nullptr;
    const float* h0 = nullptr;
    float* hT;
    if (unit < 256) {
      seq = unit >> 4; g = (unit >> 2) & 3; hp = unit & 3;
      row0 = seq * 4096; nch = 64;
      hT = P->out + O_SSMP + (size_t)seq * 32 * 8192;
    } else {
      int u = unit - 256;
      seq = u >> 4; g = (u >> 2) & 3; hp = u & 3;
      row0 = MP + seq * 64; nch = 1;
      hist = P->in[2] + (size_t)seq * 3 * CONVD;
      h0 = P->in[3] + (size_t)seq * 32 * 8192;
      hT = P->out + O_SSMS + (size_t)seq * 32 * 8192;
    }
    const int head = g * 8 + hp * 2 + hl;
    const float A_h = -__expf(P->in[13][head]);
    const float D_h = P->in[14][head];
    f32x4 hacc[8];
    if (h0) {
#pragma unroll
      for (int nt = 0; nt < 8; ++nt)
#pragma unroll
        for (int j = 0; j < 4; ++j) hacc[nt][j] = h0[((size_t)head * 64 + ps * 16 + fq * 4 + j) * 128 + nt * 16 + fr];
    } else {
#pragma unroll
      for (int nt = 0; nt < 8; ++nt) hacc[nt] = f32x4{0.f, 0.f, 0.f, 0.f};
    }
    __syncthreads();
#pragma unroll
    for (int nt = 0; nt < 8; ++nt)
#pragma unroll
      for (int j = 0; j < 4; ++j) myH[(fq * 4 + j) * S_LDB + nt * 16 + fr] = f2bf(hacc[nt][j]);
    const int cgp = tid % 48, rs = tid / 48;
    int cc;
    if (cgp < 16) cc = (g * 8 + hp * 2) * 64 + cgp * 8;
    else if (cgp < 32) cc = DI + g * 128 + (cgp - 16) * 8;
    else cc = DI + 512 + g * 128 + (cgp - 32) * 8;
    if (tid < 384) {
      if (rs < 5) {
        const float* src = (rs < 4) ? convw + rs * CONVD + cc : convb + cc;
        f32x4 a = *(const f32x4*)src, bq = *(const f32x4*)(src + 4);
        *(f32x4*)(sWc + rs * 384 + cgp * 8) = a;
        *(f32x4*)(sWc + rs * 384 + cgp * 8 + 4) = bq;
      }
    }
    const int zt = tid - 384;
    const int zrow = (zt >> 1) & 63, zhalf = zt & 1;

    u32x4 pre[11];
    float dtv;
    {
      const int r0 = row0;
      if (conv_role) {
        const bfu* zxc = zx + ((size_t)r0 - 3) * ZXW + DI;
#pragma unroll
        for (int k = 0; k < 11; ++k) {
          int rr = rs * 8 - 3 + k;
          if (rr < 0) {
            if (hist) {
              f32x4 a = *(const f32x4*)(hist + (3 + rr) * CONVD + cc), bq = *(const f32x4*)(hist + (3 + rr) * CONVD + cc + 4);
              pre[k] = u32x4{pack2(a[0], a[1]), pack2(a[2], a[3]), pack2(bq[0], bq[1]), pack2(bq[2], bq[3])};
            } else {
              pre[k] = u32x4{0u, 0u, 0u, 0u};
            }
          } else {
            pre[k] = *(const u32x4*)(zxc + (unsigned)((rs * 8 + k) * ZXW + cc));
          }
        }
      } else {
        const bfu* zsrc = zx + (size_t)(r0 + zrow) * ZXW + (g * 8 + hp * 2) * 64 + zhalf * 64;
#pragma unroll
        for (int k = 0; k < 8; ++k) pre[k] = *(const u32x4*)(zsrc + k * 8);
#pragma unroll
        for (int k = 8; k < 11; ++k) pre[k] = u32x4{0u, 0u, 0u, 0u};
      }
      dtv = dtb[(size_t)(r0 + lane) * 32 + head];
    }

    for (int c = 0; c < nch; ++c) {
      const int r0 = row0 + c * 64;
      lds_barrier();
      if (conv_role) {
        const float* wcol = sWc + cgp * 8;
        u32x4 ovr[8];
#pragma unroll
        for (int e2 = 0; e2 < 4; ++e2) {
          __builtin_amdgcn_sched_barrier(0);
          float w0[4], w1[4];
#pragma unroll
          for (int tap = 0; tap < 4; ++tap) { w0[tap] = wcol[tap * 384 + 2 * e2]; w1[tap] = wcol[tap * 384 + 2 * e2 + 1]; }
          const float bl = wcol[4 * 384 + 2 * e2], bh = wcol[4 * 384 + 2 * e2 + 1];
#pragma unroll
          for (int i = 0; i < 8; ++i) {
            float ylo = bl, yhi = bh;
#pragma unroll
            for (int tap = 0; tap < 4; ++tap) {
              unsigned rw = pre[i + tap][e2];
              ylo += w0[tap] * __uint_as_float(rw << 16);
              yhi += w1[tap] * __uint_as_float(rw & 0xffff0000u);
            }
            ovr[i][e2] = cvt_pk_bf16(silu_f(ylo), silu_f(yhi));
          }
        }
        if (cgp >= 16) {
          bfu* rowdst = (cgp < 32) ? (sB + (cgp - 16) * 8) : (sC + (cgp - 32) * 8);
#pragma unroll
          for (int i = 0; i < 8; ++i) *(u32x4*)(rowdst + (rs * 8 + i) * S_LDB) = ovr[i];
        }
        if (cgp < 32) {
          bfu* coldst = (cgp < 16) ? (sXT + (cgp * 8) * S_LDT + rs * 8) : (sBT + ((cgp - 16) * 8) * S_LDT + rs * 8);
#pragma unroll
          for (int e = 0; e < 8; ++e) {
            const int e2 = e >> 1, sh = (e & 1) * 16;
            u32x4 o;
            o[0] = ((ovr[0][e2] >> sh) & 0xffffu) | ((ovr[1][e2] >> sh) << 16);
            o[1] = ((ovr[2][e2] >> sh) & 0xffffu) | ((ovr[3][e2] >> sh) << 16);
            o[2] = ((ovr[4][e2] >> sh) & 0xffffu) | ((ovr[5][e2] >> sh) << 16);
            o[3] = ((ovr[6][e2] >> sh) & 0xffffu) | ((ovr[7][e2] >> sh) << 16);
            *(u32x4*)(coldst + e * S_LDT) = o;
          }
        }
      } else {
#pragma unroll
        for (int k = 0; k < 8; ++k) *(u32x4*)(sZ + zrow * S_LDB + zhalf * 64 + k * 8) = pre[k];
      }
      float a63;
      {
        float ac = dtv * A_h;
#pragma unroll
        for (int o = 1; o < 64; o <<= 1) {
          float t = shup(ac, o, lane);
          if (lane >= o) ac += t;
        }
        a63 = shidx(ac, 63);
        myAc[lane] = ac;
        myDt[lane] = dtv;
        myW[lane] = __expf(a63 - ac) * dtv;
      }
      lds_barrier();
      if (c + 1 < nch) {
        const int r1 = r0 + 64;
        int rsl = rs;
        asm volatile("" : "+v"(rsl));
        if (conv_role) {
          const bfu* zxc = zx + ((size_t)r1 - 3) * ZXW + DI;
#pragma unroll
          for (int k = 0; k < 11; ++k) pre[k] = *(const u32x4*)(zxc + (unsigned)((rsl * 8 + k) * ZXW + cc));
        } else {
          const bfu* zsrc = zx + (size_t)(r1 + zrow) * ZXW + (g * 8 + hp * 2) * 64 + zhalf * 64;
#pragma unroll
          for (int k = 0; k < 8; ++k) pre[k] = *(const u32x4*)(zsrc + k * 8);
        }
        dtv = dtb[(size_t)(r1 + lane) * 32 + head];
      }
      int frc = fr, fqc = fq;
      asm volatile("" : "+v"(frc), "+v"(fqc));
      {
        int it = w >> 1, jt0 = (w & 1) * 2;
        f32x4 cb0 = {0.f, 0.f, 0.f, 0.f}, cb1 = {0.f, 0.f, 0.f, 0.f};
#pragma unroll
        for (int ks = 0; ks < 4; ++ks) {
          bf16x8 a = lds_b128(sC + (it * 16 + frc) * S_LDB + ks * 32 + fqc * 8);
          bf16x8 b0 = lds_b128(sB + (jt0 * 16 + frc) * S_LDB + ks * 32 + fqc * 8);
          bf16x8 b1 = lds_b128(sB + ((jt0 + 1) * 16 + frc) * S_LDB + ks * 32 + fqc * 8);
          cb0 = mfma16(a, b0, cb0);
          cb1 = mfma16(a, b1, cb1);
        }
#pragma unroll
        for (int j = 0; j < 4; ++j) {
          sCB[(it * 16 + fqc * 4 + j) * S_LDCB + jt0 * 16 + frc] = cb0[j];
          sCB[(it * 16 + fqc * 4 + j) * S_LDCB + (jt0 + 1) * 16 + frc] = cb1[j];
        }
      }
      lds_barrier();
      const bfu* xrow = sXT + (hl * 64 + ps * 16 + frc) * S_LDT;
#pragma unroll 1
      for (int it = 0; it < 4; ++it) {
        f32x4 yacc = {0.f, 0.f, 0.f, 0.f}, oacc = {0.f, 0.f, 0.f, 0.f};
        const int i = it * 16 + frc;
        const float ac_i = myAc[i];
#pragma unroll
        for (int ks = 0; ks < 2; ++ks) {
          if (ks * 32 <= it * 16 + 15) {
            const int j0 = ks * 32 + fqc * 8;
            f32x4 c0 = *(const f32x4*)(sCB + i * S_LDCB + j0), c1 = *(const f32x4*)(sCB + i * S_LDCB + j0 + 4);
            f32x4 a0 = *(const f32x4*)(myAc + j0), a1 = *(const f32x4*)(myAc + j0 + 4);
            f32x4 d0 = *(const f32x4*)(myDt + j0), d1 = *(const f32x4*)(myDt + j0 + 4);
            float g0[4], g1[4];
#pragma unroll
            for (int e = 0; e < 4; ++e) {
              g0[e] = (j0 + e <= i) ? c0[e] * __expf(ac_i - a0[e]) * d0[e] : 0.f;
              g1[e] = (j0 + 4 + e <= i) ? c1[e] * __expf(ac_i - a1[e]) * d1[e] : 0.f;
            }
            u32x4 pk;
            pk[0] = cvt_pk_bf16(g0[0], g0[1]); pk[1] = cvt_pk_bf16(g0[2], g0[3]);
            pk[2] = cvt_pk_bf16(g1[0], g1[1]); pk[3] = cvt_pk_bf16(g1[2], g1[3]);
            bf16x8 bfv = lds_b128(xrow + j0);
            yacc = mfma16(__builtin_bit_cast(bf16x8, pk), bfv, yacc);
          }
        }
#pragma unroll
        for (int ks = 0; ks < 4; ++ks) {
          bf16x8 a = lds_b128(sC + (it * 16 + frc) * S_LDB + ks * 32 + fqc * 8);
          bf16x8 b = lds_b128(myH + frc * S_LDB + ks * 32 + fqc * 8);
          oacc = mfma16(a, b, oacc);
        }
#pragma unroll
        for (int j = 0; j < 4; ++j) {
          int ii = it * 16 + fqc * 4 + j;
          float xv = bf2f(xrow[ii]);
          float y = yacc[j] + __expf(myAc[ii]) * oacc[j] + D_h * xv;
          float zv = bf2f(sZ[ii * S_LDB + hl * 64 + ps * 16 + frc]);
          float ygv = y * silu_f(zv);
          yg[(size_t)(r0 + ii) * DI + head * 64 + ps * 16 + frc] = f2bf(ygv);
          float sq = ygv * ygv;
          sq = row16_sum(sq);
          if (frc == 0) mySq[ii] = sq;
        }
      }
      {
        const float dec = __expf(a63);
#pragma unroll
        for (int nt = 0; nt < 8; ++nt) hacc[nt] *= dec;
#pragma unroll
        for (int ks = 0; ks < 2; ++ks) {
          const int j0 = ks * 32 + fqc * 8;
          bf16x8 xr = lds_b128(xrow + j0);
          f32x4 w0 = *(const f32x4*)(myW + j0), w1 = *(const f32x4*)(myW + j0 + 4);
          u32x4 xu = __builtin_bit_cast(u32x4, xr);
          u32x4 pk;
          pk[0] = cvt_pk_bf16(__uint_as_float(xu[0] << 16) * w0[0], __uint_as_float(xu[0] & 0xffff0000u) * w0[1]);
          pk[1] = cvt_pk_bf16(__uint_as_float(xu[1] << 16) * w0[2], __uint_as_float(xu[1] & 0xffff0000u) * w0[3]);
          pk[2] = cvt_pk_bf16(__uint_as_float(xu[2] << 16) * w1[0], __uint_as_float(xu[2] & 0xffff0000u) * w1[1]);
          pk[3] = cvt_pk_bf16(__uint_as_float(xu[3] << 16) * w1[2], __uint_as_float(xu[3] & 0xffff0000u) * w1[3]);
          bf16x8 af = __builtin_bit_cast(bf16x8, pk);
#pragma unroll
          for (int nt = 0; nt < 8; ++nt) {
            bf16x8 b = lds_b128(sBT + (nt * 16 + frc) * S_LDT + j0);
            hacc[nt] = mfma16(af, b, hacc[nt]);
          }
        }
#pragma unroll
        for (int nt = 0; nt < 8; ++nt)
#pragma unroll
          for (int j = 0; j < 4; ++j) myH[(fqc * 4 + j) * S_LDB + nt * 16 + frc] = f2bf(hacc[nt][j]);
      }
      lds_barrier();
      if (tid < 64) {
        float sm = 0.f;
#pragma unroll
        for (int ww = 0; ww < 8; ++ww) sm += sSq[ww * 64 + tid];
        ssqp[(size_t)(r0 + tid) * 16 + g * 4 + hp] = sm;
      }
    }
#pragma unroll
    for (int nt = 0; nt < 8; ++nt)
#pragma unroll
      for (int j = 0; j < 4; ++j) hT[((size_t)head * 64 + ps * 16 + fq * 4 + j) * 128 + nt * 16 + fr] = hacc[nt][j];
  }
}

constexpr int A_STAGE = 32768;
constexpr int A_LDO = 132;
__device__ __forceinline__ int kswz(int key) { return ((key >> 1) & 1) | (((key >> 3) & 3) << 1); }
__device__ __forceinline__ void phase_attn(KP P, char* smem, const int wv) {
  LAS unsigned char* lds = (LAS unsigned char*)smem;
  float* sO = (float*)smem;
  const int tid = opaque_tid(wv), w = wv, lane = tid & 63, fr = lane & 15, fq = lane >> 4;
  const int cm = w >> 2, rg = w & 3;
  const bfu* qb = (const bfu*)(P->ws + WS_Q);
  bfu* ao = (bfu*)(P->ws + WS_AO);
  float lam;
  {
    float a = P->in[18][lane] * P->in[19][lane];
    float b = P->in[20][lane] * P->in[21][lane];
    a = wave_sum(a, lane); b = wave_sum(b, lane);
    lam = __expf(a) - __expf(b) + LAMBDA_INIT;
  }
  const float* subln = P->in[22];
  unsigned ksrc[2], vsrc_row[2], vsrc_col[2];
#pragma unroll
  for (int i = 0; i < 2; ++i) {
    int p = (2 * w + i) * 64 + lane;
    int row = p >> 3, phys = p & 7;
    int map = row >> 6, key = row & 63;
    ksrc[i] = (unsigned)(key * 1024 + map * 64 + ((phys ^ kswz(key)) << 3));
    vsrc_row[i] = (unsigned)row;
    vsrc_col[i] = (unsigned)((phys ^ (row & 7)) << 3);
  }
  unsigned koff[4];
#pragma unroll
  for (int t4 = 0; t4 < 4; ++t4) {
    int key = (t4 >> 1) * 32 + (fr >> 2) * 8 + (t4 & 1) * 4 + (fr & 3);
    koff[t4] = (unsigned)((cm * 64 + key) * 128 + ((fq ^ kswz(key)) << 4));
  }
  const unsigned voff0 = 16384u + (unsigned)(fr * 128 + ((fq ^ (fr & 7)) << 4));
  const unsigned kb0 = koff[0], kb1 = koff[0] ^ 64u, vb0 = voff0, vb1 = voff0 ^ 64u;

  const int G = gridDim.x;
  const bool xcd_order = (G == 256);
  const int nrounds = xcd_order ? 17 : (4096 + 64 + G - 1) / G;
  for (int r = 0; r < nrounds; ++r) {
    int b, h, pc;
    bool sample = false;
    if (xcd_order) {
      int x = blockIdx.x & 7, j = blockIdx.x >> 3;
      if (r < 16) { int bh = r * 8 + x; b = bh >> 3; h = bh & 7; pc = (r & 1) ? 31 - j : j; }
      else { if (j >= 8) break; int sidx = x * 8 + j; b = sidx >> 3; h = sidx & 7; pc = 0; sample = true; }
    } else {
      int u = blockIdx.x + r * G;
      if (u >= 4096 + 64) break;
      if (u < 4096) { pc = 31 - (u >> 7); int bh = u & 127; b = bh >> 3; h = bh & 7; }
      else { int sidx = u - 4096; b = sidx >> 3; h = sidx & 7; pc = 0; sample = true; }
    }
    int qrow0, nkt, Tstr;
    const bfu* kbase;
    const bfu* vtbase;
    if (!sample) {
      qrow0 = b * 4096 + pc * 128;
      nkt = 2 * pc + 2;
      Tstr = 4096;
      kbase = (const bfu*)(P->ws + WS_KP) + (size_t)b * 4096 * 1024 + h * 128;
      vtbase = (const bfu*)(P->ws + WS_VTP) + (size_t)(b * 8 + h) * 128 * 4096;
    } else {
      qrow0 = MP + b * 64;
      nkt = 17;
      Tstr = SKV;
      kbase = (const bfu*)(P->ws + WS_KSM) + (size_t)b * SKV * 1024 + h * 128;
      vtbase = (const bfu*)(P->ws + WS_VTS) + (size_t)(b * 8 + h) * 128 * SKV;
    }
    const bool wave_valid = !sample || rg < 2;
    const int my_nkt = sample ? nkt : (rg < 2 ? nkt - 1 : nkt);
    bf16x8 qf[2][2];
    {
      const int qr = wave_valid ? (qrow0 + rg * 32 + fr) : qrow0;
      const bfu* qp = qb + (size_t)qr * 1024 + h * 128 + cm * 64 + fq * 8;
#pragma unroll
      for (int qt = 0; qt < 2; ++qt) {
        qf[qt][0] = *(const bf16x8*)(qp + (wave_valid ? qt * 16 * 1024 : 0));
        qf[qt][1] = *(const bf16x8*)(qp + (wave_valid ? qt * 16 * 1024 : 0) + 32);
      }
    }
    float mrun[2] = {-INFINITY, -INFINITY}, lrun[2] = {0.f, 0.f};
    f32x4 oacc[2][8];
#pragma unroll
    for (int qt = 0; qt < 2; ++qt)
#pragma unroll
      for (int et = 0; et < 8; ++et) oacc[qt][et] = f32x4{0.f, 0.f, 0.f, 0.f};

#define ATT_STAGE(stage, kt_) do { \
      const bfu* kt_base = kbase + (size_t)(kt_) * 64 * 1024; \
      const bfu* vt_base = vtbase + (size_t)(kt_) * 64; \
      _Pragma("unroll") for (int _i = 0; _i < 2; ++_i) \
        __builtin_amdgcn_global_load_lds((const unsigned*)(kt_base + ksrc[_i]), (LAS unsigned*)(lds + (stage) * A_STAGE + (2 * w + _i) * 1024), 16, 0, 0); \
      _Pragma("unroll") for (int _i = 0; _i < 2; ++_i) \
        __builtin_amdgcn_global_load_lds((const unsigned*)(vt_base + (size_t)vsrc_row[_i] * Tstr + vsrc_col[_i]), (LAS unsigned*)(lds + (stage) * A_STAGE + 16384 + (2 * w + _i) * 1024), 16, 0, 0); \
    } while (0)

#define ATT_S_SOFTMAX(stage_) do { \
      LAS unsigned char* sb = lds + (stage_) * A_STAGE; \
      f32x4 st[2][4]; \
      _Pragma("unroll") for (int t4 = 0; t4 < 4; ++t4) { \
        bf16x8 a0 = *(const LAS bf16x8*)(sb + kb0 + (t4 >> 1) * 4096 + (t4 & 1) * 512); \
        bf16x8 a1 = *(const LAS bf16x8*)(sb + kb1 + (t4 >> 1) * 4096 + (t4 & 1) * 512); \
        _Pragma("unroll") for (int qt = 0; qt < 2; ++qt) { \
          f32x4 z = {0.f, 0.f, 0.f, 0.f}; \
          z = mfma16(a0, qf[qt][0], z); \
          st[qt][t4] = mfma16(a1, qf[qt][1], z); \
        } \
      } \
      _Pragma("unroll") for (int qt = 0; qt < 2; ++qt) { \
        float mx = st[qt][0][0]; \
        _Pragma("unroll") for (int t4 = 0; t4 < 4; ++t4) \
          _Pragma("unroll") for (int j = 0; j < 4; ++j) mx = fmaxf(mx, st[qt][t4][j]); \
        mx = xmax_16_32(mx); \
          \
        if (__builtin_amdgcn_ballot_w64(mx - mrun[qt] > 8.f) != 0ull) { \
          const float mnew = fmaxf(mrun[qt], mx); \
          const float alpha = __builtin_amdgcn_exp2f(mrun[qt] - mnew); \
          lrun[qt] *= alpha; \
          mrun[qt] = mnew; \
          _Pragma("unroll") for (int et = 0; et < 8; ++et) oacc[qt][et] *= alpha; \
        } \
        const f32x2 m2 = {mrun[qt], mrun[qt]}; \
        f32x2 ls2 = {0.f, 0.f}; \
        _Pragma("unroll") for (int t4 = 0; t4 < 4; ++t4) { \
          f32x2 lo = f32x2{st[qt][t4][0], st[qt][t4][1]} - m2, hi = f32x2{st[qt][t4][2], st[qt][t4][3]} - m2; \
          lo[0] = __builtin_amdgcn_exp2f(lo[0]); lo[1] = __builtin_amdgcn_exp2f(lo[1]); \
          hi[0] = __builtin_amdgcn_exp2f(hi[0]); hi[1] = __builtin_amdgcn_exp2f(hi[1]); \
          ls2 += lo; ls2 += hi; \
          st[qt][t4] = f32x4{lo[0], lo[1], hi[0], hi[1]}; \
        } \
        lrun[qt] += ls2[0] + ls2[1]; \
        _Pragma("unroll") for (int kk = 0; kk < 2; ++kk) { \
          u32x4 pk; \
          pk[0] = cvt_pk_bf16(st[qt][2 * kk][0], st[qt][2 * kk][1]); \
          pk[1] = cvt_pk_bf16(st[qt][2 * kk][2], st[qt][2 * kk][3]); \
          pk[2] = cvt_pk_bf16(st[qt][2 * kk + 1][0], st[qt][2 * kk + 1][1]); \
          pk[3] = cvt_pk_bf16(st[qt][2 * kk + 1][2], st[qt][2 * kk + 1][3]); \
          pb[qt][kk] = __builtin_bit_cast(bf16x8, pk); \
        } \
      } \
    } while (0)
#define ATT_PV(stage_) do { \
      LAS unsigned char* sb = lds + (stage_) * A_STAGE; \
      __builtin_amdgcn_s_setprio(1); \
      _Pragma("unroll") for (int kk = 0; kk < 2; ++kk) \
        _Pragma("unroll") for (int et = 0; et < 8; ++et) { \
          bf16x8 a = *(const LAS bf16x8*)(sb + (kk ? vb1 : vb0) + et * 2048); \
          oacc[0][et] = mfma16(a, pb[0][kk], oacc[0][et]); \
          oacc[1][et] = mfma16(a, pb[1][kk], oacc[1][et]); \
        } \
      __builtin_amdgcn_s_setprio(0); \
    } while (0)

    __syncthreads();
    ATT_STAGE(0, 0);
    if (nkt > 1) ATT_STAGE(1, 1);
    if (nkt > 1) asm volatile("s_waitcnt vmcnt(4)" ::: "memory");
    else asm volatile("s_waitcnt vmcnt(0)" ::: "memory");
    if (cm == 1) lds_barrier();
    bf16x8 pb[2][2];
#pragma unroll 1
    for (int kt = 0; kt < nkt; ++kt) {
      const bool act = wave_valid && kt < my_nkt;
      lds_barrier();
      if (kt + 2 < nkt) ATT_STAGE((kt + 2) & 3, kt + 2);
      if (act) ATT_S_SOFTMAX(kt & 3);
      if (kt + 1 < nkt) {
        if (kt + 2 < nkt) asm volatile("s_waitcnt vmcnt(4)" ::: "memory");
        else asm volatile("s_waitcnt vmcnt(0)" ::: "memory");
      }
      lds_barrier();
      if (act) ATT_PV(kt & 3);
    }
    if (cm == 0) lds_barrier();
#undef ATT_S_SOFTMAX
#undef ATT_PV
#undef ATT_STAGE
    lrun[0] = xsum_16_32(lrun[0]);
    lrun[1] = xsum_16_32(lrun[1]);
    __syncthreads();
    if (cm == 1 && wave_valid) {
#pragma unroll
      for (int qt = 0; qt < 2; ++qt) {
        float rl = 1.f / lrun[qt];
#pragma unroll
        for (int et = 0; et < 8; ++et) *(f32x4*)(sO + (rg * 32 + qt * 16 + fr) * A_LDO + et * 16 + fq * 4) = oacc[qt][et] * rl;
      }
    }
    __syncthreads();
    if (cm == 0 && wave_valid) {
#pragma unroll
      for (int qt = 0; qt < 2; ++qt) {
        float rl = 1.f / lrun[qt];
        float ss = 0.f;
#pragma unroll
        for (int et = 0; et < 8; ++et) {
          f32x4 o1 = *(const f32x4*)(sO + (rg * 32 + qt * 16 + fr) * A_LDO + et * 16 + fq * 4);
          f32x4 o = oacc[qt][et] * rl - o1 * lam;
          oacc[qt][et] = o;
          ss += o[0] * o[0] + o[1] * o[1] + o[2] * o[2] + o[3] * o[3];
        }
        ss = xsum_16_32(ss);
        float rstd = rsqrtf(ss * (1.f / 128.f) + EPS) * (1.f - LAMBDA_INIT);
        bfu* dst = ao + (size_t)(qrow0 + rg * 32 + qt * 16 + fr) * 1024 + h * 128;
        int fqe = fq;
        asm volatile("" : "+v"(fqe));
#pragma unroll
        for (int et = 0; et < 8; ++et) {
          int e0 = et * 16 + fqe * 4;
          f32x4 sw = *(const f32x4*)(subln + e0);
          uint2 pk;
          pk.x = cvt_pk_bf16(oacc[qt][et][0] * rstd * sw[0], oacc[qt][et][1] * rstd * sw[1]);
          pk.y = cvt_pk_bf16(oacc[qt][et][2] * rstd * sw[2], oacc[qt][et][3] * rstd * sw[3]);
          *(uint2*)(dst + e0) = pk;
        }
      }
    }
  }
}

#define XB_TMO      128
#define XB_XCNT(j)  (256  + 64 * (j))
#define XB_XSUB(j)  (1280 + 64 * (j))
#define XB_XGEN(j)  (2304 + 64 * (j))
#define XB_TOP      3328
#define XB_TOPGEN   3392
#define XCD_BAR_WORDS 3456
#define XB_SPIN_CAP (1u << 22)
__device__ __forceinline__ unsigned xb_ld(unsigned* p)              { return __hip_atomic_load(p, __ATOMIC_RELAXED, __HIP_MEMORY_SCOPE_AGENT); }
__device__ __forceinline__ unsigned xb_add(unsigned* p, unsigned v) { return __hip_atomic_fetch_add(p, v, __ATOMIC_RELAXED, __HIP_MEMORY_SCOPE_AGENT); }
__device__ __forceinline__ unsigned xb_xcc_id() { return (unsigned)__builtin_amdgcn_s_getreg((3 << 11) | 20) & 0xFu; }
#define XB_SPIN(cond, bar) do { unsigned _sp = 0; while (cond) { __builtin_amdgcn_s_sleep(1); \
    if ((++_sp & 255u) == 0u) { if (xb_ld(&(bar)[XB_TMO])) break; if (_sp > XB_SPIN_CAP) { atomicAdd(&(bar)[XB_TMO], 1u); break; } } } } while (0)
__device__ __forceinline__ void xcd_barrier_complete(unsigned* bar, unsigned x, unsigned& nloc, unsigned& nx) {
  const unsigned G = gridDim.x;
  unsigned sum, cnt, mine, sp = 0u;
  for (;;) {
    sum = 0u; cnt = 0u; mine = 0u;
#pragma unroll
    for (unsigned j = 0; j < 16; ++j) { const unsigned c = xb_ld(&bar[XB_XCNT(j)]); sum += c; cnt += (c > 0u) ? 1u : 0u; mine = (j == x) ? c : mine; }
    if (sum == G) break;
    __builtin_amdgcn_s_sleep(1);
    if ((++sp & 255u) == 0u) { if (xb_ld(&bar[XB_TMO])) break; if (sp > XB_SPIN_CAP) { atomicAdd(&bar[XB_TMO], 1u); break; } }
  }
  nloc = mine > 0u ? mine : 1u; nx = cnt > 0u ? cnt : 1u;
}
__device__ __forceinline__ void xcd_barrier(unsigned* bar, volatile __attribute__((address_space(3))) unsigned* st, const int tid) {
  asm volatile("s_waitcnt vmcnt(0)" ::: "memory");
  __syncthreads();
  if (tid == 0) {
    const unsigned x = xb_xcc_id();
    __builtin_amdgcn_s_waitcnt(0);
    unsigned nloc = st[0], nx = st[1];
    if (nloc == 0u) { xcd_barrier_complete(bar, x, nloc, nx); st[0] = nloc; st[1] = nx; }
    const unsigned old = xb_add(&bar[XB_XSUB(x)], 1u);
    const unsigned gen = old / nloc;
    if (old + 1u == (gen + 1u) * nloc) {
      __builtin_amdgcn_fence(__ATOMIC_RELEASE, "agent");
      asm volatile("s_waitcnt vmcnt(0)" ::: "memory");
      const unsigned og = xb_add(&bar[XB_TOP], 1u);
      const unsigned tg = og / nx;
      if (og + 1u == (tg + 1u) * nx) xb_add(&bar[XB_TOPGEN], 1u);
      else XB_SPIN(xb_ld(&bar[XB_TOPGEN]) == tg, bar);
      __builtin_amdgcn_fence(__ATOMIC_ACQUIRE, "agent");
      xb_add(&bar[XB_XGEN(x)], 1u);
      asm volatile("s_waitcnt vmcnt(0)" ::: "memory");
    } else {
      XB_SPIN(xb_ld(&bar[XB_XGEN(x)]) == gen, bar);
      __builtin_amdgcn_fence(__ATOMIC_ACQUIRE, "agent");
      asm volatile("s_waitcnt vmcnt(0)" ::: "memory");
    }
  }
  __syncthreads();
}

__global__ void __launch_bounds__(512) fwd_kernel(Params Pk) {
  extern __shared__ __attribute__((aligned(16))) char smem_base[];
  const int wv = __builtin_amdgcn_readfirstlane((int)(threadIdx.x >> 6));
  volatile __attribute__((address_space(3))) unsigned* xst = (volatile __attribute__((address_space(3))) unsigned*)(smem_base + LDS_BYTES - 16);
  if (threadIdx.x == 0) {
    xst[0] = 0u; xst[1] = 0u;
    (void)xb_add(&((unsigned*)(Pk.ws + WS_BAR))[XB_XCNT(xb_xcc_id())], 1u);
  }
  __syncthreads();
  for (int ph = Pk.ph_lo; ph < Pk.ph_hi; ++ph) {
    int zoff = 0;
    asm volatile("" : "+s"(zoff));
    char* smem = smem_base + zoff;
    KP P = (KP)__builtin_amdgcn_kernarg_segment_ptr();
    asm volatile("" : "+s"(P));
#ifdef PROBE_DUP
    for (int rep = 0; rep < (((PROBE_DUP >> ph) & 1) ? 2 : 1); ++rep)
#endif
    switch (ph) {
      case 0: case 4: case 7: case 11: {
        const float* w = ph == 0 ? P->in[6] : (ph == 4 ? P->in[7] : (ph == 7 ? P->in[6] + D : P->in[7] + D));
        if (ph == 0) phase_norm<false, false>(P->in[0], P->in[1], nullptr, w, (bfu*)(P->ws + WS_XN), nullptr, wv);
        else phase_norm<false, true>(nullptr, nullptr, (const bfu*)(P->ws + WS_XR), w, (bfu*)(P->ws + WS_XN), nullptr, wv);
        if (ph == 0) phase_convert_weights(P, smem, wv);
        if (ph == 7) phase_convert_cache(P, smem, wv);
      } break;
      case 1: gemm_phase<EPI_INPROJ>(P, (const bfu*)(P->ws + WS_XN), (const bfu*)(P->ws + WS_W_INP), 1024, INP_NP / 256, smem, wv); break;
      case 2: phase_ssd(P, smem, wv); break;
      case 3: gemm_phase<EPI_OUTPROJ>(P, (const bfu*)(P->out + O_KP), (const bfu*)(P->ws + WS_W_OUTP), 2048, 4, smem, wv); break;
      case 5: case 12:
        gemm_phase<EPI_GU>(P, (const bfu*)(P->ws + WS_XN), (const bfu*)(P->ws + (ph == 5 ? WS_W_GU0 : WS_W_GU1)), 1024, 22, smem, wv);
        break;
      case 6: case 10: case 13: {
        const bfu* A = (const bfu*)(P->ws + (ph == 10 ? WS_AO : WS_BIG));
        const bfu* Bt = (const bfu*)(P->ws + (ph == 6 ? WS_W_DN0 : (ph == 10 ? WS_W_AO : WS_W_DN1)));
        gemm_phase<EPI_RES>(P, A, Bt, ph == 10 ? 1024 : DFF, 4, smem, wv);
      } break;
      case 8: gemm_phase<EPI_QKV>(P, (const bfu*)(P->ws + WS_XN), (const bfu*)(P->ws + WS_W_QKV), 1024, 12, smem, wv); break;
      case 9: phase_attn(P, smem, wv); break;
      case 14: phase_norm<true, true>(nullptr, nullptr, (const bfu*)(P->ws + WS_XR), P->in[8], nullptr, P->out, wv); break;
    }
    if (ph + 1 < Pk.ph_hi) {
      if (ph == Pk.ph_lo) cg::this_grid().sync();
      else xcd_barrier((unsigned*)(P->ws + WS_BAR), xst, opaque_tid(wv));
    }
  }
}

extern "C" void kernel_launch(void* const* d_in, const int* in_sizes, int n_in, void* d_out, int out_size, void* d_ws, size_t ws_size,
                              hipStream_t stream) {
  static int grid = 0;
  if (grid == 0) {
    if (n_in != 27 || ws_size < WS_END || out_size != 209412096) {
      fprintf(stderr, "kernel_launch: unexpected sizes n_in=%d ws=%zu (need %zu) out=%d\n", n_in, ws_size, (size_t)WS_END, out_size);
    }
    int dev = 0, cus = 0, per_cu = 0;
    (void)hipGetDevice(&dev);
    (void)hipDeviceGetAttribute(&cus, hipDeviceAttributeMultiprocessorCount, dev);
    (void)hipFuncSetAttribute((const void*)fwd_kernel, hipFuncAttributeMaxDynamicSharedMemorySize, LDS_BYTES);
    (void)hipOccupancyMaxActiveBlocksPerMultiprocessor(&per_cu, (const void*)fwd_kernel, 512, LDS_BYTES);
    if (per_cu < 1) { fprintf(stderr, "kernel_launch: occupancy query returned %d\n", per_cu); per_cu = 1; }
    grid = cus * per_cu;
    fprintf(stderr, "kernel_launch: grid=%d (cus=%d per_cu=%d) ws=%zu need=%zu\n", grid, cus, per_cu, ws_size, (size_t)WS_END);
  }
  Params p{};
  for (int i = 0; i < 27; ++i) p.in[i] = (const float*)d_in[i];
  p.out = (float*)d_out;
  p.ws = (unsigned char*)d_ws;
#if COOP
  (void)hipMemsetAsync((char*)d_ws + WS_BAR, 0, 16384, stream);
  p.ph_lo = 0; p.ph_hi = NPH;
  void* args[] = {&p};
  hipError_t e = hipLaunchCooperativeKernel((const void*)fwd_kernel, dim3(grid), dim3(512), args, LDS_BYTES, stream);
  if (e != hipSuccess) fprintf(stderr, "cooperative launch failed: %s (grid %d)\n", hipGetErrorString(e), grid);
#else
  for (int ph = 0; ph < NPH; ++ph) {
    p.ph_lo = ph; p.ph_hi = ph + 1;
    hipLaunchKernelGGL(fwd_kernel, dim3(grid), dim3(512), LDS_BYTES, stream, p);
  }
#endif
}
```

```cpp
#include <hip/hip_runtime.h>
#include <hip/hip_cooperative_groups.h>
#include <cmath>
#include <cstdio>
namespace cg = cooperative_groups;

#ifndef COOP
#define COOP 1
#endif

typedef unsigned short bfu;
using bf16x8 = __attribute__((ext_vector_type(8))) short;
using f32x4 = __attribute__((ext_vector_type(4))) float;
using u32x4 = __attribute__((ext_vector_type(4))) unsigned;
using f32x2 = __attribute__((ext_vector_type(2))) float;

constexpr int D = 1024;
constexpr int MP = 65536;
constexpr int MS = 512;
constexpr int MT = MP + MS;
constexpr int DI = 2048;
constexpr int CONVD = 3072;
constexpr int ZXW = 5120;
constexpr int INP_N = 5152;
constexpr int INP_NP = 5376;
constexpr int DFF = 2816;
constexpr int SKV = 1088;
constexpr float EPS = 1e-6f;
constexpr float LAMBDA_INIT = 0.35550906759f;
constexpr float QSCALE = 0.125f * 1.4426950408889634f;

constexpr size_t O_Y = 0;
constexpr size_t O_CONVP = 67633152;
constexpr size_t O_SSMP = 67780608;
constexpr size_t O_KP = 71974912;
constexpr size_t O_VP = 139083776;
constexpr size_t O_CONVS = 206192640;
constexpr size_t O_SSMS = 206266368;
constexpr size_t O_KS = 208363520;
constexpr size_t O_VS = 208887808;

constexpr size_t WS_W_INP = 0;
constexpr size_t WS_W_OUTP = WS_W_INP + (size_t)INP_NP * 1024 * 2;
constexpr size_t WS_W_GU0 = WS_W_OUTP + (size_t)1024 * 2048 * 2;
constexpr size_t WS_W_DN0 = WS_W_GU0 + (size_t)5632 * 1024 * 2;
constexpr size_t WS_W_QKV = WS_W_DN0 + (size_t)1024 * 2816 * 2;
constexpr size_t WS_W_AO = WS_W_QKV + (size_t)3072 * 1024 * 2;
constexpr size_t WS_W_GU1 = WS_W_AO + (size_t)1024 * 1024 * 2;
constexpr size_t WS_W_DN1 = WS_W_GU1 + (size_t)5632 * 1024 * 2;
constexpr size_t WS_XN = WS_W_DN1 + (size_t)1024 * 2816 * 2;
constexpr size_t WS_DT = WS_XN + (size_t)MT * 1024 * 2;
constexpr size_t WS_SSQ = WS_DT + (size_t)MT * 32 * 4;
constexpr size_t WS_BIG = WS_SSQ + (size_t)MT * 16 * 4;
constexpr size_t WS_BAR = WS_BIG + (size_t)MT * ZXW * 2;
constexpr size_t WS_XR = WS_BAR + 16384;
constexpr size_t WS_END = WS_XR + (size_t)MT * 1024 * 2;
constexpr size_t WS_Q = WS_BIG;
constexpr size_t WS_KP = WS_Q + (size_t)MT * 1024 * 2;
constexpr size_t WS_VTP = WS_KP + (size_t)MP * 1024 * 2;
constexpr size_t WS_KSM = WS_VTP + (size_t)MP * 1024 * 2;
constexpr size_t WS_VTS = WS_KSM + (size_t)8 * SKV * 1024 * 2;
constexpr size_t WS_AO = WS_VTS + (size_t)8 * SKV * 1024 * 2;
static_assert(WS_AO + (size_t)MT * 1024 * 2 <= WS_BAR, "layer-1 aliases overflow");
static_assert((size_t)MT * DFF * 2 <= WS_KSM - WS_BIG, "ffn h overlaps sample K");

constexpr int LDS_BYTES = 159744;
constexpr int NPH = 15;

struct Params {
  const float* in[27];
  float* out;
  unsigned char* ws;
  int ph_lo, ph_hi;
};
typedef const __attribute__((address_space(4))) Params* KP;

__device__ __forceinline__ bfu f2bf(float f) {
  unsigned u = __float_as_uint(f);
  u += 0x7fffu + ((u >> 16) & 1u);
  return (bfu)(u >> 16);
}
__device__ __forceinline__ float bf2f(bfu h) { return __uint_as_float(((unsigned)h) << 16); }
__device__ __forceinline__ unsigned pack2(float a, float b) { return (unsigned)f2bf(a) | ((unsigned)f2bf(b) << 16); }
__device__ __forceinline__ unsigned cvt_pk_bf16(float lo, float hi) {
  unsigned r;
  asm volatile("v_cvt_pk_bf16_f32 %0, %1, %2" : "=v"(r) : "v"(lo), "v"(hi));
  return r;
}
__device__ __forceinline__ float silu_f(float x) { return x * __builtin_amdgcn_rcpf(1.f + __expf(-x)); }
__device__ __forceinline__ float shx(float v, int mask, int lane) {
  return __int_as_float(__builtin_amdgcn_ds_bpermute((lane ^ mask) << 2, __float_as_int(v)));
}
__device__ __forceinline__ float shup(float v, int d, int lane) {
  return __int_as_float(__builtin_amdgcn_ds_bpermute((lane - d) << 2, __float_as_int(v)));
}
__device__ __forceinline__ float shidx(float v, int src) {
  return __int_as_float(__builtin_amdgcn_ds_bpermute(src << 2, __float_as_int(v)));
}
__device__ __forceinline__ float wave_sum(float v, int lane) {
#pragma unroll
  for (int o = 32; o >= 1; o >>= 1) v += shx(v, o, lane);
  return v;
}
__device__ __forceinline__ f32x4 mfma16(bf16x8 a, bf16x8 b, f32x4 c) {
  return __builtin_amdgcn_mfma_f32_16x16x32_bf16(a, b, c, 0, 0, 0);
}
__device__ __forceinline__ int opaque_tid(int wv) {
  int lane;
  asm volatile("v_mbcnt_lo_u32_b32 %0, -1, 0\n\tv_mbcnt_hi_u32_b32 %0, -1, %0" : "=v"(lane));
  return wv * 64 + lane;
}
__device__ __forceinline__ float xmax_16_32(float v) {
  auto a = __builtin_amdgcn_permlane16_swap(__float_as_uint(v), __float_as_uint(v), false, false);
  v = fmaxf(__uint_as_float(a[0]), __uint_as_float(a[1]));
  auto b = __builtin_amdgcn_permlane32_swap(__float_as_uint(v), __float_as_uint(v), false, false);
  return fmaxf(__uint_as_float(b[0]), __uint_as_float(b[1]));
}
__device__ __forceinline__ float xsum_16_32(float v) {
  auto a = __builtin_amdgcn_permlane16_swap(__float_as_uint(v), __float_as_uint(v), false, false);
  v = __uint_as_float(a[0]) + __uint_as_float(a[1]);
  auto b = __builtin_amdgcn_permlane32_swap(__float_as_uint(v), __float_as_uint(v), false, false);
  return __uint_as_float(b[0]) + __uint_as_float(b[1]);
}
__device__ __forceinline__ float row16_sum(float v) {
  v += __int_as_float(__builtin_amdgcn_update_dpp(0, __float_as_int(v), 0xB1, 0xf, 0xf, true));
  v += __int_as_float(__builtin_amdgcn_update_dpp(0, __float_as_int(v), 0x4E, 0xf, 0xf, true));
  v += __int_as_float(__builtin_amdgcn_update_dpp(0, __float_as_int(v), 0x141, 0xf, 0xf, true));
  v += __int_as_float(__builtin_amdgcn_update_dpp(0, __float_as_int(v), 0x140, 0xf, 0xf, true));
  return v;
}
__device__ __forceinline__ f32x4 bf4_to_f32(uint2 u) {
  return f32x4{__uint_as_float(u.x << 16), __uint_as_float(u.x & 0xffff0000u), __uint_as_float(u.y << 16), __uint_as_float(u.y & 0xffff0000u)};
}
__device__ __forceinline__ void lds_barrier() {
  asm volatile("s_waitcnt lgkmcnt(0)" ::: "memory");
  __builtin_amdgcn_s_barrier();
  asm volatile("" ::: "memory");
}
__device__ __forceinline__ bf16x8 lds_b128(const bfu* p) { return *reinterpret_cast<const bf16x8*>(p); }

__device__ __forceinline__ void conv_tile(const float* __restrict__ src, const float* __restrict__ src2, const float* __restrict__ scale,
                                          bfu* __restrict__ dst, int Nsrc, int mode, int dstStride, int kt, int nt, float* sT, const int tid) {
  __syncthreads();
#pragma unroll
  for (int i = 0; i < 8; ++i) {
    int idx = tid + i * 512;
    int kk = idx >> 6, rr = idx & 63;
    int r = nt * 64 + rr;
    size_t k = (size_t)(kt * 64 + kk);
    float v = 0.f;
    if (mode == 0) {
      if (r < Nsrc) v = src[k * Nsrc + r];
    } else if (mode == 1) {
      int blk = r >> 5, w = r & 31;
      int sc = blk * 16 + (w & 15);
      v = (w < 16 ? src : src2)[k * Nsrc + sc];
    } else {
      int sc = r;
      if (r < 2048) {
        int pos = r & 63, pb = pos >> 4;
        int tb = (pb == 1) ? 2 : ((pb == 2) ? 1 : pb);
        sc = (r & ~63) + tb * 16 + (pos & 15);
      }
      v = src[k * Nsrc + sc];
    }
    sT[kk * 65 + rr] = v;
  }
  __syncthreads();
#pragma unroll
  for (int i = 0; i < 8; ++i) {
    int idx = tid + i * 512;
    int rr = idx >> 6, kk = idx & 63;
    float v = sT[kk * 65 + rr];
    if (scale) v *= scale[kt * 64 + kk];
    dst[(size_t)(nt * 64 + rr) * dstStride + kt * 64 + kk] = f2bf(v);
  }
}

__device__ __forceinline__ void phase_convert_weights(KP P, char* smem, const int wv) {
  float* sT = (float*)smem;
  const int tid = opaque_tid(wv);
  for (int t = blockIdx.x; t < 7104; t += gridDim.x) {
    const float *src, *src2 = nullptr, *scale = nullptr;
    bfu* dst;
    int K, Nsrc, mode = 0, lt;
    if (t < 1344) { lt = t; src = P->in[9]; dst = (bfu*)(P->ws + WS_W_INP); K = 1024; Nsrc = INP_N; }
    else if (t < 1856) { lt = t - 1344; src = P->in[16]; scale = P->in[15]; dst = (bfu*)(P->ws + WS_W_OUTP); K = 2048; Nsrc = 1024; }
    else if (t < 3264) { lt = t - 1856; src = P->in[24]; src2 = P->in[25]; dst = (bfu*)(P->ws + WS_W_GU0); K = 1024; Nsrc = DFF; mode = 1; }
    else if (t < 3968) { lt = t - 3264; src = P->in[26]; dst = (bfu*)(P->ws + WS_W_DN0); K = 2816; Nsrc = 1024; }
    else if (t < 4736) { lt = t - 3968; src = P->in[17]; dst = (bfu*)(P->ws + WS_W_QKV); K = 1024; Nsrc = 3072; mode = 2; }
    else if (t < 4992) { lt = t - 4736; src = P->in[23]; dst = (bfu*)(P->ws + WS_W_AO); K = 1024; Nsrc = 1024; }
    else if (t < 6400) { lt = t - 4992; src = P->in[24] + (size_t)1024 * DFF; src2 = P->in[25] + (size_t)1024 * DFF; dst = (bfu*)(P->ws + WS_W_GU1); K = 1024; Nsrc = DFF; mode = 1; }
    else { lt = t - 6400; src = P->in[26] + (size_t)DFF * 1024; dst = (bfu*)(P->ws + WS_W_DN1); K = 2816; Nsrc = 1024; }
    int nkt = K / 64;
    int kt = lt % nkt, nt = lt / nkt;
    conv_tile(src, src2, scale, dst, Nsrc, mode, K, kt, nt, sT, tid);
  }
}

__device__ __forceinline__ void phase_convert_cache(KP P, char* smem, const int wv) {
  float* sT = (float*)smem;
  const int tid = opaque_tid(wv);
  bfu* ks = (bfu*)(P->ws + WS_KSM);
  bfu* vts = (bfu*)(P->ws + WS_VTS);
  const float* ck = P->in[4];
  const float* cv = P->in[5];
  for (size_t i = (size_t)blockIdx.x * 512 + tid; i < (size_t)8 * 1024 * 256; i += (size_t)gridDim.x * 512) {
    size_t e = i * 4;
    int b = (int)(e >> 20);
    size_t rem = e & ((1u << 20) - 1);
    float4 v = *(const float4*)(ck + e);
    uint2 o; o.x = pack2(v.x, v.y); o.y = pack2(v.z, v.w);
    *(uint2*)(ks + (size_t)b * SKV * 1024 + rem) = o;
  }
  for (int t = blockIdx.x; t < 8 * 256; t += gridDim.x) {
    int b = t >> 8, lt = t & 255;
    int kt = lt & 15, nt = lt >> 4;
    conv_tile(cv + (size_t)b * 1024 * 1024, nullptr, nullptr, vts + (size_t)b * 1024 * SKV, 1024, 0, SKV, kt, nt, sT, tid);
  }
}

template <bool FINAL, bool SRCB>
__device__ __forceinline__ void phase_norm(const float* xa, const float* xb, const bfu* xr, const float* w, bfu* dst, float* fdst, const int wv) {
  const int tid_ = opaque_tid(wv);
  const int lane = tid_ & 63, wid = tid_ >> 6;
  f32x4 w4[4];
#pragma unroll
  for (int i = 0; i < 4; ++i) w4[i] = ((const f32x4*)w)[i * 64 + lane];
  for (int row = blockIdx.x * 8 + wid; row < MT / 2; row += gridDim.x * 8) {
    f32x4 v[2][4];
    float ss[2] = {0.f, 0.f};
#pragma unroll
    for (int h = 0; h < 2; ++h) {
      const int r = row + h * (MT / 2);
      if (SRCB) {
#pragma unroll
        for (int i = 0; i < 4; ++i) v[h][i] = bf4_to_f32(((const uint2*)(xr + (size_t)r * D))[i * 64 + lane]);
      } else {
        const float* x = r < MP ? xa + (size_t)r * D : xb + (size_t)(r - MP) * D;
#pragma unroll
        for (int i = 0; i < 4; ++i) v[h][i] = ((const f32x4*)x)[i * 64 + lane];
      }
    }
#pragma unroll
    for (int h = 0; h < 2; ++h) {
#pragma unroll
      for (int i = 0; i < 4; ++i) ss[h] += v[h][i][0] * v[h][i][0] + v[h][i][1] * v[h][i][1] + v[h][i][2] * v[h][i][2] + v[h][i][3] * v[h][i][3];
      ss[h] = wave_sum(ss[h], lane);
    }
#pragma unroll
    for (int h = 0; h < 2; ++h) {
      const int r = row + h * (MT / 2);
      const float rstd = rsqrtf(ss[h] * (1.f / D) + EPS);
#pragma unroll
      for (int i = 0; i < 4; ++i) {
        f32x4 o = v[h][i] * rstd * w4[i];
        if (FINAL) {
          ((f32x4*)(fdst + (size_t)r * D))[i * 64 + lane] = o;
        } else {
          uint2 pk; pk.x = cvt_pk_bf16(o[0], o[1]); pk.y = cvt_pk_bf16(o[2], o[3]);
          ((uint2*)(dst + (size_t)r * D))[i * 64 + lane] = pk;
        }
      }
    }
  }
}

enum { EPI_INPROJ = 0, EPI_OUTPROJ = 1, EPI_RES = 2, EPI_GU = 3, EPI_QKV = 4 };
#define LAS __attribute__((address_space(3)))
constexpr int HT_B = 128 * 64 * 2;
__device__ __forceinline__ int lds_byte(int r, int c) {
  int st = (r >> 4) * 2 + (c >> 5), rr = r & 15, cc = c & 31, ob = rr * 64 + cc * 2;
  return st * 1024 + (ob ^ (((ob >> 9) & 1) << 5));
}
__device__ __forceinline__ void stage_rc(int b, int& R, int& C) {
  int st = b / 1024, sb = b % 1024, swz = sb ^ (((sb >> 9) & 1) << 5);
  R = (st >> 1) * 16 + swz / 64;
  C = (st & 1) * 32 + (swz % 64) / 2;
}
__device__ __forceinline__ float softplus_f(float x) { return x > 20.f ? x : log1pf(__expf(x)); }

__device__ __forceinline__ float ssd_rstd(const float* __restrict__ ssq, int row) {
  const f32x4* p = (const f32x4*)(ssq + (size_t)row * 16);
  f32x4 a = p[0], b = p[1], c = p[2], d = p[3];
  float sm = (a[0] + a[1]) + (a[2] + a[3]) + (b[0] + b[1]) + (b[2] + b[3]) + (c[0] + c[1]) + (c[2] + c[3]) + (d[0] + d[1]) + (d[2] + d[3]);
  return rsqrtf(sm * (1.f / DI) + EPS);
}

template <int EPI>
__device__ __forceinline__ void gemm_acc_init(KP P, f32x4 (&acc)[2][2][4][2], int brow, int bcol, int wr, int wc, int fr_, int fq_, const float* sRu) {
  if (EPI == EPI_OUTPROJ || EPI == EPI_RES) {
    int fr = fr_, fq = fq_;
    asm volatile("" : "+v"(fr), "+v"(fq));
    const float* xin = (brow < MP ? P->in[0] + (size_t)brow * D : P->in[1] + (size_t)(brow - MP) * D) + bcol;
    const bfu* xrb = (const bfu*)(P->ws + WS_XR) + (size_t)brow * D + bcol;
#pragma unroll
    for (int ai = 0; ai < 2; ++ai)
#pragma unroll
      for (int m = 0; m < 4; ++m) {
        __builtin_amdgcn_sched_barrier(0);
        unsigned lr = ai * 128 + wr * 64 + m * 16 + fr;
        unsigned o = lr * D + wc * 32 + fq * 4;
        float sc = 1.f;
        if (EPI == EPI_OUTPROJ) sc = 1.f / sRu[lr];
#pragma unroll
        for (int bj = 0; bj < 2; ++bj)
#pragma unroll
          for (int n = 0; n < 2; ++n) {
            if (EPI == EPI_RES) acc[ai][bj][m][n] = bf4_to_f32(*(const uint2*)(xrb + o + bj * 128 + n * 16));
            else acc[ai][bj][m][n] = *(const f32x4*)(xin + o + bj * 128 + n * 16) * sc;
          }
      }
  } else {
#pragma unroll
    for (int ai = 0; ai < 2; ++ai)
#pragma unroll
      for (int bj = 0; bj < 2; ++bj)
#pragma unroll
        for (int m = 0; m < 4; ++m)
#pragma unroll
          for (int n = 0; n < 2; ++n) acc[ai][bj][m][n] = f32x4{0.f, 0.f, 0.f, 0.f};
  }
}

template <int EPI>
__device__ __forceinline__ void gemm_epilogue(KP P, f32x4 (&acc)[2][2][4][2], int brow, int bcol, int wr, int wc, int fr_, int fq_, const float* sRu) {
  int fr = fr_, fq = fq_;
  asm volatile("" : "+v"(fr), "+v"(fq));
  const unsigned lrow0 = wr * 64 + fr;
  const unsigned lcol0 = wc * 32 + fq * 4;
  if (EPI == EPI_INPROJ) {
    if (bcol < ZXW) {
      bfu* zxb = (bfu*)(P->ws + WS_BIG) + (size_t)brow * ZXW + bcol;
#pragma unroll
      for (int ai = 0; ai < 2; ++ai)
#pragma unroll
        for (int m = 0; m < 4; ++m) {
          __builtin_amdgcn_sched_barrier(0);
          unsigned o = (lrow0 + ai * 128 + m * 16) * ZXW + lcol0;
#pragma unroll
          for (int bj = 0; bj < 2; ++bj)
#pragma unroll
            for (int n = 0; n < 2; ++n) {
              f32x4 v = acc[ai][bj][m][n];
              uint2 pk; pk.x = cvt_pk_bf16(v[0], v[1]); pk.y = cvt_pk_bf16(v[2], v[3]);
              *(uint2*)(zxb + o + bj * 128 + n * 16) = pk;
            }
        }
      const bool has_tail = (brow >= MP) || (((brow + 256) & 4095) == 0);
      if (has_tail && bcol >= DI) {
#pragma unroll
        for (int ai = 0; ai < 2; ++ai)
#pragma unroll
          for (int m = 0; m < 4; ++m) {
            __builtin_amdgcn_sched_barrier(0);
            int row = brow + lrow0 + ai * 128 + m * 16;
            float* dst = nullptr;
            if (row < MP) {
              int t = row & 4095;
              if (t >= 4093) dst = P->out + O_CONVP + ((size_t)(row >> 12) * 3 + (t - 4093)) * CONVD;
            } else {
              int rs = row - MP, t = rs & 63;
              if (t >= 61) dst = P->out + O_CONVS + ((size_t)(rs >> 6) * 3 + (t - 61)) * CONVD;
            }
            if (dst) {
              unsigned o = bcol - DI + lcol0;
#pragma unroll
              for (int bj = 0; bj < 2; ++bj)
#pragma unroll
                for (int n = 0; n < 2; ++n) *(f32x4*)(dst + o + bj * 128 + n * 16) = acc[ai][bj][m][n];
            }
          }
      }
    } else {
      if (wc == 0) {
        float* dtb = (float*)(P->ws + WS_DT) + (size_t)brow * 32;
        const float* dtbias = P->in[12];
        const f32x4 b0 = *(const f32x4*)(dtbias + fq * 4), b1 = *(const f32x4*)(dtbias + 16 + fq * 4);
#pragma unroll
        for (int ai = 0; ai < 2; ++ai)
#pragma unroll
          for (int m = 0; m < 4; ++m) {
            __builtin_amdgcn_sched_barrier(0);
            unsigned o = (lrow0 + ai * 128 + m * 16) * 32 + fq * 4;
            f32x4 x0 = acc[ai][0][m][0] + b0, x1 = acc[ai][0][m][1] + b1;
            f32x4 d0, d1;
#pragma unroll
            for (int j = 0; j < 4; ++j) { d0[j] = softplus_f(x0[j]); d1[j] = softplus_f(x1[j]); }
            *(f32x4*)(dtb + o) = d0;
            *(f32x4*)(dtb + o + 16) = d1;
          }
      }
    }
  } else if (EPI == EPI_OUTPROJ || EPI == EPI_RES) {
    bfu* xo = (bfu*)(P->ws + WS_XR) + (size_t)brow * D + bcol;
#pragma unroll
    for (int ai = 0; ai < 2; ++ai)
#pragma unroll
      for (int m = 0; m < 4; ++m) {
        __builtin_amdgcn_sched_barrier(0);
        unsigned lr = lrow0 + ai * 128 + m * 16;
        unsigned o = lr * D + lcol0;
        float rsd = 1.f;
        if (EPI == EPI_OUTPROJ) rsd = sRu[lr];
#pragma unroll
        for (int bj = 0; bj < 2; ++bj)
#pragma unroll
          for (int n = 0; n < 2; ++n) {
            f32x4 v = acc[ai][bj][m][n] * rsd;
            uint2 pk; pk.x = cvt_pk_bf16(v[0], v[1]); pk.y = cvt_pk_bf16(v[2], v[3]);
            *(uint2*)(xo + o + bj * 128 + n * 16) = pk;
          }
      }
  } else if (EPI == EPI_GU) {
    bfu* hb = (bfu*)(P->ws + WS_BIG) + (size_t)brow * DFF + (bcol >> 1);
#pragma unroll
    for (int ai = 0; ai < 2; ++ai)
#pragma unroll
      for (int m = 0; m < 4; ++m) {
        __builtin_amdgcn_sched_barrier(0);
        unsigned o = (lrow0 + ai * 128 + m * 16) * DFF + wc * 16 + fq * 4;
#pragma unroll
        for (int bj = 0; bj < 2; ++bj) {
          f32x4 g = acc[ai][bj][m][0], u = acc[ai][bj][m][1];
          uint2 pk;
          pk.x = cvt_pk_bf16(silu_f(g[0]) * u[0], silu_f(g[1]) * u[1]);
          pk.y = cvt_pk_bf16(silu_f(g[2]) * u[2], silu_f(g[3]) * u[3]);
          *(uint2*)(hb + o + bj * 64) = pk;
        }
      }
  } else if (EPI == EPI_QKV) {
    const bool prompt = brow < MP;
    if (bcol < 2048) {
      const bool isq = bcol < 1024;
#pragma unroll
      for (int bj = 0; bj < 2; ++bj) {
        const int col32 = bcol + bj * 128 + wc * 32;
        int frb = fr, fqb = fq;
        asm volatile("" : "+v"(frb), "+v"(fqb));
        const unsigned lrow0b = wr * 64 + frb;
        const int d0 = ((col32 >> 5) & 1) * 16 + fqb * 4;
        float inv[4];
#pragma unroll
        for (int j = 0; j < 4; ++j) inv[j] = exp2f(-(float)(d0 + j) * (13.287712379549449f / 32.f)) * 0.15915494309189535f;
        const unsigned c1 = (col32 & ~63 & 1023) + d0;
        bfu* bdst;
        float* fdst = nullptr;
        if (isq) bdst = (bfu*)(P->ws + WS_Q) + (size_t)brow * 1024;
        else if (prompt) { bdst = (bfu*)(P->ws + WS_KP) + (size_t)brow * 1024; fdst = P->out + O_KP + (size_t)brow * 1024; }
        else { bdst = (bfu*)(P->ws + WS_KSM); fdst = P->out + O_KS + (size_t)(brow - MP) * 1024; }
#pragma unroll
        for (int ai = 0; ai < 2; ++ai)
#pragma unroll
          for (int m = 0; m < 4; ++m) {
            __builtin_amdgcn_sched_barrier(0);
            unsigned lr = lrow0b + ai * 128 + m * 16;
            int row = brow + lr;
            int pos = prompt ? (row & 4095) : 1024 + ((row - MP) & 63);
            f32x4 x1 = acc[ai][bj][m][0], x2 = acc[ai][bj][m][1], o1, o2;
#pragma unroll
            for (int j = 0; j < 4; ++j) {
              float rev = (float)pos * inv[j];
              rev -= floorf(rev);
              float sn = __builtin_amdgcn_sinf(rev), cs = __builtin_amdgcn_cosf(rev);
              o1[j] = x1[j] * cs - x2[j] * sn;
              o2[j] = x2[j] * cs + x1[j] * sn;
            }
            if (isq) {
              uint2 p1, p2;
              p1.x = cvt_pk_bf16(o1[0] * QSCALE, o1[1] * QSCALE); p1.y = cvt_pk_bf16(o1[2] * QSCALE, o1[3] * QSCALE);
              p2.x = cvt_pk_bf16(o2[0] * QSCALE, o2[1] * QSCALE); p2.y = cvt_pk_bf16(o2[2] * QSCALE, o2[3] * QSCALE);
              *(uint2*)(bdst + lr * 1024 + c1) = p1;
              *(uint2*)(bdst + lr * 1024 + c1 + 32) = p2;
            } else {
              *(f32x4*)(fdst + lr * 1024 + c1) = o1;
              *(f32x4*)(fdst + lr * 1024 + c1 + 32) = o2;
              unsigned bo;
              if (prompt) bo = lr * 1024 + c1;
              else { int rs = row - MP; bo = ((rs >> 6) * SKV + 1024 + (rs & 63)) * 1024 + c1; }
              uint2 p1, p2;
              p1.x = cvt_pk_bf16(o1[0], o1[1]); p1.y = cvt_pk_bf16(o1[2], o1[3]);
              p2.x = cvt_pk_bf16(o2[0], o2[1]); p2.y = cvt_pk_bf16(o2[2], o2[3]);
              *(uint2*)(bdst + bo) = p1;
              *(uint2*)(bdst + bo + 32) = p2;
            }
          }
      }
    } else {
      float* fdst = prompt ? P->out + O_VP + (size_t)brow * 1024 + (bcol - 2048) : P->out + O_VS + (size_t)(brow - MP) * 1024 + (bcol - 2048);
      bfu* vt = prompt ? (bfu*)(P->ws + WS_VTP) : (bfu*)(P->ws + WS_VTS);
#pragma unroll
      for (int ai = 0; ai < 2; ++ai)
#pragma unroll
        for (int m = 0; m < 4; ++m) {
          __builtin_amdgcn_sched_barrier(0);
          unsigned lr = lrow0 + ai * 128 + m * 16;
          int row = brow + lr;
          size_t tb;
          unsigned tstr;
          if (prompt) { tb = (size_t)(row >> 12) * 1024 * 4096 + (row & 4095); tstr = 4096; }
          else { int rs = row - MP; tb = (size_t)(rs >> 6) * 1024 * SKV + 1024 + (rs & 63); tstr = SKV; }
#pragma unroll
          for (int bj = 0; bj < 2; ++bj)
#pragma unroll
            for (int n = 0; n < 2; ++n) {
              f32x4 v = acc[ai][bj][m][n];
              unsigned lc = lcol0 + bj * 128 + n * 16;
              *(f32x4*)(fdst + lr * 1024 + lc) = v;
              unsigned c = bcol - 2048 + lc;
#pragma unroll
              for (int j = 0; j < 4; ++j) vt[tb + (size_t)(c + j) * tstr] = f2bf(v[j]);
            }
        }
    }
  }
}

template <int EPI>
__device__ __forceinline__ void gemm_phase(KP P, const bfu* __restrict__ A, const bfu* __restrict__ Bt, int K, int ntn, char* smem, const int wv) {
  const int tid = opaque_tid(wv), wid = wv, lane = tid & 63, wr = wid >> 2, wc = wid & 3, fr = lane & 15, fq = lane >> 4;
  LAS unsigned char* lds = (LAS unsigned char*)smem;
  constexpr bool SPLIT_SAMPLE = (EPI == EPI_OUTPROJ || EPI == EPI_RES);
  const int ntm = SPLIT_SAMPLE ? MP / 256 : MT / 256;
  const int ntiles = ntm * ntn;
  const int nig = 8 * ntn;
  const int nt = K / 64;
  const int G = gridDim.x, xper = G >> 3;
  const int vb = ((G & 7) == 0) ? (int)(blockIdx.x & 7) * xper + (int)(blockIdx.x >> 3) : (int)blockIdx.x;
  if (!SPLIT_SAMPLE && vb >= ntiles) return;
  unsigned voff[2];
#pragma unroll
  for (int i = 0; i < 2; ++i) { int R, C; stage_rc(tid * 16 + i * 8192, R, C); voff[i] = (unsigned)(R * K + C) * 2u; }
  const size_t kstep = (size_t)(64 * 2);
  const size_t hstep = (size_t)128 * K * 2;
  const size_t tstep = 2 * hstep;
  const unsigned ldsw = (unsigned)wid * 1024u;
  const int aoff = lds_byte(wr * 64 + fr, fq * 8), boff = lds_byte(wc * 32 + fr, fq * 8);
#define PG8_SA(b, h) (((b) * 2 + (h)) * HT_B)
#define PG8_SB(b, h) ((4 + (b) * 2 + (h)) * HT_B)
#define PG8_STAGE(bufoff, gbase) do { _Pragma("unroll") for (int _i = 0; _i < 2; ++_i) \
    __builtin_amdgcn_global_load_lds((const unsigned*)((const char*)(gbase) + voff[_i]), (LAS unsigned*)(lds + (bufoff) + ldsw + _i * 8192), 16, 0, 0); } while (0)
#define PG8_LDA(dst, b, h) do { _Pragma("unroll") for (int m = 0; m < 4; ++m) _Pragma("unroll") for (int k = 0; k < 2; ++k) dst[m][k] = *(const LAS bf16x8*)(lds + PG8_SA(b, h) + aoff + m * 2048 + k * 1024); } while (0)
#define PG8_LDB(dst, b, h) do { _Pragma("unroll") for (int n = 0; n < 2; ++n) _Pragma("unroll") for (int k = 0; k < 2; ++k) dst[n][k] = *(const LAS bf16x8*)(lds + PG8_SB(b, h) + boff + n * 2048 + k * 1024); } while (0)
#define PG8_MMA(ai, bj, At, Bt_) do { __builtin_amdgcn_s_setprio(1); _Pragma("unroll") for (int m = 0; m < 4; ++m) _Pragma("unroll") for (int n = 0; n < 2; ++n) _Pragma("unroll") for (int k = 0; k < 2; ++k) \
    acc[ai][bj][m][n] = __builtin_amdgcn_mfma_f32_16x16x32_bf16(Bt_[n][k], At[m][k], acc[ai][bj][m][n], 0, 0, 0); __builtin_amdgcn_s_setprio(0); } while (0)
#define PG8_WAIT_V(n) asm volatile("s_waitcnt vmcnt(" #n ")" ::: "memory")
#define PG8_WAIT_L(n) asm volatile("s_waitcnt lgkmcnt(" #n ")" ::: "memory")
#define PG8_BAR __builtin_amdgcn_s_barrier()
#define PG8_SCHED __builtin_amdgcn_sched_barrier(0)
#define TILE_PMPN(t, pm, pn) do { int gid_ = (t) / nig, fm_ = gid_ * 8, gsz_ = min(ntm - fm_, 8); pm = fm_ + ((t) % nig) % gsz_; pn = ((t) % nig) / gsz_; } while (0)
  int ctile = vb, cpm, cpn;
  TILE_PMPN(ctile, cpm, cpn);
  f32x4 acc[2][2][4][2];
  __syncthreads();
  const float* sRu = (const float*)(smem + 131072);
  if (EPI == EPI_OUTPROJ) {
    float* sR = (float*)(smem + 131072);
    const float* ssq = (const float*)(P->ws + WS_SSQ);
    int ui = 0;
    for (int t = vb; t < ntiles && ui < 8; t += G, ++ui) {
      int pm, pn;
      TILE_PMPN(t, pm, pn);
      if (tid < 256) sR[ui * 256 + tid] = ssd_rstd(ssq, pm * 256 + tid);
    }
    __syncthreads();
  }
  gemm_acc_init<EPI>(P, acc, cpm * 256, cpn * 256, wr, wc, fr, fq, sRu);
  bf16x8 At[4][2], B0[2][2], B1[2][2];
  const char* cA = (const char*)A + (size_t)cpm * tstep;
  const char* cB = (const char*)Bt + (size_t)cpn * tstep;
  PG8_STAGE(PG8_SB(0, 0), cB); PG8_STAGE(PG8_SA(0, 0), cA); PG8_STAGE(PG8_SB(0, 1), cB + hstep); PG8_STAGE(PG8_SA(0, 1), cA + hstep);
  if (wr == 1) PG8_BAR;
  PG8_WAIT_V(4); PG8_BAR;
  PG8_STAGE(PG8_SB(1, 0), cB + kstep); PG8_STAGE(PG8_SA(1, 0), cA + kstep); PG8_STAGE(PG8_SB(1, 1), cB + hstep + kstep);
  PG8_WAIT_V(6); PG8_BAR;
  for (;;) {
    const int ntile = ctile + G;
    const bool has_next = ntile < ntiles;
    int npm = cpm, npn = cpn;
    if (has_next) TILE_PMPN(ntile, npm, npn);
    const char* nA = (const char*)A + (size_t)npm * tstep;
    const char* nB = (const char*)Bt + (size_t)npn * tstep;
    for (int t = 0; t < nt; t += 2) {
      const bool last = (t == nt - 2);
      const char* a1 = cA + (size_t)(t + 1) * kstep;
      const char* a2 = last ? nA : cA + (size_t)(t + 2) * kstep;
      const char* b2 = last ? nB : cB + (size_t)(t + 2) * kstep;
      const char* a3 = a2 + kstep;
      const char* b3 = b2 + kstep;
      PG8_LDB(B0, 0, 0); PG8_SCHED; PG8_LDA(At, 0, 0); PG8_STAGE(PG8_SA(1, 1), a1 + hstep);
      PG8_WAIT_L(8); PG8_BAR; PG8_WAIT_L(0); PG8_MMA(0, 0, At, B0); PG8_BAR; PG8_SCHED;
      PG8_LDB(B1, 0, 1); PG8_STAGE(PG8_SB(0, 0), b2);
      PG8_BAR; PG8_WAIT_L(0); PG8_MMA(0, 1, At, B1); PG8_BAR;
      PG8_LDA(At, 0, 1); PG8_STAGE(PG8_SA(0, 0), a2);
      PG8_BAR; PG8_WAIT_L(0); PG8_MMA(1, 0, At, B0); PG8_BAR; PG8_SCHED;
      PG8_STAGE(PG8_SB(0, 1), b2 + hstep);
      PG8_WAIT_V(6); PG8_BAR; PG8_MMA(1, 1, At, B1); PG8_BAR;
      PG8_LDB(B0, 1, 0); PG8_SCHED; PG8_LDA(At, 1, 0); PG8_STAGE(PG8_SA(0, 1), a2 + hstep);
      PG8_WAIT_L(8); PG8_BAR; PG8_WAIT_L(0); PG8_MMA(0, 0, At, B0); PG8_BAR; PG8_SCHED;
      PG8_LDB(B1, 1, 1); PG8_STAGE(PG8_SB(1, 0), b3);
      PG8_BAR; PG8_WAIT_L(0); PG8_MMA(0, 1, At, B1); PG8_BAR;
      PG8_LDA(At, 1, 1); PG8_STAGE(PG8_SA(1, 0), a3);
      PG8_BAR; PG8_WAIT_L(0); PG8_MMA(1, 0, At, B0); PG8_BAR; PG8_SCHED;
      PG8_STAGE(PG8_SB(1, 1), b3 + hstep);
      PG8_WAIT_V(6); PG8_BAR; PG8_MMA(1, 1, At, B1); PG8_BAR;
    }
    gemm_epilogue<EPI>(P, acc, cpm * 256, cpn * 256, wr, wc, fr, fq, sRu);
    if (!has_next) break;
    sRu += 256;
    gemm_acc_init<EPI>(P, acc, npm * 256, npn * 256, wr, wc, fr, fq, sRu);
    ctile = ntile; cpm = npm; cpn = npn; cA = nA; cB = nB;
  }
  PG8_WAIT_V(0);
  if (wr == 0) PG8_BAR;
  PG8_BAR;
  if (SPLIT_SAMPLE) {
    float* sRed = (float*)smem;
    const int kw = K >> 3;
    for (int task = blockIdx.x; task < 256; task += G) {
      const int rb = task >> 4, cb = task & 15;
      const bfu* ap = A + (size_t)(MP + rb * 32 + fr) * K + wid * kw + fq * 8;
      const bfu* bp = Bt + (size_t)(cb * 64 + fr) * K + wid * kw + fq * 8;
      f32x4 pacc[2][4];
#pragma unroll
      for (int rt = 0; rt < 2; ++rt)
#pragma unroll
        for (int ct = 0; ct < 4; ++ct) pacc[rt][ct] = f32x4{0.f, 0.f, 0.f, 0.f};
      for (int ks = 0; ks < kw; ks += 32) {
        bf16x8 af[2], bf[4];
#pragma unroll
        for (int rt = 0; rt < 2; ++rt) af[rt] = *(const bf16x8*)(ap + (size_t)rt * 16 * K + ks);
#pragma unroll
        for (int ct = 0; ct < 4; ++ct) bf[ct] = *(const bf16x8*)(bp + (size_t)ct * 16 * K + ks);
#pragma unroll
        for (int rt = 0; rt < 2; ++rt)
#pragma unroll
          for (int ct = 0; ct < 4; ++ct) pacc[rt][ct] = mfma16(af[rt], bf[ct], pacc[rt][ct]);
      }
      __syncthreads();
#pragma unroll
      for (int rt = 0; rt < 2; ++rt)
#pragma unroll
        for (int ct = 0; ct < 4; ++ct) *(f32x4*)(sRed + ((wid * 8 + rt * 4 + ct) * 64 + lane) * 4) = pacc[rt][ct];
      __syncthreads();
      {
        f32x4 sum = {0.f, 0.f, 0.f, 0.f};
#pragma unroll
        for (int ww = 0; ww < 8; ++ww) sum += *(const f32x4*)(sRed + ((ww * 8 + wid) * 64 + lane) * 4);
        const int col = cb * 64 + (wid & 3) * 16 + fr;
#pragma unroll
        for (int j = 0; j < 4; ++j) {
          const int srow = rb * 32 + (wid >> 2) * 16 + fq * 4 + j;
          bfu* op = (bfu*)(P->ws + WS_XR) + (size_t)(MP + srow) * D + col;
          if (EPI == EPI_OUTPROJ) {
            const float rs = ssd_rstd((const float*)(P->ws + WS_SSQ), MP + srow);
            *op = f2bf(P->in[1][(size_t)srow * D + col] + rs * sum[j]);
          } else {
            *op = f2bf(bf2f(*op) + sum[j]);
          }
        }
      }
    }
  }
#undef PG8_SA
#undef PG8_SB
#undef PG8_STAGE
#undef PG8_LDA
#undef PG8_LDB
#undef PG8_MMA
#undef PG8_WAIT_V
#undef PG8_WAIT_L
#undef PG8_BAR
#undef PG8_SCHED
#undef TILE_PMPN
}

constexpr int S_LDB = 136;
constexpr int S_LDT = 72;
constexpr int S_LDCB = 68;
__device__ __forceinline__ void phase_ssd(KP P, char* smem, const int wv) {
  bfu* sB = (bfu*)smem;
  bfu* sC = sB + 64 * S_LDB;
  bfu* sBT = sC + 64 * S_LDB;
  bfu* sXT = sBT + 128 * S_LDT;
  bfu* sG = sXT + 128 * S_LDT;
  bfu* sH = sG + 2 * 64 * S_LDT;
  float* sAc = (float*)(sH + 8 * 16 * S_LDB);
  float* sDt = sAc + 512;
  float* sW = sDt + 512;
  float* sSq = sW + 512;
  bfu* sZ = (bfu*)(sSq + 512);
  float* sWc = (float*)(sZ + 64 * S_LDB);
  const int tid = opaque_tid(wv), w = wv, lane = tid & 63, fr = lane & 15, fq = lane >> 4;
  const int hl = w >> 2, ps = w & 3;
  const bfu* zx = (const bfu*)(P->ws + WS_BIG);
  const float* dtb = (const float*)(P->ws + WS_DT);
  float* ssqp = (float*)(P->ws + WS_SSQ);
  bfu* yg = (bfu*)(P->out + O_KP);
  const float* convw = P->in[10];
  const float* convb = P->in[11];
  bfu* myH = sH + w * 16 * S_LDB;
  float* myAc = sAc + w * 64;
  float* myDt = sDt + w * 64;
  float* myW = sW + w * 64;
  float* mySq = sSq + w * 64;
  const bool conv_role = w < 6;

  for (int unit = blockIdx.x; unit < 384; unit += gridDim.x) {
    int seq, g, hp, row0, nch;
    const float* hist = nullptr;
    const float* h0 = nullptr;
    float* hT;
    if (unit < 256) {
      seq = unit >> 4; g = (unit >> 2) & 3; hp = unit & 3;
      row0 = seq * 4096; nch = 64;
      hT = P->out + O_SSMP + (size_t)seq * 32 * 8192;
    } else {
      int u = unit - 256;
      seq = u >> 4; g = (u >> 2) & 3; hp = u & 3;
      row0 = MP + seq * 64; nch = 1;
      hist = P->in[2] + (size_t)seq * 3 * CONVD;
      h0 = P->in[3] + (size_t)seq * 32 * 8192;
      hT = P->out + O_SSMS + (size_t)seq * 32 * 8192;
    }
    const int head = g * 8 + hp * 2 + hl;
    const float A_h = -__expf(P->in[13][head]);
    const float D_h = P->in[14][head];
    f32x4 hacc[8];
    if (h0) {
#pragma unroll
      for (int nt = 0; nt < 8; ++nt)
#pragma unroll
        for (int j = 0; j < 4; ++j) hacc[nt][j] = h0[((size_t)head * 64 + ps * 16 + fq * 4 + j) * 128 + nt * 16 + fr];
    } else {
#pragma unroll
      for (int nt = 0; nt < 8; ++nt) hacc[nt] = f32x4{0.f, 0.f, 0.f, 0.f};
    }
    __syncthreads();
#pragma unroll
    for (int nt = 0; nt < 8; ++nt)
#pragma unroll
      for (int j = 0; j < 4; ++j) myH[(fq * 4 + j) * S_LDB + nt * 16 + fr] = f2bf(hacc[nt][j]);
    const int cgp = tid % 48, rs = tid / 48;
    int cc;
    if (cgp < 16) cc = (g * 8 + hp * 2) * 64 + cgp * 8;
    else if (cgp < 32) cc = DI + g * 128 + (cgp - 16) * 8;
    else cc = DI + 512 + g * 128 + (cgp - 32) * 8;
    if (tid < 384) {
      if (rs < 5) {
        const float* src = (rs < 4) ? convw + rs * CONVD + cc : convb + cc;
        f32x4 a = *(const f32x4*)src, bq = *(const f32x4*)(src + 4);
        *(f32x4*)(sWc + rs * 384 + cgp * 8) = a;
        *(f32x4*)(sWc + rs * 384 + cgp * 8 + 4) = bq;
      }
    }
    const int zt = tid - 384;
    const int zrow = (zt >> 1) & 63, zhalf = zt & 1;

    u32x4 pre[11];
    float dtv;
    {
      const int r0 = row0;
      if (conv_role) {
        const bfu* zxc = zx + ((size_t)r0 - 3) * ZXW + DI;
#pragma unroll
        for (int k = 0; k < 11; ++k) {
          int rr = rs * 8 - 3 + k;
          if (rr < 0) {
            if (hist) {
              f32x4 a = *(const f32x4*)(hist + (3 + rr) * CONVD + cc), bq = *(const f32x4*)(hist + (3 + rr) * CONVD + cc + 4);
              pre[k] = u32x4{pack2(a[0], a[1]), pack2(a[2], a[3]), pack2(bq[0], bq[1]), pack2(bq[2], bq[3])};
            } else {
              pre[k] = u32x4{0u, 0u, 0u, 0u};
            }
          } else {
            pre[k] = *(const u32x4*)(zxc + (unsigned)((rs * 8 + k) * ZXW + cc));
          }
        }
      } else {
        const bfu* zsrc = zx + (size_t)(r0 + zrow) * ZXW + (g * 8 + hp * 2) * 64 + zhalf * 64;
#pragma unroll
        for (int k = 0; k < 8; ++k) pre[k] = *(const u32x4*)(zsrc + k * 8);
#pragma unroll
        for (int k = 8; k < 11; ++k) pre[k] = u32x4{0u, 0u, 0u, 0u};
      }
      dtv = dtb[(size_t)(r0 + lane) * 32 + head];
    }

    for (int c = 0; c < nch; ++c) {
      const int r0 = row0 + c * 64;
      lds_barrier();
      if (conv_role) {
        const float* wcol = sWc + cgp * 8;
        u32x4 ovr[8];
#pragma unroll
        for (int e2 = 0; e2 < 4; ++e2) {
          __builtin_amdgcn_sched_barrier(0);
          float w0[4], w1[4];
#pragma unroll
          for (int tap = 0; tap < 4; ++tap) { w0[tap] = wcol[tap * 384 + 2 * e2]; w1[tap] = wcol[tap * 384 + 2 * e2 + 1]; }
          const float bl = wcol[4 * 384 + 2 * e2], bh = wcol[4 * 384 + 2 * e2 + 1];
#pragma unroll
          for (int i = 0; i < 8; ++i) {
            float ylo = bl, yhi = bh;
#pragma unroll
            for (int tap = 0; tap < 4; ++tap) {
              unsigned rw = pre[i + tap][e2];
              ylo += w0[tap] * __uint_as_float(rw << 16);
              yhi += w1[tap] * __uint_as_float(rw & 0xffff0000u);
            }
            ovr[i][e2] = cvt_pk_bf16(silu_f(ylo), silu_f(yhi));
          }
        }
        if (cgp >= 16) {
          bfu* rowdst = (cgp < 32) ? (sB + (cgp - 16) * 8) : (sC + (cgp - 32) * 8);
#pragma unroll
          for (int i = 0; i < 8; ++i) *(u32x4*)(rowdst + (rs * 8 + i) * S_LDB) = ovr[i];
        }
        if (cgp < 32) {
          bfu* coldst = (cgp < 16) ? (sXT + (cgp * 8) * S_LDT + rs * 8) : (sBT + ((cgp - 16) * 8) * S_LDT + rs * 8);
#pragma unroll
          for (int e = 0; e < 8; ++e) {
            const int e2 = e >> 1, sh = (e & 1) * 16;
            u32x4 o;
            o[0] = ((ovr[0][e2] >> sh) & 0xffffu) | ((ovr[1][e2] >> sh) << 16);
            o[1] = ((ovr[2][e2] >> sh) & 0xffffu) | ((ovr[3][e2] >> sh) << 16);
            o[2] = ((ovr[4][e2] >> sh) & 0xffffu) | ((ovr[5][e2] >> sh) << 16);
            o[3] = ((ovr[6][e2] >> sh) & 0xffffu) | ((ovr[7][e2] >> sh) << 16);
            *(u32x4*)(coldst + e * S_LDT) = o;
          }
        }
      } else {
#pragma unroll
        for (int k = 0; k < 8; ++k) *(u32x4*)(sZ + zrow * S_LDB + zhalf * 64 + k * 8) = pre[k];
      }
      float a63;
      {
        float ac = dtv * A_h;
#pragma unroll
        for (int o = 1; o < 64; o <<= 1) {
          float t = shup(ac, o, lane);
          if (lane >= o) ac += t;
        }
        a63 = shidx(ac, 63);
        myAc[lane] = ac;
        myDt[lane] = dtv;
        myW[lane] = __expf(a63 - ac) * dtv;
      }
      lds_barrier();
      if (c + 1 < nch) {
        const int r1 = r0 + 64;
        int rsl = rs;
        asm volatile("" : "+v"(rsl));
        if (conv_role) {
          const bfu* zxc = zx + ((size_t)r1 - 3) * ZXW + DI;
#pragma unroll
          for (int k = 0; k < 11; ++k) pre[k] = *(const u32x4*)(zxc + (unsigned)((rsl * 8 + k) * ZXW + cc));
        } else {
          const bfu* zsrc = zx + (size_t)(r1 + zrow) * ZXW + (g * 8 + hp * 2) * 64 + zhalf * 64;
#pragma unroll
          for (int k = 0; k < 8; ++k) pre[k] = *(const u32x4*)(zsrc + k * 8);
        }
        dtv = dtb[(size_t)(r1 + lane) * 32 + head];
      }
      int frc = fr, fqc = fq;
      asm volatile("" : "+v"(frc), "+v"(fqc));
      {
        const int it = w >> 1, jt0 = (w & 1) * 2;
        f32x4 cb[2] = {{0.f, 0.f, 0.f, 0.f}, {0.f, 0.f, 0.f, 0.f}};
#pragma unroll
        for (int ks = 0; ks < 4; ++ks) {
          bf16x8 a = lds_b128(sC + (it * 16 + frc) * S_LDB + ks * 32 + fqc * 8);
          bf16x8 b0 = lds_b128(sB + (jt0 * 16 + frc) * S_LDB + ks * 32 + fqc * 8);
          bf16x8 b1 = lds_b128(sB + ((jt0 + 1) * 16 + frc) * S_LDB + ks * 32 + fqc * 8);
          cb[0] = mfma16(a, b0, cb[0]);
          cb[1] = mfma16(a, b1, cb[1]);
        }
        const int i0 = it * 16 + fqc * 4;
#pragma unroll
        for (int hh = 0; hh < 2; ++hh) {
          const float* hAc = sAc + hh * 256;
          const float* hDt = sDt + hh * 256;
          const f32x4 aci = *(const f32x4*)(hAc + i0);
#pragma unroll
          for (int t = 0; t < 2; ++t) {
            const int jj = (jt0 + t) * 16 + frc;
            const float acj = hAc[jj], dtj = hDt[jj];
#pragma unroll
            for (int j = 0; j < 4; ++j) {
              const float gv = (jj <= i0 + j) ? cb[t][j] * __expf(aci[j] - acj) * dtj : 0.f;
              sG[(hh * 64 + i0 + j) * S_LDT + jj] = f2bf(gv);
            }
          }
        }
      }
      lds_barrier();
      const bfu* xrow = sXT + (hl * 64 + ps * 16 + frc) * S_LDT;
#pragma unroll 1
      for (int it = 0; it < 4; ++it) {
        f32x4 yacc = {0.f, 0.f, 0.f, 0.f}, oacc = {0.f, 0.f, 0.f, 0.f};
        const bfu* grow = sG + (hl * 64 + it * 16 + frc) * S_LDT;
#pragma unroll
        for (int ks = 0; ks < 2; ++ks) {
          if (ks * 32 <= it * 16 + 15) {
            const int j0 = ks * 32 + fqc * 8;
            bf16x8 gfr = lds_b128(grow + j0);
            bf16x8 bfv = lds_b128(xrow + j0);
            yacc = mfma16(gfr, bfv, yacc);
          }
        }
#pragma unroll
        for (int ks = 0; ks < 4; ++ks) {
          bf16x8 a = lds_b128(sC + (it * 16 + frc) * S_LDB + ks * 32 + fqc * 8);
          bf16x8 b = lds_b128(myH + frc * S_LDB + ks * 32 + fqc * 8);
          oacc = mfma16(a, b, oacc);
        }
#pragma unroll
        for (int j = 0; j < 4; ++j) {
          int ii = it * 16 + fqc * 4 + j;
          float xv = bf2f(xrow[ii]);
          float y = yacc[j] + __expf(myAc[ii]) * oacc[j] + D_h * xv;
          float zv = bf2f(sZ[ii * S_LDB + hl * 64 + ps * 16 + frc]);
          float ygv = y * silu_f(zv);
          yg[(size_t)(r0 + ii) * DI + head * 64 + ps * 16 + frc] = f2bf(ygv);
          float sq = ygv * ygv;
          sq = row16_sum(sq);
          if (frc == 0) mySq[ii] = sq;
        }
      }
      {
        const float dec = __expf(a63);
#pragma unroll
        for (int nt = 0; nt < 8; ++nt) hacc[nt] *= dec;
#pragma unroll
        for (int ks = 0; ks < 2; ++ks) {
          const int j0 = ks * 32 + fqc * 8;
          bf16x8 xr = lds_b128(xrow + j0);
          f32x4 w0 = *(const f32x4*)(myW + j0), w1 = *(const f32x4*)(myW + j0 + 4);
          u32x4 xu = __builtin_bit_cast(u32x4, xr);
          u32x4 pk;
          pk[0] = cvt_pk_bf16(__uint_as_float(xu[0] << 16) * w0[0], __uint_as_float(xu[0] & 0xffff0000u) * w0[1]);
          pk[1] = cvt_pk_bf16(__uint_as_float(xu[1] << 16) * w0[2], __uint_as_float(xu[1] & 0xffff0000u) * w0[3]);
          pk[2] = cvt_pk_bf16(__uint_as_float(xu[2] << 16) * w1[0], __uint_as_float(xu[2] & 0xffff0000u) * w1[1]);
          pk[3] = cvt_pk_bf16(__uint_as_float(xu[3] << 16) * w1[2], __uint_as_float(xu[3] & 0xffff0000u) * w1[3]);
          bf16x8 af = __builtin_bit_cast(bf16x8, pk);
#pragma unroll
          for (int nt = 0; nt < 8; ++nt) {
            bf16x8 b = lds_b128(sBT + (nt * 16 + frc) * S_LDT + j0);
            hacc[nt] = mfma16(af, b, hacc[nt]);
          }
        }
#pragma unroll
        for (int nt = 0; nt < 8; ++nt)
#pragma unroll
          for (int j = 0; j < 4; ++j) myH[(fqc * 4 + j) * S_LDB + nt * 16 + frc] = f2bf(hacc[nt][j]);
      }
      lds_barrier();
      if (tid < 64) {
        float sm = 0.f;
#pragma unroll
        for (int ww = 0; ww < 8; ++ww) sm += sSq[ww * 64 + tid];
        ssqp[(size_t)(r0 + tid) * 16 + g * 4 + hp] = sm;
      }
    }
#pragma unroll
    for (int nt = 0; nt < 8; ++nt)
#pragma unroll
      for (int j = 0; j < 4; ++j) hT[((size_t)head * 64 + ps * 16 + fq * 4 + j) * 128 + nt * 16 + fr] = hacc[nt][j];
  }
}

constexpr int A_STAGE = 32768;
constexpr int A_LDO = 132;
__device__ __forceinline__ int kswz(int key) { return ((key >> 1) & 1) | (((key >> 3) & 3) << 1); }
__device__ __forceinline__ void phase_attn(KP P, char* smem, const int wv) {
  LAS unsigned char* lds = (LAS unsigned char*)smem;
  float* sO = (float*)smem;
  const int tid = opaque_tid(wv), w = wv, lane = tid & 63, fr = lane & 15, fq = lane >> 4;
  const int cm = w >> 2, rg = w & 3;
  const bfu* qb = (const bfu*)(P->ws + WS_Q);
  bfu* ao = (bfu*)(P->ws + WS_AO);
  float lam;
  {
    float a = P->in[18][lane] * P->in[19][lane];
    float b = P->in[20][lane] * P->in[21][lane];
    a = wave_sum(a, lane); b = wave_sum(b, lane);
    lam = __expf(a) - __expf(b) + LAMBDA_INIT;
  }
  const float* subln = P->in[22];
  unsigned ksrc[2], vsrc_row[2], vsrc_col[2];
#pragma unroll
  for (int i = 0; i < 2; ++i) {
    int p = (2 * w + i) * 64 + lane;
    int row = p >> 3, phys = p & 7;
    int map = row >> 6, key = row & 63;
    ksrc[i] = (unsigned)(key * 1024 + map * 64 + ((phys ^ kswz(key)) << 3));
    vsrc_row[i] = (unsigned)row;
    vsrc_col[i] = (unsigned)((phys ^ (row & 7)) << 3);
  }
  unsigned koff[4];
#pragma unroll
  for (int t4 = 0; t4 < 4; ++t4) {
    int key = (t4 >> 1) * 32 + (fr >> 2) * 8 + (t4 & 1) * 4 + (fr & 3);
    koff[t4] = (unsigned)((cm * 64 + key) * 128 + ((fq ^ kswz(key)) << 4));
  }
  const unsigned voff0 = 16384u + (unsigned)(fr * 128 + ((fq ^ (fr & 7)) << 4));
  const unsigned kb0 = koff[0], kb1 = koff[0] ^ 64u, vb0 = voff0, vb1 = voff0 ^ 64u;

  const int G = gridDim.x;
  const bool xcd_order = (G == 256);
  const int nrounds = xcd_order ? 17 : (4096 + 64 + G - 1) / G;
  for (int r = 0; r < nrounds; ++r) {
    int b, h, pc;
    bool sample = false;
    if (xcd_order) {
      int x = blockIdx.x & 7, j = blockIdx.x >> 3;
      if (r < 16) { int bh = r * 8 + x; b = bh >> 3; h = bh & 7; pc = (r & 1) ? 31 - j : j; }
      else { if (j >= 8) break; int sidx = x * 8 + j; b = sidx >> 3; h = sidx & 7; pc = 0; sample = true; }
    } else {
      int u = blockIdx.x + r * G;
      if (u >= 4096 + 64) break;
      if (u < 4096) { pc = 31 - (u >> 7); int bh = u & 127; b = bh >> 3; h = bh & 7; }
      else { int sidx = u - 4096; b = sidx >> 3; h = sidx & 7; pc = 0; sample = true; }
    }
    int qrow0, nkt, Tstr;
    const bfu* kbase;
    const bfu* vtbase;
    if (!sample) {
      qrow0 = b * 4096 + pc * 128;
      nkt = 2 * pc + 2;
      Tstr = 4096;
      kbase = (const bfu*)(P->ws + WS_KP) + (size_t)b * 4096 * 1024 + h * 128;
      vtbase = (const bfu*)(P->ws + WS_VTP) + (size_t)(b * 8 + h) * 128 * 4096;
    } else {
      qrow0 = MP + b * 64;
      nkt = 17;
      Tstr = SKV;
      kbase = (const bfu*)(P->ws + WS_KSM) + (size_t)b * SKV * 1024 + h * 128;
      vtbase = (const bfu*)(P->ws + WS_VTS) + (size_t)(b * 8 + h) * 128 * SKV;
    }
    const bool wave_valid = !sample || rg < 2;
    const int my_nkt = sample ? nkt : (rg < 2 ? nkt - 1 : nkt);
    bf16x8 qf[2][2];
    {
      const int qr = wave_valid ? (qrow0 + rg * 32 + fr) : qrow0;
      const bfu* qp = qb + (size_t)qr * 1024 + h * 128 + cm * 64 + fq * 8;
#pragma unroll
      for (int qt = 0; qt < 2; ++qt) {
        qf[qt][0] = *(const bf16x8*)(qp + (wave_valid ? qt * 16 * 1024 : 0));
        qf[qt][1] = *(const bf16x8*)(qp + (wave_valid ? qt * 16 * 1024 : 0) + 32);
      }
    }
    float mrun[2] = {-INFINITY, -INFINITY}, lrun[2] = {0.f, 0.f};
    f32x4 oacc[2][8];
#pragma unroll
    for (int qt = 0; qt < 2; ++qt)
#pragma unroll
      for (int et = 0; et < 8; ++et) oacc[qt][et] = f32x4{0.f, 0.f, 0.f, 0.f};

#define ATT_STAGE(stage, kt_) do { \
      const bfu* kt_base = kbase + (size_t)(kt_) * 64 * 1024; \
      const bfu* vt_base = vtbase + (size_t)(kt_) * 64; \
      _Pragma("unroll") for (int _i = 0; _i < 2; ++_i) \
        __builtin_amdgcn_global_load_lds((const unsigned*)(kt_base + ksrc[_i]), (LAS unsigned*)(lds + (stage) * A_STAGE + (2 * w + _i) * 1024), 16, 0, 0); \
      _Pragma("unroll") for (int _i = 0; _i < 2; ++_i) \
        __builtin_amdgcn_global_load_lds((const unsigned*)(vt_base + (size_t)vsrc_row[_i] * Tstr + vsrc_col[_i]), (LAS unsigned*)(lds + (stage) * A_STAGE + 16384 + (2 * w + _i) * 1024), 16, 0, 0); \
    } while (0)

#define ATT_S_SOFTMAX(stage_) do { \
      LAS unsigned char* sb = lds + (stage_) * A_STAGE; \
      f32x4 st[2][4]; \
      _Pragma("unroll") for (int t4 = 0; t4 < 4; ++t4) { \
        bf16x8 a0 = *(const LAS bf16x8*)(sb + kb0 + (t4 >> 1) * 4096 + (t4 & 1) * 512); \
        bf16x8 a1 = *(const LAS bf16x8*)(sb + kb1 + (t4 >> 1) * 4096 + (t4 & 1) * 512); \
        _Pragma("unroll") for (int qt = 0; qt < 2; ++qt) { \
          f32x4 z = {0.f, 0.f, 0.f, 0.f}; \
          z = mfma16(a0, qf[qt][0], z); \
          st[qt][t4] = mfma16(a1, qf[qt][1], z); \
        } \
      } \
      _Pragma("unroll") for (int qt = 0; qt < 2; ++qt) { \
        float mx = st[qt][0][0]; \
        _Pragma("unroll") for (int t4 = 0; t4 < 4; ++t4) \
          _Pragma("unroll") for (int j = 0; j < 4; ++j) mx = fmaxf(mx, st[qt][t4][j]); \
        mx = xmax_16_32(mx); \
          \
        if (__builtin_amdgcn_ballot_w64(mx - mrun[qt] > 8.f) != 0ull) { \
          const float mnew = fmaxf(mrun[qt], mx); \
          const float alpha = __builtin_amdgcn_exp2f(mrun[qt] - mnew); \
          lrun[qt] *= alpha; \
          mrun[qt] = mnew; \
          _Pragma("unroll") for (int et = 0; et < 8; ++et) oacc[qt][et] *= alpha; \
        } \
        const f32x2 m2 = {mrun[qt], mrun[qt]}; \
        f32x2 ls2 = {0.f, 0.f}; \
        _Pragma("unroll") for (int t4 = 0; t4 < 4; ++t4) { \
          f32x2 lo = f32x2{st[qt][t4][0], st[qt][t4][1]} - m2, hi = f32x2{st[qt][t4][2], st[qt][t4][3]} - m2; \
          lo[0] = __builtin_amdgcn_exp2f(lo[0]); lo[1] = __builtin_amdgcn_exp2f(lo[1]); \
          hi[0] = __builtin_amdgcn_exp2f(hi[0]); hi[1] = __builtin_amdgcn_exp2f(hi[1]); \
          ls2 += lo; ls2 += hi; \
          st[qt][t4] = f32x4{lo[0], lo[1], hi[0], hi[1]}; \
        } \
        lrun[qt] += ls2[0] + ls2[1]; \
        _Pragma("unroll") for (int kk = 0; kk < 2; ++kk) { \
          u32x4 pk; \
          pk[0] = cvt_pk_bf16(st[qt][2 * kk][0], st[qt][2 * kk][1]); \
          pk[1] = cvt_pk_bf16(st[qt][2 * kk][2], st[qt][2 * kk][3]); \
          pk[2] = cvt_pk_bf16(st[qt][2 * kk + 1][0], st[qt][2 * kk + 1][1]); \
          pk[3] = cvt_pk_bf16(st[qt][2 * kk + 1][2], st[qt][2 * kk + 1][3]); \
          pb[qt][kk] = __builtin_bit_cast(bf16x8, pk); \
        } \
      } \
    } while (0)
#define ATT_PV(stage_) do { \
      LAS unsigned char* sb = lds + (stage_) * A_STAGE; \
      __builtin_amdgcn_s_setprio(1); \
      _Pragma("unroll") for (int kk = 0; kk < 2; ++kk) \
        _Pragma("unroll") for (int et = 0; et < 8; ++et) { \
          bf16x8 a = *(const LAS bf16x8*)(sb + (kk ? vb1 : vb0) + et * 2048); \
          oacc[0][et] = mfma16(a, pb[0][kk], oacc[0][et]); \
          oacc[1][et] = mfma16(a, pb[1][kk], oacc[1][et]); \
        } \
      __builtin_amdgcn_s_setprio(0); \
    } while (0)

    __syncthreads();
    ATT_STAGE(0, 0);
    if (nkt > 1) ATT_STAGE(1, 1);
    if (nkt > 1) asm volatile("s_waitcnt vmcnt(4)" ::: "memory");
    else asm volatile("s_waitcnt vmcnt(0)" ::: "memory");
    if (cm == 1) lds_barrier();
    bf16x8 pb[2][2];
#pragma unroll 1
    for (int kt = 0; kt < nkt; ++kt) {
      const bool act = wave_valid && kt < my_nkt;
      lds_barrier();
      if (kt + 2 < nkt) ATT_STAGE((kt + 2) & 3, kt + 2);
      if (act) ATT_S_SOFTMAX(kt & 3);
      if (kt + 1 < nkt) {
        if (kt + 2 < nkt) asm volatile("s_waitcnt vmcnt(4)" ::: "memory");
        else asm volatile("s_waitcnt vmcnt(0)" ::: "memory");
      }
      lds_barrier();
      if (act) ATT_PV(kt & 3);
    }
    if (cm == 0) lds_barrier();
#undef ATT_S_SOFTMAX
#undef ATT_PV
#undef ATT_STAGE
    lrun[0] = xsum_16_32(lrun[0]);
    lrun[1] = xsum_16_32(lrun[1]);
    __syncthreads();
    if (cm == 1 && wave_valid) {
#pragma unroll
      for (int qt = 0; qt < 2; ++qt) {
        float rl = 1.f / lrun[qt];
#pragma unroll
        for (int et = 0; et < 8; ++et) *(f32x4*)(sO + (rg * 32 + qt * 16 + fr) * A_LDO + et * 16 + fq * 4) = oacc[qt][et] * rl;
      }
    }
    __syncthreads();
    if (cm == 0 && wave_valid) {
#pragma unroll
      for (int qt = 0; qt < 2; ++qt) {
        float rl = 1.f / lrun[qt];
        float ss = 0.f;
#pragma unroll
        for (int et = 0; et < 8; ++et) {
          f32x4 o1 = *(const f32x4*)(sO + (rg * 32 + qt * 16 + fr) * A_LDO + et * 16 + fq * 4);
          f32x4 o = oacc[qt][et] * rl - o1 * lam;
          oacc[qt][et] = o;
          ss += o[0] * o[0] + o[1] * o[1] + o[2] * o[2] + o[3] * o[3];
        }
        ss = xsum_16_32(ss);
        float rstd = rsqrtf(ss * (1.f / 128.f) + EPS) * (1.f - LAMBDA_INIT);
        bfu* dst = ao + (size_t)(qrow0 + rg * 32 + qt * 16 + fr) * 1024 + h * 128;
        int fqe = fq;
        asm volatile("" : "+v"(fqe));
#pragma unroll
        for (int et = 0; et < 8; ++et) {
          int e0 = et * 16 + fqe * 4;
          f32x4 sw = *(const f32x4*)(subln + e0);
          uint2 pk;
          pk.x = cvt_pk_bf16(oacc[qt][et][0] * rstd * sw[0], oacc[qt][et][1] * rstd * sw[1]);
          pk.y = cvt_pk_bf16(oacc[qt][et][2] * rstd * sw[2], oacc[qt][et][3] * rstd * sw[3]);
          *(uint2*)(dst + e0) = pk;
        }
      }
    }
  }
}

#define XB_TMO      128
#define XB_XCNT(j)  (256  + 64 * (j))
#define XB_XSUB(j)  (1280 + 64 * (j))
#define XB_XGEN(j)  (2304 + 64 * (j))
#define XB_TOP      3328
#define XB_TOPGEN   3392
#define XCD_BAR_WORDS 3456
#define XB_SPIN_CAP (1u << 22)
__device__ __forceinline__ unsigned xb_ld(unsigned* p)              { return __hip_atomic_load(p, __ATOMIC_RELAXED, __HIP_MEMORY_SCOPE_AGENT); }
__device__ __forceinline__ unsigned xb_add(unsigned* p, unsigned v) { return __hip_atomic_fetch_add(p, v, __ATOMIC_RELAXED, __HIP_MEMORY_SCOPE_AGENT); }
__device__ __forceinline__ unsigned xb_xcc_id() { return (unsigned)__builtin_amdgcn_s_getreg((3 << 11) | 20) & 0xFu; }
#define XB_SPIN(cond, bar) do { unsigned _sp = 0; while (cond) { __builtin_amdgcn_s_sleep(1); \
    if ((++_sp & 255u) == 0u) { if (xb_ld(&(bar)[XB_TMO])) break; if (_sp > XB_SPIN_CAP) { atomicAdd(&(bar)[XB_TMO], 1u); break; } } } } while (0)
__device__ __forceinline__ void xcd_barrier_complete(unsigned* bar, unsigned x, unsigned& nloc, unsigned& nx) {
  const unsigned G = gridDim.x;
  unsigned sum, cnt, mine, sp = 0u;
  for (;;) {
    sum = 0u; cnt = 0u; mine = 0u;
#pragma unroll
    for (unsigned j = 0; j < 16; ++j) { const unsigned c = xb_ld(&bar[XB_XCNT(j)]); sum += c; cnt += (c > 0u) ? 1u : 0u; mine = (j == x) ? c : mine; }
    if (sum == G) break;
    __builtin_amdgcn_s_sleep(1);
    if ((++sp & 255u) == 0u) { if (xb_ld(&bar[XB_TMO])) break; if (sp > XB_SPIN_CAP) { atomicAdd(&bar[XB_TMO], 1u); break; } }
  }
  nloc = mine > 0u ? mine : 1u; nx = cnt > 0u ? cnt : 1u;
}
__device__ __forceinline__ void xcd_barrier(unsigned* bar, volatile __attribute__((address_space(3))) unsigned* st, const int tid) {
  asm volatile("s_waitcnt vmcnt(0)" ::: "memory");
  __syncthreads();
  if (tid == 0) {
    const unsigned x = xb_xcc_id();
    __builtin_amdgcn_s_waitcnt(0);
    unsigned nloc = st[0], nx = st[1];
    if (nloc == 0u) { xcd_barrier_complete(bar, x, nloc, nx); st[0] = nloc; st[1] = nx; }
    const unsigned old = xb_add(&bar[XB_XSUB(x)], 1u);
    const unsigned gen = old / nloc;
    if (old + 1u == (gen + 1u) * nloc) {
      __builtin_amdgcn_fence(__ATOMIC_RELEASE, "agent");
      asm volatile("s_waitcnt vmcnt(0)" ::: "memory");
      const unsigned og = xb_add(&bar[XB_TOP], 1u);
      const unsigned tg = og / nx;
      if (og + 1u == (tg + 1u) * nx) xb_add(&bar[XB_TOPGEN], 1u);
      else XB_SPIN(xb_ld(&bar[XB_TOPGEN]) == tg, bar);
      __builtin_amdgcn_fence(__ATOMIC_ACQUIRE, "agent");
      xb_add(&bar[XB_XGEN(x)], 1u);
      asm volatile("s_waitcnt vmcnt(0)" ::: "memory");
    } else {
      XB_SPIN(xb_ld(&bar[XB_XGEN(x)]) == gen, bar);
      __builtin_amdgcn_fence(__ATOMIC_ACQUIRE, "agent");
      asm volatile("s_waitcnt vmcnt(0)" ::: "memory");
    }
  }
  __syncthreads();
}

__global__ void __launch_bounds__(512) fwd_kernel(Params Pk) {
  extern __shared__ __attribute__((aligned(16))) char smem_base[];
  const int wv = __builtin_amdgcn_readfirstlane((int)(threadIdx.x >> 6));
  volatile __attribute__((address_space(3))) unsigned* xst = (volatile __attribute__((address_space(3))) unsigned*)(smem_base + LDS_BYTES - 16);
  if (threadIdx.x == 0) {
    xst[0] = 0u; xst[1] = 0u;
    (void)xb_add(&((unsigned*)(Pk.ws + WS_BAR))[XB_XCNT(xb_xcc_id())], 1u);
  }
  __syncthreads();
  for (int ph = Pk.ph_lo; ph < Pk.ph_hi; ++ph) {
    int zoff = 0;
    asm volatile("" : "+s"(zoff));
    char* smem = smem_base + zoff;
    KP P = (KP)__builtin_amdgcn_kernarg_segment_ptr();
    asm volatile("" : "+s"(P));
#ifdef PROBE_DUP
    for (int rep = 0; rep < (((PROBE_DUP >> ph) & 1) ? 2 : 1); ++rep)
#endif
    switch (ph) {
      case 0: case 4: case 7: case 11: {
        const float* w = ph == 0 ? P->in[6] : (ph == 4 ? P->in[7] : (ph == 7 ? P->in[6] + D : P->in[7] + D));
        if (ph == 0) phase_norm<false, false>(P->in[0], P->in[1], nullptr, w, (bfu*)(P->ws + WS_XN), nullptr, wv);
        else phase_norm<false, true>(nullptr, nullptr, (const bfu*)(P->ws + WS_XR), w, (bfu*)(P->ws + WS_XN), nullptr, wv);
        if (ph == 0) phase_convert_weights(P, smem, wv);
        if (ph == 7) phase_convert_cache(P, smem, wv);
      } break;
      case 1: gemm_phase<EPI_INPROJ>(P, (const bfu*)(P->ws + WS_XN), (const bfu*)(P->ws + WS_W_INP), 1024, INP_NP / 256, smem, wv); break;
      case 2: phase_ssd(P, smem, wv); break;
      case 3: gemm_phase<EPI_OUTPROJ>(P, (const bfu*)(P->out + O_KP), (const bfu*)(P->ws + WS_W_OUTP), 2048, 4, smem, wv); break;
      case 5: case 12:
        gemm_phase<EPI_GU>(P, (const bfu*)(P->ws + WS_XN), (const bfu*)(P->ws + (ph == 5 ? WS_W_GU0 : WS_W_GU1)), 1024, 22, smem, wv);
        break;
      case 6: case 10: case 13: {
        const bfu* A = (const bfu*)(P->ws + (ph == 10 ? WS_AO : WS_BIG));
        const bfu* Bt = (const bfu*)(P->ws + (ph == 6 ? WS_W_DN0 : (ph == 10 ? WS_W_AO : WS_W_DN1)));
        gemm_phase<EPI_RES>(P, A, Bt, ph == 10 ? 1024 : DFF, 4, smem, wv);
      } break;
      case 8: gemm_phase<EPI_QKV>(P, (const bfu*)(P->ws + WS_XN), (const bfu*)(P->ws + WS_W_QKV), 1024, 12, smem, wv); break;
      case 9: phase_attn(P, smem, wv); break;
      case 14: phase_norm<true, true>(nullptr, nullptr, (const bfu*)(P->ws + WS_XR), P->in[8], nullptr, P->out, wv); break;
    }
    if (ph + 1 < Pk.ph_hi) {
      if (ph == Pk.ph_lo) cg::this_grid().sync();
      else xcd_barrier((unsigned*)(P->ws + WS_BAR), xst, opaque_tid(wv));
    }
  }
}

extern "C" void kernel_launch(void* const* d_in, const int* in_sizes, int n_in, void* d_out, int out_size, void* d_ws, size_t ws_size,
                              hipStream_t stream) {
  static int grid = 0;
  if (grid == 0) {
    if (n_in != 27 || ws_size < WS_END || out_size != 209412096) {
      fprintf(stderr, "kernel_launch: unexpected sizes n_in=%d ws=%zu (need %zu) out=%d\n", n_in, ws_size, (size_t)WS_END, out_size);
    }
    int dev = 0, cus = 0, per_cu = 0;
    (void)hipGetDevice(&dev);
    (void)hipDeviceGetAttribute(&cus, hipDeviceAttributeMultiprocessorCount, dev);
    (void)hipFuncSetAttribute((const void*)fwd_kernel, hipFuncAttributeMaxDynamicSharedMemorySize, LDS_BYTES);
    (void)hipOccupancyMaxActiveBlocksPerMultiprocessor(&per_cu, (const void*)fwd_kernel, 512, LDS_BYTES);
    if (per_cu < 1) { fprintf(stderr, "kernel_launch: occupancy query returned %d\n", per_cu); per_cu = 1; }
    grid = cus * per_cu;
    fprintf(stderr, "kernel_launch: grid=%d (cus=%d per_cu=%d) ws=%zu need=%zu\n", grid, cus, per_cu, ws_size, (size_t)WS_END);
  }
  Params p{};
  for (int i = 0; i < 27; ++i) p.in[i] = (const float*)d_in[i];
  p.out = (float*)d_out;
  p.ws = (unsigned char*)d_ws;
#if COOP
  (void)hipMemsetAsync((char*)d_ws + WS_BAR, 0, 16384, stream);
  p.ph_lo = 0; p.ph_hi = NPH;
  void* args[] = {&p};
  hipError_t e = hipLaunchCooperativeKernel((const void*)fwd_kernel, dim3(grid), dim3(512), args, LDS_BYTES, stream);
  if (e != hipSuccess) fprintf(stderr, "cooperative launch failed: %s (grid %d)\n", hipGetErrorString(e), grid);
#else
  for (int ph = 0; ph < NPH; ++ph) {
    p.ph_lo = ph; p.ph_hi = ph + 1;
    hipLaunchKernelGGL(fwd_kernel, dim3(grid), dim3(512), LDS_BYTES, stream, p);
  }
#endif
}
```

```cpp
#include <hip/hip_runtime.h>
#include <hip/hip_cooperative_groups.h>
#include <cmath>
#include <cstdio>
namespace cg = cooperative_groups;

#ifndef COOP
#define COOP 1
#endif

typedef unsigned short bfu;
using bf16x8 = __attribute__((ext_vector_type(8))) short;
using f32x4 = __attribute__((ext_vector_type(4))) float;
using u32x4 = __attribute__((ext_vector_type(4))) unsigned;
using f32x2 = __attribute__((ext_vector_type(2))) float;

constexpr int D = 1024;
constexpr int MP = 65536;
constexpr int MS = 512;
constexpr int MT = MP + MS;
constexpr int DI = 2048;
constexpr int CONVD = 3072;
constexpr int ZXW = 5120;
constexpr int INP_N = 5152;
constexpr int INP_NP = 5376;
constexpr int DFF = 2816;
constexpr int SKV = 1088;
constexpr float EPS = 1e-6f;
constexpr float LAMBDA_INIT = 0.35550906759f;
constexpr float QSCALE = 0.125f * 1.4426950408889634f;

constexpr size_t O_Y = 0;
constexpr size_t O_CONVP = 67633152;
constexpr size_t O_SSMP = 67780608;
constexpr size_t O_KP = 71974912;
constexpr size_t O_VP = 139083776;
constexpr size_t O_CONVS = 206192640;
constexpr size_t O_SSMS = 206266368;
constexpr size_t O_KS = 208363520;
constexpr size_t O_VS = 208887808;

constexpr size_t WS_W_INP = 0;
constexpr size_t WS_W_OUTP = WS_W_INP + (size_t)INP_NP * 1024 * 2;
constexpr size_t WS_W_GU0 = WS_W_OUTP + (size_t)1024 * 2048 * 2;
constexpr size_t WS_W_DN0 = WS_W_GU0 + (size_t)5632 * 1024 * 2;
constexpr size_t WS_W_QKV = WS_W_DN0 + (size_t)1024 * 2816 * 2;
constexpr size_t WS_W_AO = WS_W_QKV + (size_t)3072 * 1024 * 2;
constexpr size_t WS_W_GU1 = WS_W_AO + (size_t)1024 * 1024 * 2;
constexpr size_t WS_W_DN1 = WS_W_GU1 + (size_t)5632 * 1024 * 2;
constexpr size_t WS_XN = WS_W_DN1 + (size_t)1024 * 2816 * 2;
constexpr size_t WS_DT = WS_XN + (size_t)MT * 1024 * 2;
constexpr size_t WS_SSQ = WS_DT + (size_t)MT * 32 * 4;
constexpr size_t WS_BIG = WS_SSQ + (size_t)MT * 16 * 4;
constexpr size_t WS_BAR = WS_BIG + (size_t)MT * ZXW * 2;
constexpr size_t WS_XR = WS_BAR + 16384;
constexpr size_t WS_END = WS_XR + (size_t)MT * 1024 * 2;
constexpr size_t WS_Q = WS_BIG;
constexpr size_t WS_KP = WS_Q + (size_t)MT * 1024 * 2;
constexpr size_t WS_VTP = WS_KP + (size_t)MP * 1024 * 2;
constexpr size_t WS_KSM = WS_VTP + (size_t)MP * 1024 * 2;
constexpr size_t WS_VTS = WS_KSM + (size_t)8 * SKV * 1024 * 2;
constexpr size_t WS_AO = WS_VTS + (size_t)8 * SKV * 1024 * 2;
static_assert(WS_AO + (size_t)MT * 1024 * 2 <= WS_BAR, "layer-1 aliases overflow");
static_assert((size_t)MT * DFF * 2 <= WS_KSM - WS_BIG, "ffn h overlaps sample K");

constexpr int LDS_BYTES = 159744;
constexpr int NPH = 15;

struct Params {
  const float* in[27];
  float* out;
  unsigned char* ws;
  int ph_lo, ph_hi;
};
typedef const __attribute__((address_space(4))) Params* KP;

__device__ __forceinline__ bfu f2bf(float f) {
  unsigned u = __float_as_uint(f);
  u += 0x7fffu + ((u >> 16) & 1u);
  return (bfu)(u >> 16);
}
__device__ __forceinline__ float bf2f(bfu h) { return __uint_as_float(((unsigned)h) << 16); }
__device__ __forceinline__ unsigned pack2(float a, float b) { return (unsigned)f2bf(a) | ((unsigned)f2bf(b) << 16); }
__device__ __forceinline__ unsigned cvt_pk_bf16(float lo, float hi) {
  unsigned r;
  asm volatile("v_cvt_pk_bf16_f32 %0, %1, %2" : "=v"(r) : "v"(lo), "v"(hi));
  return r;
}
__device__ __forceinline__ float silu_f(float x) { return x * __builtin_amdgcn_rcpf(1.f + __expf(-x)); }
__device__ __forceinline__ float shx(float v, int mask, int lane) {
  return __int_as_float(__builtin_amdgcn_ds_bpermute((lane ^ mask) << 2, __float_as_int(v)));
}
__device__ __forceinline__ float shup(float v, int d, int lane) {
  return __int_as_float(__builtin_amdgcn_ds_bpermute((lane - d) << 2, __float_as_int(v)));
}
__device__ __forceinline__ float shidx(float v, int src) {
  return __int_as_float(__builtin_amdgcn_ds_bpermute(src << 2, __float_as_int(v)));
}
__device__ __forceinline__ float wave_sum(float v, int lane) {
#pragma unroll
  for (int o = 32; o >= 1; o >>= 1) v += shx(v, o, lane);
  return v;
}
__device__ __forceinline__ f32x4 mfma16(bf16x8 a, bf16x8 b, f32x4 c) {
  return __builtin_amdgcn_mfma_f32_16x16x32_bf16(a, b, c, 0, 0, 0);
}
__device__ __forceinline__ int opaque_tid(int wv) {
  int lane;
  asm volatile("v_mbcnt_lo_u32_b32 %0, -1, 0\n\tv_mbcnt_hi_u32_b32 %0, -1, %0" : "=v"(lane));
  return wv * 64 + lane;
}
__device__ __forceinline__ float xmax_16_32(float v) {
  auto a = __builtin_amdgcn_permlane16_swap(__float_as_uint(v), __float_as_uint(v), false, false);
  v = fmaxf(__uint_as_float(a[0]), __uint_as_float(a[1]));
  auto b = __builtin_amdgcn_permlane32_swap(__float_as_uint(v), __float_as_uint(v), false, false);
  return fmaxf(__uint_as_float(b[0]), __uint_as_float(b[1]));
}
__device__ __forceinline__ float xsum_16_32(float v) {
  auto a = __builtin_amdgcn_permlane16_swap(__float_as_uint(v), __float_as_uint(v), false, false);
  v = __uint_as_float(a[0]) + __uint_as_float(a[1]);
  auto b = __builtin_amdgcn_permlane32_swap(__float_as_uint(v), __float_as_uint(v), false, false);
  return __uint_as_float(b[0]) + __uint_as_float(b[1]);
}
__device__ __forceinline__ float row16_sum(float v) {
  v += __int_as_float(__builtin_amdgcn_update_dpp(0, __float_as_int(v), 0xB1, 0xf, 0xf, true));
  v += __int_as_float(__builtin_amdgcn_update_dpp(0, __float_as_int(v), 0x4E, 0xf, 0xf, true));
  v += __int_as_float(__builtin_amdgcn_update_dpp(0, __float_as_int(v), 0x141, 0xf, 0xf, true));
  v += __int_as_float(__builtin_amdgcn_update_dpp(0, __float_as_int(v), 0x140, 0xf, 0xf, true));
  return v;
}
__device__ __forceinline__ f32x4 bf4_to_f32(uint2 u) {
  return f32x4{__uint_as_float(u.x << 16), __uint_as_float(u.x & 0xffff0000u), __uint_as_float(u.y << 16), __uint_as_float(u.y & 0xffff0000u)};
}
__device__ __forceinline__ void lds_barrier() {
  asm volatile("s_waitcnt lgkmcnt(0)" ::: "memory");
  __builtin_amdgcn_s_barrier();
  asm volatile("" ::: "memory");
}
__device__ __forceinline__ bf16x8 lds_b128(const bfu* p) { return *reinterpret_cast<const bf16x8*>(p); }

__device__ __forceinline__ void conv_tile(const float* __restrict__ src, const float* __restrict__ src2, const float* __restrict__ scale,
                                          bfu* __restrict__ dst, int Nsrc, int mode, int dstStride, int kt, int nt, float* sT, const int tid) {
  __syncthreads();
#pragma unroll
  for (int i = 0; i < 8; ++i) {
    int idx = tid + i * 512;
    int kk = idx >> 6, rr = idx & 63;
    int r = nt * 64 + rr;
    size_t k = (size_t)(kt * 64 + kk);
    float v = 0.f;
    if (mode == 0) {
      if (r < Nsrc) v = src[k * Nsrc + r];
    } else if (mode == 1) {
      int blk = r >> 5, w = r & 31;
      int sc = blk * 16 + (w & 15);
      v = (w < 16 ? src : src2)[k * Nsrc + sc];
    } else {
      int sc = r;
      if (r < 2048) {
        int pos = r & 63, pb = pos >> 4;
        int tb = (pb == 1) ? 2 : ((pb == 2) ? 1 : pb);
        sc = (r & ~63) + tb * 16 + (pos & 15);
      }
      v = src[k * Nsrc + sc];
    }
    sT[kk * 65 + rr] = v;
  }
  __syncthreads();
#pragma unroll
  for (int i = 0; i < 8; ++i) {
    int idx = tid + i * 512;
    int rr = idx >> 6, kk = idx & 63;
    float v = sT[kk * 65 + rr];
    if (scale) v *= scale[kt * 64 + kk];
    dst[(size_t)(nt * 64 + rr) * dstStride + kt * 64 + kk] = f2bf(v);
  }
}

__device__ __forceinline__ void phase_convert_weights(KP P, char* smem, const int wv) {
  float* sT = (float*)smem;
  const int tid = opaque_tid(wv);
  for (int t = blockIdx.x; t < 7104; t += gridDim.x) {
    const float *src, *src2 = nullptr, *scale = nullptr;
    bfu* dst;
    int K, Nsrc, mode = 0, lt;
    if (t < 1344) { lt = t; src = P->in[9]; dst = (bfu*)(P->ws + WS_W_INP); K = 1024; Nsrc = INP_N; }
    else if (t < 1856) { lt = t - 1344; src = P->in[16]; scale = P->in[15]; dst = (bfu*)(P->ws + WS_W_OUTP); K = 2048; Nsrc = 1024; }
    else if (t < 3264) { lt = t - 1856; src = P->in[24]; src2 = P->in[25]; dst = (bfu*)(P->ws + WS_W_GU0); K = 1024; Nsrc = DFF; mode = 1; }
    else if (t < 3968) { lt = t - 3264; src = P->in[26]; dst = (bfu*)(P->ws + WS_W_DN0); K = 2816; Nsrc = 1024; }
    else if (t < 4736) { lt = t - 3968; src = P->in[17]; dst = (bfu*)(P->ws + WS_W_QKV); K = 1024; Nsrc = 3072; mode = 2; }
    else if (t < 4992) { lt = t - 4736; src = P->in[23]; dst = (bfu*)(P->ws + WS_W_AO); K = 1024; Nsrc = 1024; }
    else if (t < 6400) { lt = t - 4992; src = P->in[24] + (size_t)1024 * DFF; src2 = P->in[25] + (size_t)1024 * DFF; dst = (bfu*)(P->ws + WS_W_GU1); K = 1024; Nsrc = DFF; mode = 1; }
    else { lt = t - 6400; src = P->in[26] + (size_t)DFF * 1024; dst = (bfu*)(P->ws + WS_W_DN1); K = 2816; Nsrc = 1024; }
    int nkt = K / 64;
    int kt = lt % nkt, nt = lt / nkt;
    conv_tile(src, src2, scale, dst, Nsrc, mode, K, kt, nt, sT, tid);
  }
}

__device__ __forceinline__ void phase_convert_cache(KP P, char* smem, const int wv) {
  float* sT = (float*)smem;
  const int tid = opaque_tid(wv);
  bfu* ks = (bfu*)(P->ws + WS_KSM);
  bfu* vts = (bfu*)(P->ws + WS_VTS);
  const float* ck = P->in[4];
  const float* cv = P->in[5];
  for (size_t i = (size_t)blockIdx.x * 512 + tid; i < (size_t)8 * 1024 * 256; i += (size_t)gridDim.x * 512) {
    size_t e = i * 4;
    int b = (int)(e >> 20);
    size_t rem = e & ((1u << 20) - 1);
    float4 v = *(const float4*)(ck + e);
    uint2 o; o.x = pack2(v.x, v.y); o.y = pack2(v.z, v.w);
    *(uint2*)(ks + (size_t)b * SKV * 1024 + rem) = o;
  }
  for (int t = blockIdx.x; t < 8 * 256; t += gridDim.x) {
    int b = t >> 8, lt = t & 255;
    int kt = lt & 15, nt = lt >> 4;
    conv_tile(cv + (size_t)b * 1024 * 1024, nullptr, nullptr, vts + (size_t)b * 1024 * SKV, 1024, 0, SKV, kt, nt, sT, tid);
  }
}

template <bool FINAL, bool SRCB>
__device__ __forceinline__ void phase_norm(const float* xa, const float* xb, const bfu* xr, const float* w, bfu* dst, float* fdst, const int wv) {
  const int tid_ = opaque_tid(wv);
  const int lane = tid_ & 63, wid = tid_ >> 6;
  f32x4 w4[4];
#pragma unroll
  for (int i = 0; i < 4; ++i) w4[i] = ((const f32x4*)w)[i * 64 + lane];
  for (int row = blockIdx.x * 8 + wid; row < MT / 2; row += gridDim.x * 8) {
    f32x4 v[2][4];
    float ss[2] = {0.f, 0.f};
#pragma unroll
    for (int h = 0; h < 2; ++h) {
      const int r = row + h * (MT / 2);
      if (SRCB) {
#pragma unroll
        for (int i = 0; i < 4; ++i) v[h][i] = bf4_to_f32(((const uint2*)(xr + (size_t)r * D))[i * 64 + lane]);
      } else {
        const float* x = r < MP ? xa + (size_t)r * D : xb + (size_t)(r - MP) * D;
#pragma unroll
        for (int i = 0; i < 4; ++i) v[h][i] = ((const f32x4*)x)[i * 64 + lane];
      }
    }
#pragma unroll
    for (int h = 0; h < 2; ++h) {
#pragma unroll
      for (int i = 0; i < 4; ++i) ss[h] += v[h][i][0] * v[h][i][0] + v[h][i][1] * v[h][i][1] + v[h][i][2] * v[h][i][2] + v[h][i][3] * v[h][i][3];
      ss[h] = wave_sum(ss[h], lane);
    }
#pragma unroll
    for (int h = 0; h < 2; ++h) {
      const int r = row + h * (MT / 2);
      const float rstd = rsqrtf(ss[h] * (1.f / D) + EPS);
#pragma unroll
      for (int i = 0; i < 4; ++i) {
        f32x4 o = v[h][i] * rstd * w4[i];
        if (FINAL) {
          ((f32x4*)(fdst + (size_t)r * D))[i * 64 + lane] = o;
        } else {
          uint2 pk; pk.x = cvt_pk_bf16(o[0], o[1]); pk.y = cvt_pk_bf16(o[2], o[3]);
          ((uint2*)(dst + (size_t)r * D))[i * 64 + lane] = pk;
        }
      }
    }
  }
}

enum { EPI_INPROJ = 0, EPI_OUTPROJ = 1, EPI_RES = 2, EPI_GU = 3, EPI_QKV = 4 };
#define LAS __attribute__((address_space(3)))
constexpr int HT_B = 128 * 64 * 2;
__device__ __forceinline__ int lds_byte(int r, int c) {
  int st = (r >> 4) * 2 + (c >> 5), rr = r & 15, cc = c & 31, ob = rr * 64 + cc * 2;
  return st * 1024 + (ob ^ (((ob >> 9) & 1) << 5));
}
__device__ __forceinline__ void stage_rc(int b, int& R, int& C) {
  int st = b / 1024, sb = b % 1024, swz = sb ^ (((sb >> 9) & 1) << 5);
  R = (st >> 1) * 16 + swz / 64;
  C = (st & 1) * 32 + (swz % 64) / 2;
}
__device__ __forceinline__ float softplus_f(float x) { return x > 20.f ? x : log1pf(__expf(x)); }

__device__ __forceinline__ float ssd_rstd(const float* __restrict__ ssq, int row) {
  const f32x4* p = (const f32x4*)(ssq + (size_t)row * 16);
  f32x4 a = p[0], b = p[1], c = p[2], d = p[3];
  float sm = (a[0] + a[1]) + (a[2] + a[3]) + (b[0] + b[1]) + (b[2] + b[3]) + (c[0] + c[1]) + (c[2] + c[3]) + (d[0] + d[1]) + (d[2] + d[3]);
  return rsqrtf(sm * (1.f / DI) + EPS);
}

template <int EPI>
__device__ __forceinline__ void gemm_acc_init(KP P, f32x4 (&acc)[2][2][4][2], int brow, int bcol, int wr, int wc, int fr_, int fq_, const float* sRu) {
  if (EPI == EPI_OUTPROJ || EPI == EPI_RES) {
    int fr = fr_, fq = fq_;
    asm volatile("" : "+v"(fr), "+v"(fq));
    const float* xin = (brow < MP ? P->in[0] + (size_t)brow * D : P->in[1] + (size_t)(brow - MP) * D) + bcol;
    const bfu* xrb = (const bfu*)(P->ws + WS_XR) + (size_t)brow * D + bcol;
#pragma unroll
    for (int ai = 0; ai < 2; ++ai)
#pragma unroll
      for (int m = 0; m < 4; ++m) {
        __builtin_amdgcn_sched_barrier(0);
        unsigned lr = ai * 128 + wr * 64 + m * 16 + fr;
        unsigned o = lr * D + wc * 32 + fq * 4;
        float sc = 1.f;
        if (EPI == EPI_OUTPROJ) sc = 1.f / sRu[lr];
#pragma unroll
        for (int bj = 0; bj < 2; ++bj)
#pragma unroll
          for (int n = 0; n < 2; ++n) {
            if (EPI == EPI_RES) acc[ai][bj][m][n] = bf4_to_f32(*(const uint2*)(xrb + o + bj * 128 + n * 16));
            else acc[ai][bj][m][n] = *(const f32x4*)(xin + o + bj * 128 + n * 16) * sc;
          }
      }
  } else {
#pragma unroll
    for (int ai = 0; ai < 2; ++ai)
#pragma unroll
      for (int bj = 0; bj < 2; ++bj)
#pragma unroll
        for (int m = 0; m < 4; ++m)
#pragma unroll
          for (int n = 0; n < 2; ++n) acc[ai][bj][m][n] = f32x4{0.f, 0.f, 0.f, 0.f};
  }
}

template <int EPI>
__device__ __forceinline__ void gemm_epilogue(KP P, f32x4 (&acc)[2][2][4][2], int brow, int bcol, int wr, int wc, int fr_, int fq_, const float* sRu) {
  int fr = fr_, fq = fq_;
  asm volatile("" : "+v"(fr), "+v"(fq));
  const unsigned lrow0 = wr * 64 + fr;
  const unsigned lcol0 = wc * 32 + fq * 4;
  if (EPI == EPI_INPROJ) {
    if (bcol < ZXW) {
      bfu* zxb = (bfu*)(P->ws + WS_BIG) + (size_t)brow * ZXW + bcol;
#pragma unroll
      for (int ai = 0; ai < 2; ++ai)
#pragma unroll
        for (int m = 0; m < 4; ++m) {
          __builtin_amdgcn_sched_barrier(0);
          unsigned o = (lrow0 + ai * 128 + m * 16) * ZXW + lcol0;
#pragma unroll
          for (int bj = 0; bj < 2; ++bj)
#pragma unroll
            for (int n = 0; n < 2; ++n) {
              f32x4 v = acc[ai][bj][m][n];
              uint2 pk; pk.x = cvt_pk_bf16(v[0], v[1]); pk.y = cvt_pk_bf16(v[2], v[3]);
              *(uint2*)(zxb + o + bj * 128 + n * 16) = pk;
            }
        }
      const bool has_tail = (brow >= MP) || (((brow + 256) & 4095) == 0);
      if (has_tail && bcol >= DI) {
#pragma unroll
        for (int ai = 0; ai < 2; ++ai)
#pragma unroll
          for (int m = 0; m < 4; ++m) {
            __builtin_amdgcn_sched_barrier(0);
            int row = brow + lrow0 + ai * 128 + m * 16;
            float* dst = nullptr;
            if (row < MP) {
              int t = row & 4095;
              if (t >= 4093) dst = P->out + O_CONVP + ((size_t)(row >> 12) * 3 + (t - 4093)) * CONVD;
            } else {
              int rs = row - MP, t = rs & 63;
              if (t >= 61) dst = P->out + O_CONVS + ((size_t)(rs >> 6) * 3 + (t - 61)) * CONVD;
            }
            if (dst) {
              unsigned o = bcol - DI + lcol0;
#pragma unroll
              for (int bj = 0; bj < 2; ++bj)
#pragma unroll
                for (int n = 0; n < 2; ++n) *(f32x4*)(dst + o + bj * 128 + n * 16) = acc[ai][bj][m][n];
            }
          }
      }
    } else {
      if (wc == 0) {
        float* dtb = (float*)(P->ws + WS_DT) + (size_t)brow * 32;
        const float* dtbias = P->in[12];
        const f32x4 b0 = *(const f32x4*)(dtbias + fq * 4), b1 = *(const f32x4*)(dtbias + 16 + fq * 4);
#pragma unroll
        for (int ai = 0; ai < 2; ++ai)
#pragma unroll
          for (int m = 0; m < 4; ++m) {
            __builtin_amdgcn_sched_barrier(0);
            unsigned o = (lrow0 + ai * 128 + m * 16) * 32 + fq * 4;
            f32x4 x0 = acc[ai][0][m][0] + b0, x1 = acc[ai][0][m][1] + b1;
            f32x4 d0, d1;
#pragma unroll
            for (int j = 0; j < 4; ++j) { d0[j] = softplus_f(x0[j]); d1[j] = softplus_f(x1[j]); }
            *(f32x4*)(dtb + o) = d0;
            *(f32x4*)(dtb + o + 16) = d1;
          }
      }
    }
  } else if (EPI == EPI_OUTPROJ || EPI == EPI_RES) {
    bfu* xo = (bfu*)(P->ws + WS_XR) + (size_t)brow * D + bcol;
#pragma unroll
    for (int ai = 0; ai < 2; ++ai)
#pragma unroll
      for (int m = 0; m < 4; ++m) {
        __builtin_amdgcn_sched_barrier(0);
        unsigned lr = lrow0 + ai * 128 + m * 16;
        unsigned o = lr * D + lcol0;
        float rsd = 1.f;
        if (EPI == EPI_OUTPROJ) rsd = sRu[lr];
#pragma unroll
        for (int bj = 0; bj < 2; ++bj)
#pragma unroll
          for (int n = 0; n < 2; ++n) {
            f32x4 v = acc[ai][bj][m][n] * rsd;
            uint2 pk; pk.x = cvt_pk_bf16(v[0], v[1]); pk.y = cvt_pk_bf16(v[2], v[3]);
            *(uint2*)(xo + o + bj * 128 + n * 16) = pk;
          }
      }
  } else if (EPI == EPI_GU) {
    bfu* hb = (bfu*)(P->ws + WS_BIG) + (size_t)brow * DFF + (bcol >> 1);
#pragma unroll
    for (int ai = 0; ai < 2; ++ai)
#pragma unroll
      for (int m = 0; m < 4; ++m) {
        __builtin_amdgcn_sched_barrier(0);
        unsigned o = (lrow0 + ai * 128 + m * 16) * DFF + wc * 16 + fq * 4;
#pragma unroll
        for (int bj = 0; bj < 2; ++bj) {
          f32x4 g = acc[ai][bj][m][0], u = acc[ai][bj][m][1];
          uint2 pk;
          pk.x = cvt_pk_bf16(silu_f(g[0]) * u[0], silu_f(g[1]) * u[1]);
          pk.y = cvt_pk_bf16(silu_f(g[2]) * u[2], silu_f(g[3]) * u[3]);
          *(uint2*)(hb + o + bj * 64) = pk;
        }
      }
  } else if (EPI == EPI_QKV) {
    const bool prompt = brow < MP;
    if (bcol < 2048) {
      const bool isq = bcol < 1024;
#pragma unroll
      for (int bj = 0; bj < 2; ++bj) {
        const int col32 = bcol + bj * 128 + wc * 32;
        int frb = fr, fqb = fq;
        asm volatile("" : "+v"(frb), "+v"(fqb));
        const unsigned lrow0b = wr * 64 + frb;
        const int d0 = ((col32 >> 5) & 1) * 16 + fqb * 4;
        float inv[4];
#pragma unroll
        for (int j = 0; j < 4; ++j) inv[j] = exp2f(-(float)(d0 + j) * (13.287712379549449f / 32.f)) * 0.15915494309189535f;
        const unsigned c1 = (col32 & ~63 & 1023) + d0;
        bfu* bdst;
        float* fdst = nullptr;
        if (isq) bdst = (bfu*)(P->ws + WS_Q) + (size_t)brow * 1024;
        else if (prompt) { bdst = (bfu*)(P->ws + WS_KP) + (size_t)brow * 1024; fdst = P->out + O_KP + (size_t)brow * 1024; }
        else { bdst = (bfu*)(P->ws + WS_KSM); fdst = P->out + O_KS + (size_t)(brow - MP) * 1024; }
#pragma unroll
        for (int ai = 0; ai < 2; ++ai)
#pragma unroll
          for (int m = 0; m < 4; ++m) {
            __builtin_amdgcn_sched_barrier(0);
            unsigned lr = lrow0b + ai * 128 + m * 16;
            int row = brow + lr;
            int pos = prompt ? (row & 4095) : 1024 + ((row - MP) & 63);
            f32x4 x1 = acc[ai][bj][m][0], x2 = acc[ai][bj][m][1], o1, o2;
#pragma unroll
            for (int j = 0; j < 4; ++j) {
              float rev = (float)pos * inv[j];
              rev -= floorf(rev);
              float sn = __builtin_amdgcn_sinf(rev), cs = __builtin_amdgcn_cosf(rev);
              o1[j] = x1[j] * cs - x2[j] * sn;
              o2[j] = x2[j] * cs + x1[j] * sn;
            }
            if (isq) {
              uint2 p1, p2;
              p1.x = cvt_pk_bf16(o1[0] * QSCALE, o1[1] * QSCALE); p1.y = cvt_pk_bf16(o1[2] * QSCALE, o1[3] * QSCALE);
              p2.x = cvt_pk_bf16(o2[0] * QSCALE, o2[1] * QSCALE); p2.y = cvt_pk_bf16(o2[2] * QSCALE, o2[3] * QSCALE);
              *(uint2*)(bdst + lr * 1024 + c1) = p1;
              *(uint2*)(bdst + lr * 1024 + c1 + 32) = p2;
            } else {
              *(f32x4*)(fdst + lr * 1024 + c1) = o1;
              *(f32x4*)(fdst + lr * 1024 + c1 + 32) = o2;
              unsigned bo;
              if (prompt) bo = lr * 1024 + c1;
              else { int rs = row - MP; bo = ((rs >> 6) * SKV + 1024 + (rs & 63)) * 1024 + c1; }
              uint2 p1, p2;
              p1.x = cvt_pk_bf16(o1[0], o1[1]); p1.y = cvt_pk_bf16(o1[2], o1[3]);
              p2.x = cvt_pk_bf16(o2[0], o2[1]); p2.y = cvt_pk_bf16(o2[2], o2[3]);
              *(uint2*)(bdst + bo) = p1;
              *(uint2*)(bdst + bo + 32) = p2;
            }
          }
      }
    } else {
      float* fdst = prompt ? P->out + O_VP + (size_t)brow * 1024 + (bcol - 2048) : P->out + O_VS + (size_t)(brow - MP) * 1024 + (bcol - 2048);
      bfu* vt = prompt ? (bfu*)(P->ws + WS_VTP) : (bfu*)(P->ws + WS_VTS);
#pragma unroll
      for (int ai = 0; ai < 2; ++ai)
#pragma unroll
        for (int m = 0; m < 4; ++m) {
          __builtin_amdgcn_sched_barrier(0);
          unsigned lr = lrow0 + ai * 128 + m * 16;
          int row = brow + lr;
          size_t tb;
          unsigned tstr;
          if (prompt) { tb = (size_t)(row >> 12) * 1024 * 4096 + (row & 4095); tstr = 4096; }
          else { int rs = row - MP; tb = (size_t)(rs >> 6) * 1024 * SKV + 1024 + (rs & 63); tstr = SKV; }
#pragma unroll
          for (int bj = 0; bj < 2; ++bj)
#pragma unroll
            for (int n = 0; n < 2; ++n) {
              f32x4 v = acc[ai][bj][m][n];
              unsigned lc = lcol0 + bj * 128 + n * 16;
              *(f32x4*)(fdst + lr * 1024 + lc) = v;
              unsigned c = bcol - 2048 + lc;
#pragma unroll
              for (int j = 0; j < 4; ++j) vt[tb + (size_t)(c + j) * tstr] = f2bf(v[j]);
            }
        }
    }
  }
}

template <int EPI>
__device__ __forceinline__ void gemm_phase(KP P, const bfu* __restrict__ A, const bfu* __restrict__ Bt, int K, int ntn, char* smem, const int wv) {
  const int tid = opaque_tid(wv), wid = wv, lane = tid & 63, wr = wid >> 2, wc = wid & 3, fr = lane & 15, fq = lane >> 4;
  LAS unsigned char* lds = (LAS unsigned char*)smem;
  constexpr bool SPLIT_SAMPLE = (EPI == EPI_OUTPROJ || EPI == EPI_RES);
  const int ntm = SPLIT_SAMPLE ? MP / 256 : MT / 256;
  const int ntiles = ntm * ntn;
  const int nig = 8 * ntn;
  const int nt = K / 64;
  const int G = gridDim.x, xper = G >> 3;
  const int vb = ((G & 7) == 0) ? (int)(blockIdx.x & 7) * xper + (int)(blockIdx.x >> 3) : (int)blockIdx.x;
  if (!SPLIT_SAMPLE && vb >= ntiles) return;
  unsigned voff[2];
#pragma unroll
  for (int i = 0; i < 2; ++i) { int R, C; stage_rc(tid * 16 + i * 8192, R, C); voff[i] = (unsigned)(R * K + C) * 2u; }
  const size_t kstep = (size_t)(64 * 2);
  const size_t hstep = (size_t)128 * K * 2;
  const size_t tstep = 2 * hstep;
  const unsigned ldsw = (unsigned)wid * 1024u;
  const int aoff = lds_byte(wr * 64 + fr, fq * 8), boff = lds_byte(wc * 32 + fr, fq * 8);
#define PG8_SA(b, h) (((b) * 2 + (h)) * HT_B)
#define PG8_SB(b, h) ((4 + (b) * 2 + (h)) * HT_B)
#define PG8_STAGE(bufoff, gbase) do { _Pragma("unroll") for (int _i = 0; _i < 2; ++_i) \
    __builtin_amdgcn_global_load_lds((const unsigned*)((const char*)(gbase) + voff[_i]), (LAS unsigned*)(lds + (bufoff) + ldsw + _i * 8192), 16, 0, 0); } while (0)
#define PG8_LDA(dst, b, h) do { _Pragma("unroll") for (int m = 0; m < 4; ++m) _Pragma("unroll") for (int k = 0; k < 2; ++k) dst[m][k] = *(const LAS bf16x8*)(lds + PG8_SA(b, h) + aoff + m * 2048 + k * 1024); } while (0)
#define PG8_LDB(dst, b, h) do { _Pragma("unroll") for (int n = 0; n < 2; ++n) _Pragma("unroll") for (int k = 0; k < 2; ++k) dst[n][k] = *(const LAS bf16x8*)(lds + PG8_SB(b, h) + boff + n * 2048 + k * 1024); } while (0)
#define PG8_MMA(ai, bj, At, Bt_) do { __builtin_amdgcn_s_setprio(1); _Pragma("unroll") for (int m = 0; m < 4; ++m) _Pragma("unroll") for (int n = 0; n < 2; ++n) _Pragma("unroll") for (int k = 0; k < 2; ++k) \
    acc[ai][bj][m][n] = __builtin_amdgcn_mfma_f32_16x16x32_bf16(Bt_[n][k], At[m][k], acc[ai][bj][m][n], 0, 0, 0); __builtin_amdgcn_s_setprio(0); } while (0)
#define PG8_WAIT_V(n) asm volatile("s_waitcnt vmcnt(" #n ")" ::: "memory")
#define PG8_WAIT_L(n) asm volatile("s_waitcnt lgkmcnt(" #n ")" ::: "memory")
#define PG8_BAR __builtin_amdgcn_s_barrier()
#define PG8_SCHED __builtin_amdgcn_sched_barrier(0)
#define TILE_PMPN(t, pm, pn) do { int gid_ = (t) / nig, fm_ = gid_ * 8, gsz_ = min(ntm - fm_, 8); pm = fm_ + ((t) % nig) % gsz_; pn = ((t) % nig) / gsz_; } while (0)
  int ctile = vb, cpm, cpn;
  TILE_PMPN(ctile, cpm, cpn);
  f32x4 acc[2][2][4][2];
  __syncthreads();
  const float* sRu = (const float*)(smem + 131072);
  if (EPI == EPI_OUTPROJ) {
    float* sR = (float*)(smem + 131072);
    const float* ssq = (const float*)(P->ws + WS_SSQ);
    int ui = 0;
    for (int t = vb; t < ntiles && ui < 8; t += G, ++ui) {
      int pm, pn;
      TILE_PMPN(t, pm, pn);
      if (tid < 256) sR[ui * 256 + tid] = ssd_rstd(ssq, pm * 256 + tid);
    }
    __syncthreads();
  }
  gemm_acc_init<EPI>(P, acc, cpm * 256, cpn * 256, wr, wc, fr, fq, sRu);
  bf16x8 At[4][2], B0[2][2], B1[2][2];
  const char* cA = (const char*)A + (size_t)cpm * tstep;
  const char* cB = (const char*)Bt + (size_t)cpn * tstep;
  PG8_STAGE(PG8_SB(0, 0), cB); PG8_STAGE(PG8_SA(0, 0), cA); PG8_STAGE(PG8_SB(0, 1), cB + hstep); PG8_STAGE(PG8_SA(0, 1), cA + hstep);
  if (wr == 1) PG8_BAR;
  PG8_WAIT_V(4); PG8_BAR;
  PG8_STAGE(PG8_SB(1, 0), cB + kstep); PG8_STAGE(PG8_SA(1, 0), cA + kstep); PG8_STAGE(PG8_SB(1, 1), cB + hstep + kstep);
  PG8_WAIT_V(6); PG8_BAR;
  for (;;) {
    const int ntile = ctile + G;
    const bool has_next = ntile < ntiles;
    int npm = cpm, npn = cpn;
    if (has_next) TILE_PMPN(ntile, npm, npn);
    const char* nA = (const char*)A + (size_t)npm * tstep;
    const char* nB = (const char*)Bt + (size_t)npn * tstep;
    for (int t = 0; t < nt; t += 2) {
      const bool last = (t == nt - 2);
      const char* a1 = cA + (size_t)(t + 1) * kstep;
      const char* a2 = last ? nA : cA + (size_t)(t + 2) * kstep;
      const char* b2 = last ? nB : cB + (size_t)(t + 2) * kstep;
      const char* a3 = a2 + kstep;
      const char* b3 = b2 + kstep;
      PG8_LDB(B0, 0, 0); PG8_SCHED; PG8_LDA(At, 0, 0); PG8_STAGE(PG8_SA(1, 1), a1 + hstep);
      PG8_WAIT_L(8); PG8_BAR; PG8_WAIT_L(0); PG8_MMA(0, 0, At, B0); PG8_BAR; PG8_SCHED;
      PG8_LDB(B1, 0, 1); PG8_STAGE(PG8_SB(0, 0), b2);
      PG8_BAR; PG8_WAIT_L(0); PG8_MMA(0, 1, At, B1); PG8_BAR;
      PG8_LDA(At, 0, 1); PG8_STAGE(PG8_SA(0, 0), a2);
      PG8_BAR; PG8_WAIT_L(0); PG8_MMA(1, 0, At, B0); PG8_BAR; PG8_SCHED;
      PG8_STAGE(PG8_SB(0, 1), b2 + hstep);
      PG8_WAIT_V(6); PG8_BAR; PG8_MMA(1, 1, At, B1); PG8_BAR;
      PG8_LDB(B0, 1, 0); PG8_SCHED; PG8_LDA(At, 1, 0); PG8_STAGE(PG8_SA(0, 1), a2 + hstep);
      PG8_WAIT_L(8); PG8_BAR; PG8_WAIT_L(0); PG8_MMA(0, 0, At, B0); PG8_BAR; PG8_SCHED;
      PG8_LDB(B1, 1, 1); PG8_STAGE(PG8_SB(1, 0), b3);
      PG8_BAR; PG8_WAIT_L(0); PG8_MMA(0, 1, At, B1); PG8_BAR;
      PG8_LDA(At, 1, 1); PG8_STAGE(PG8_SA(1, 0), a3);
      PG8_BAR; PG8_WAIT_L(0); PG8_MMA(1, 0, At, B0); PG8_BAR; PG8_SCHED;
      PG8_STAGE(PG8_SB(1, 1), b3 + hstep);
      PG8_WAIT_V(6); PG8_BAR; PG8_MMA(1, 1, At, B1); PG8_BAR;
    }
    gemm_epilogue<EPI>(P, acc, cpm * 256, cpn * 256, wr, wc, fr, fq, sRu);
    if (!has_next) break;
    sRu += 256;
    gemm_acc_init<EPI>(P, acc, npm * 256, npn * 256, wr, wc, fr, fq, sRu);
    ctile = ntile; cpm = npm; cpn = npn; cA = nA; cB = nB;
  }
  PG8_WAIT_V(0);
  if (wr == 0) PG8_BAR;
  PG8_BAR;
  if (SPLIT_SAMPLE) {
    float* sRed = (float*)smem;
    const int kw = K >> 3;
    for (int task = blockIdx.x; task < 256; task += G) {
      const int rb = task >> 4, cb = task & 15;
      const bfu* ap = A + (size_t)(MP + rb * 32 + fr) * K + wid * kw + fq * 8;
      const bfu* bp = Bt + (size_t)(cb * 64 + fr) * K + wid * kw + fq * 8;
      f32x4 pacc[2][4];
#pragma unroll
      for (int rt = 0; rt < 2; ++rt)
#pragma unroll
        for (int ct = 0; ct < 4; ++ct) pacc[rt][ct] = f32x4{0.f, 0.f, 0.f, 0.f};
      for (int ks = 0; ks < kw; ks += 32) {
        bf16x8 af[2], bf[4];
#pragma unroll
        for (int rt = 0; rt < 2; ++rt) af[rt] = *(const bf16x8*)(ap + (size_t)rt * 16 * K + ks);
#pragma unroll
        for (int ct = 0; ct < 4; ++ct) bf[ct] = *(const bf16x8*)(bp + (size_t)ct * 16 * K + ks);
#pragma unroll
        for (int rt = 0; rt < 2; ++rt)
#pragma unroll
          for (int ct = 0; ct < 4; ++ct) pacc[rt][ct] = mfma16(af[rt], bf[ct], pacc[rt][ct]);
      }
      __syncthreads();
#pragma unroll
      for (int rt = 0; rt < 2; ++rt)
#pragma unroll
        for (int ct = 0; ct < 4; ++ct) *(f32x4*)(sRed + ((wid * 8 + rt * 4 + ct) * 64 + lane) * 4) = pacc[rt][ct];
      __syncthreads();
      {
        f32x4 sum = {0.f, 0.f, 0.f, 0.f};
#pragma unroll
        for (int ww = 0; ww < 8; ++ww) sum += *(const f32x4*)(sRed + ((ww * 8 + wid) * 64 + lane) * 4);
        const int col = cb * 64 + (wid & 3) * 16 + fr;
#pragma unroll
        for (int j = 0; j < 4; ++j) {
          const int srow = rb * 32 + (wid >> 2) * 16 + fq * 4 + j;
          bfu* op = (bfu*)(P->ws + WS_XR) + (size_t)(MP + srow) * D + col;
          if (EPI == EPI_OUTPROJ) {
            const float rs = ssd_rstd((const float*)(P->ws + WS_SSQ), MP + srow);
            *op = f2bf(P->in[1][(size_t)srow * D + col] + rs * sum[j]);
          } else {
            *op = f2bf(bf2f(*op) + sum[j]);
          }
        }
      }
    }
  }
#undef PG8_SA
#undef PG8_SB
#undef PG8_STAGE
#undef PG8_LDA
#undef PG8_LDB
#undef PG8_MMA
#undef PG8_WAIT_V
#undef PG8_WAIT_L
#undef PG8_BAR
#undef PG8_SCHED
#undef TILE_PMPN
}

constexpr int S_LDB = 136;
constexpr int S_LDT = 72;
constexpr int S_LDCB = 68;
__device__ __forceinline__ void phase_ssd(KP P, char* smem, const int wv) {
  bfu* sB = (bfu*)smem;
  bfu* sC = sB + 64 * S_LDB;
  bfu* sBT = sC + 64 * S_LDB;
  bfu* sXT = sBT + 128 * S_LDT;
  bfu* sG = sXT + 128 * S_LDT;
  bfu* sH = sG + 2 * 64 * S_LDT;
  float* sAc = (float*)(sH + 8 * 16 * S_LDB);
  float* sDt = sAc + 512;
  float* sW = sDt + 512;
  float* sSq = sW + 512;
  bfu* sZ = (bfu*)(sSq + 512);
  float* sWc = (float*)(sZ + 64 * S_LDB);
  const int tid = opaque_tid(wv), w = wv, lane = tid & 63, fr = lane & 15, fq = lane >> 4;
  const int hl = w >> 2, ps = w & 3;
  const bfu* zx = (const bfu*)(P->ws + WS_BIG);
  const float* dtb = (const float*)(P->ws + WS_DT);
  float* ssqp = (float*)(P->ws + WS_SSQ);
  bfu* yg = (bfu*)(P->out + O_KP);
  const float* convw = P->in[10];
  const float* convb = P->in[11];
  bfu* myH = sH + w * 16 * S_LDB;
  float* myAc = sAc + w * 64;
  float* myDt = sDt + w * 64;
  float* myW = sW + w * 64;
  float* mySq = sSq + w * 64;
  const bool conv_role = w < 6;

  for (int unit = blockIdx.x; unit < 384; unit += gridDim.x) {
    int seq, g, hp, row0, nch;
    const float* hist = nullptr;
    const float* h0 = nullptr;
    float* hT;
    if (unit < 256) {
      seq = unit >> 4; g = (unit >> 2) & 3; hp = unit & 3;
      row0 = seq * 4096; nch = 64;
      hT = P->out + O_SSMP + (size_t)seq * 32 * 8192;
    } else {
      int u = unit - 256;
      seq = u >> 4; g = (u >> 2) & 3; hp = u & 3;
      row0 = MP + seq * 64; nch = 1;
      hist = P->in[2] + (size_t)seq * 3 * CONVD;
      h0 = P->in[3] + (size_t)seq * 32 * 8192;
      hT = P->out + O_SSMS + (size_t)seq * 32 * 8192;
    }
    const int head = g * 8 + hp * 2 + hl;
    const float A_h = -__expf(P->in[13][head]);
    const float D_h = P->in[14][head];
    f32x4 hacc[8];
    if (h0) {
#pragma unroll
      for (int nt = 0; nt < 8; ++nt)
#pragma unroll
        for (int j = 0; j < 4; ++j) hacc[nt][j] = h0[((size_t)head * 64 + ps * 16 + fq * 4 + j) * 128 + nt * 16 + fr];
    } else {
#pragma unroll
      for (int nt = 0; nt < 8; ++nt) hacc[nt] = f32x4{0.f, 0.f, 0.f, 0.f};
    }
    __syncthreads();
#pragma unroll
    for (int nt = 0; nt < 8; ++nt)
#pragma unroll
      for (int j = 0; j < 4; ++j) myH[(fq * 4 + j) * S_LDB + nt * 16 + fr] = f2bf(hacc[nt][j]);
    const int cgp = tid % 48, rs = tid / 48;
    int cc;
    if (cgp < 16) cc = (g * 8 + hp * 2) * 64 + cgp * 8;
    else if (cgp < 32) cc = DI + g * 128 + (cgp - 16) * 8;
    else cc = DI + 512 + g * 128 + (cgp - 32) * 8;
    if (tid < 384) {
      if (rs < 5) {
        const float* src = (rs < 4) ? convw + rs * CONVD + cc : convb + cc;
        f32x4 a = *(const f32x4*)src, bq = *(const f32x4*)(src + 4);
        *(f32x4*)(sWc + rs * 384 + cgp * 8) = a;
        *(f32x4*)(sWc + rs * 384 + cgp * 8 + 4) = bq;
      }
    }
    const int zt = tid - 384;
    const int zrow = (zt >> 1) & 63, zhalf = zt & 1;

    u32x4 pre[11];
    float dtv;
    {
      const int r0 = row0;
      if (conv_role) {
        const bfu* zxc = zx + ((size_t)r0 - 3) * ZXW + DI;
#pragma unroll
        for (int k = 0; k < 11; ++k) {
          int rr = rs * 8 - 3 + k;
          if (rr < 0) {
            if (hist) {
              f32x4 a = *(const f32x4*)(hist + (3 + rr) * CONVD + cc), bq = *(const f32x4*)(hist + (3 + rr) * CONVD + cc + 4);
              pre[k] = u32x4{pack2(a[0], a[1]), pack2(a[2], a[3]), pack2(bq[0], bq[1]), pack2(bq[2], bq[3])};
            } else {
              pre[k] = u32x4{0u, 0u, 0u, 0u};
            }
          } else {
            pre[k] = *(const u32x4*)(zxc + (unsigned)((rs * 8 + k) * ZXW + cc));
          }
        }
      } else {
        const bfu* zsrc = zx + (size_t)(r0 + zrow) * ZXW + (g * 8 + hp * 2) * 64 + zhalf * 64;
#pragma unroll
        for (int k = 0; k < 8; ++k) pre[k] = *(const u32x4*)(zsrc + k * 8);
#pragma unroll
        for (int k = 8; k < 11; ++k) pre[k] = u32x4{0u, 0u, 0u, 0u};
      }
      dtv = dtb[(size_t)(r0 + lane) * 32 + head];
    }

    for (int c = 0; c < nch; ++c) {
      const int r0 = row0 + c * 64;
      lds_barrier();
      if (conv_role) {
        const float* wcol = sWc + cgp * 8;
        u32x4 ovr[8];
#pragma unroll
        for (int e2 = 0; e2 < 4; ++e2) {
          __builtin_amdgcn_sched_barrier(0);
          float w0[4], w1[4];
#pragma unroll
          for (int tap = 0; tap < 4; ++tap) { w0[tap] = wcol[tap * 384 + 2 * e2]; w1[tap] = wcol[tap * 384 + 2 * e2 + 1]; }
          const float bl = wcol[4 * 384 + 2 * e2], bh = wcol[4 * 384 + 2 * e2 + 1];
#pragma unroll
          for (int i = 0; i < 8; ++i) {
            float ylo = bl, yhi = bh;
#pragma unroll
            for (int tap = 0; tap < 4; ++tap) {
              unsigned rw = pre[i + tap][e2];
              ylo += w0[tap] * __uint_as_float(rw << 16);
              yhi += w1[tap] * __uint_as_float(rw & 0xffff0000u);
            }
            ovr[i][e2] = cvt_pk_bf16(silu_f(ylo), silu_f(yhi));
          }
        }
        if (cgp >= 16) {
          bfu* rowdst = (cgp < 32) ? (sB + (cgp - 16) * 8) : (sC + (cgp - 32) * 8);
#pragma unroll
          for (int i = 0; i < 8; ++i) *(u32x4*)(rowdst + (rs * 8 + i) * S_LDB) = ovr[i];
        }
        if (cgp < 32) {
          bfu* coldst = (cgp < 16) ? (sXT + (cgp * 8) * S_LDT + rs * 8) : (sBT + ((cgp - 16) * 8) * S_LDT + rs * 8);
#pragma unroll
          for (int e = 0; e < 8; ++e) {
            const int e2 = e >> 1, sh = (e & 1) * 16;
            u32x4 o;
            o[0] = ((ovr[0][e2] >> sh) & 0xffffu) | ((ovr[1][e2] >> sh) << 16);
            o[1] = ((ovr[2][e2] >> sh) & 0xffffu) | ((ovr[3][e2] >> sh) << 16);
            o[2] = ((ovr[4][e2] >> sh) & 0xffffu) | ((ovr[5][e2] >> sh) << 16);
            o[3] = ((ovr[6][e2] >> sh) & 0xffffu) | ((ovr[7][e2] >> sh) << 16);
            *(u32x4*)(coldst + e * S_LDT) = o;
          }
        }
      } else {
#pragma unroll
        for (int k = 0; k < 8; ++k) *(u32x4*)(sZ + zrow * S_LDB + zhalf * 64 + k * 8) = pre[k];
      }
      float a63;
      {
        float ac = dtv * A_h;
#pragma unroll
        for (int o = 1; o < 64; o <<= 1) {
          float t = shup(ac, o, lane);
          if (lane >= o) ac += t;
        }
        a63 = shidx(ac, 63);
        myAc[lane] = ac;
        myDt[lane] = dtv;
        myW[lane] = __expf(a63 - ac) * dtv;
      }
      lds_barrier();
      if (c + 1 < nch) {
        const int r1 = r0 + 64;
        int rsl = rs;
        asm volatile("" : "+v"(rsl));
        if (conv_role) {
          const bfu* zxc = zx + ((size_t)r1 - 3) * ZXW + DI;
#pragma unroll
          for (int k = 0; k < 11; ++k) pre[k] = *(const u32x4*)(zxc + (unsigned)((rsl * 8 + k) * ZXW + cc));
        } else {
          const bfu* zsrc = zx + (size_t)(r1 + zrow) * ZXW + (g * 8 + hp * 2) * 64 + zhalf * 64;
#pragma unroll
          for (int k = 0; k < 8; ++k) pre[k] = *(const u32x4*)(zsrc + k * 8);
        }
        dtv = dtb[(size_t)(r1 + lane) * 32 + head];
      }
      int frc = fr, fqc = fq;
      asm volatile("" : "+v"(frc), "+v"(fqc));
      {
        const int it = w >> 1, jt0 = (w & 1) * 2;
        f32x4 cb[2] = {{0.f, 0.f, 0.f, 0.f}, {0.f, 0.f, 0.f, 0.f}};
#pragma unroll
        for (int ks = 0; ks < 4; ++ks) {
          bf16x8 a = lds_b128(sC + (it * 16 + frc) * S_LDB + ks * 32 + fqc * 8);
          bf16x8 b0 = lds_b128(sB + (jt0 * 16 + frc) * S_LDB + ks * 32 + fqc * 8);
          bf16x8 b1 = lds_b128(sB + ((jt0 + 1) * 16 + frc) * S_LDB + ks * 32 + fqc * 8);
          cb[0] = mfma16(a, b0, cb[0]);
          cb[1] = mfma16(a, b1, cb[1]);
        }
        const int i0 = it * 16 + fqc * 4;
#pragma unroll
        for (int hh = 0; hh < 2; ++hh) {
          const float* hAc = sAc + hh * 256;
          const float* hDt = sDt + hh * 256;
          const f32x4 aci = *(const f32x4*)(hAc + i0);
#pragma unroll
          for (int t = 0; t < 2; ++t) {
            const int jj = (jt0 + t) * 16 + frc;
            const float acj = hAc[jj], dtj = hDt[jj];
#pragma unroll
            for (int j = 0; j < 4; ++j) {
              const float gv = (jj <= i0 + j) ? cb[t][j] * __expf(aci[j] - acj) * dtj : 0.f;
              sG[(hh * 64 + i0 + j) * S_LDT + jj] = f2bf(gv);
            }
          }
        }
      }
      lds_barrier();
      const bfu* xrow = sXT + (hl * 64 + ps * 16 + frc) * S_LDT;
#pragma unroll 1
      for (int it = 0; it < 4; ++it) {
        f32x4 yacc = {0.f, 0.f, 0.f, 0.f}, oacc = {0.f, 0.f, 0.f, 0.f};
        const bfu* grow = sG + (hl * 64 + it * 16 + frc) * S_LDT;
#pragma unroll
        for (int ks = 0; ks < 2; ++ks) {
          if (ks * 32 <= it * 16 + 15) {
            const int j0 = ks * 32 + fqc * 8;
            bf16x8 gfr = lds_b128(grow + j0);
            bf16x8 bfv = lds_b128(xrow + j0);
            yacc = mfma16(gfr, bfv, yacc);
          }
        }
#pragma unroll
        for (int ks = 0; ks < 4; ++ks) {
          bf16x8 a = lds_b128(sC + (it * 16 + frc) * S_LDB + ks * 32 + fqc * 8);
          bf16x8 b = lds_b128(myH + frc * S_LDB + ks * 32 + fqc * 8);
          oacc = mfma16(a, b, oacc);
        }
#pragma unroll
        for (int j = 0; j < 4; ++j) {
          int ii = it * 16 + fqc * 4 + j;
          float xv = bf2f(xrow[ii]);
          float y = yacc[j] + __expf(myAc[ii]) * oacc[j] + D_h * xv;
          float zv = bf2f(sZ[ii * S_LDB + hl * 64 + ps * 16 + frc]);
          float ygv = y * silu_f(zv);
          yg[(size_t)(r0 + ii) * DI + head * 64 + ps * 16 + frc] = f2bf(ygv);
          float sq = ygv * ygv;
          sq = row16_sum(sq);
          if (frc == 0) mySq[ii] = sq;
        }
      }
      {
        const float dec = __expf(a63);
#pragma unroll
        for (int nt = 0; nt < 8; ++nt) hacc[nt] *= dec;
#pragma unroll
        for (int ks = 0; ks < 2; ++ks) {
          const int j0 = ks * 32 + fqc * 8;
          bf16x8 xr = lds_b128(xrow + j0);
          f32x4 w0 = *(const f32x4*)(myW + j0), w1 = *(const f32x4*)(myW + j0 + 4);
          u32x4 xu = __builtin_bit_cast(u32x4, xr);
          u32x4 pk;
          pk[0] = cvt_pk_bf16(__uint_as_float(xu[0] << 16) * w0[0], __uint_as_float(xu[0] & 0xffff0000u) * w0[1]);
          pk[1] = cvt_pk_bf16(__uint_as_float(xu[1] << 16) * w0[2], __uint_as_float(xu[1] & 0xffff0000u) * w0[3]);
          pk[2] = cvt_pk_bf16(__uint_as_float(xu[2] << 16) * w1[0], __uint_as_float(xu[2] & 0xffff0000u) * w1[1]);
          pk[3] = cvt_pk_bf16(__uint_as_float(xu[3] << 16) * w1[2], __uint_as_float(xu[3] & 0xffff0000u) * w1[3]);
          bf16x8 af = __builtin_bit_cast(bf16x8, pk);
#pragma unroll
          for (int nt = 0; nt < 8; ++nt) {
            bf16x8 b = lds_b128(sBT + (nt * 16 + frc) * S_LDT + j0);
            hacc[nt] = mfma16(af, b, hacc[nt]);
          }
        }
#pragma unroll
        for (int nt = 0; nt < 8; ++nt)
#pragma unroll
          for (int j = 0; j < 4; ++j) myH[(fqc * 4 + j) * S_LDB + nt * 16 + frc] = f2bf(hacc[nt][j]);
      }
      lds_barrier();
      if (tid < 64) {
        float sm = 0.f;
#pragma unroll
        for (int ww = 0; ww < 8; ++ww) sm += sSq[ww * 64 + tid];
        ssqp[(size_t)(r0 + tid) * 16 + g * 4 + hp] = sm;
      }
    }
#pragma unroll
    for (int nt = 0; nt < 8; ++nt)
#pragma unroll
      for (int j = 0; j < 4; ++j) hT[((size_t)head * 64 + ps * 16 + fq * 4 + j) * 128 + nt * 16 + fr] = hacc[nt][j];
  }
}

constexpr int A_STAGE = 32768;
constexpr int A_LDO = 132;
__device__ __forceinline__ int kswz(int key) { return ((key >> 1) & 1) | (((key >> 3) & 3) << 1); }
__device__ __forceinline__ void phase_attn(KP P, char* smem, const int wv) {
  LAS unsigned char* lds = (LAS unsigned char*)smem;
  float* sO = (float*)smem;
  const int tid = opaque_tid(wv), w = wv, lane = tid & 63, fr = lane & 15, fq = lane >> 4;
  const int cm = w >> 2, rg = w & 3;
  const bfu* qb = (const bfu*)(P->ws + WS_Q);
  bfu* ao = (bfu*)(P->ws + WS_AO);
  float lam;
  {
    float a = P->in[18][lane] * P->in[19][lane];
    float b = P->in[20][lane] * P->in[21][lane];
    a = wave_sum(a, lane); b = wave_sum(b, lane);
    lam = __expf(a) - __expf(b) + LAMBDA_INIT;
  }
  const float* subln = P->in[22];
  unsigned ksrc[2], vsrc_row[2], vsrc_col[2];
#pragma unroll
  for (int i = 0; i < 2; ++i) {
    int p = (2 * w + i) * 64 + lane;
    int row = p >> 3, phys = p & 7;
    int map = row >> 6, key = row & 63;
    ksrc[i] = (unsigned)(key * 1024 + map * 64 + ((phys ^ kswz(key)) << 3));
    vsrc_row[i] = (unsigned)row;
    vsrc_col[i] = (unsigned)((phys ^ (row & 7)) << 3);
  }
  unsigned koff[4];
#pragma unroll
  for (int t4 = 0; t4 < 4; ++t4) {
    int key = (t4 >> 1) * 32 + (fr >> 2) * 8 + (t4 & 1) * 4 + (fr & 3);
    koff[t4] = (unsigned)((cm * 64 + key) * 128 + ((fq ^ kswz(key)) << 4));
  }
  const unsigned voff0 = 16384u + (unsigned)(fr * 128 + ((fq ^ (fr & 7)) << 4));
  const unsigned kb0 = koff[0], kb1 = koff[0] ^ 64u, vb0 = voff0, vb1 = voff0 ^ 64u;

  const int G = gridDim.x;
  const bool xcd_order = (G == 256);
  const int nrounds = xcd_order ? 17 : (4096 + 64 + G - 1) / G;
  for (int r = 0; r < nrounds; ++r) {
    int b, h, pc;
    bool sample = false;
    if (xcd_order) {
      int x = blockIdx.x & 7, j = blockIdx.x >> 3;
      if (r < 16) { int bh = r * 8 + x; b = bh >> 3; h = bh & 7; pc = (r & 1) ? 31 - j : j; }
      else { if (j >= 8) break; int sidx = x * 8 + j; b = sidx >> 3; h = sidx & 7; pc = 0; sample = true; }
    } else {
      int u = blockIdx.x + r * G;
      if (u >= 4096 + 64) break;
      if (u < 4096) { pc = 31 - (u >> 7); int bh = u & 127; b = bh >> 3; h = bh & 7; }
      else { int sidx = u - 4096; b = sidx >> 3; h = sidx & 7; pc = 0; sample = true; }
    }
    int qrow0, nkt, Tstr;
    const bfu* kbase;
    const bfu* vtbase;
    if (!sample) {
      qrow0 = b * 4096 + pc * 128;
      nkt = 2 * pc + 2;
      Tstr = 4096;
      kbase = (const bfu*)(P->ws + WS_KP) + (size_t)b * 4096 * 1024 + h * 128;
      vtbase = (const bfu*)(P->ws + WS_VTP) + (size_t)(b * 8 + h) * 128 * 4096;
    } else {
      qrow0 = MP + b * 64;
      nkt = 17;
      Tstr = SKV;
      kbase = (const bfu*)(P->ws + WS_KSM) + (size_t)b * SKV * 1024 + h * 128;
      vtbase = (const bfu*)(P->ws + WS_VTS) + (size_t)(b * 8 + h) * 128 * SKV;
    }
    const bool wave_valid = !sample || rg < 2;
    const int my_nkt = sample ? nkt : (rg < 2 ? nkt - 1 : nkt);
    bf16x8 qf[2][2];
    {
      const int qr = wave_valid ? (qrow0 + rg * 32 + fr) : qrow0;
      const bfu* qp = qb + (size_t)qr * 1024 + h * 128 + cm * 64 + fq * 8;
#pragma unroll
      for (int qt = 0; qt < 2; ++qt) {
        qf[qt][0] = *(const bf16x8*)(qp + (wave_valid ? qt * 16 * 1024 : 0));
        qf[qt][1] = *(const bf16x8*)(qp + (wave_valid ? qt * 16 * 1024 : 0) + 32);
      }
    }
    float mrun[2] = {-INFINITY, -INFINITY}, lrun[2] = {0.f, 0.f};
    f32x4 oacc[2][8];
#pragma unroll
    for (int qt = 0; qt < 2; ++qt)
#pragma unroll
      for (int et = 0; et < 8; ++et) oacc[qt][et] = f32x4{0.f, 0.f, 0.f, 0.f};

#define ATT_STAGE(stage, kt_) do { \
      const bfu* kt_base = kbase + (size_t)(kt_) * 64 * 1024; \
      const bfu* vt_base = vtbase + (size_t)(kt_) * 64; \
      _Pragma("unroll") for (int _i = 0; _i < 2; ++_i) \
        __builtin_amdgcn_global_load_lds((const unsigned*)(kt_base + ksrc[_i]), (LAS unsigned*)(lds + (stage) * A_STAGE + (2 * w + _i) * 1024), 16, 0, 0); \
      _Pragma("unroll") for (int _i = 0; _i < 2; ++_i) \
        __builtin_amdgcn_global_load_lds((const unsigned*)(vt_base + (size_t)vsrc_row[_i] * Tstr + vsrc_col[_i]), (LAS unsigned*)(lds + (stage) * A_STAGE + 16384 + (2 * w + _i) * 1024), 16, 0, 0); \
    } while (0)

#define ATT_S_SOFTMAX(stage_) do { \
      LAS unsigned char* sb = lds + (stage_) * A_STAGE; \
      f32x4 st[2][4]; \
      _Pragma("unroll") for (int t4 = 0; t4 < 4; ++t4) { \
        bf16x8 a0 = *(const LAS bf16x8*)(sb + kb0 + (t4 >> 1) * 4096 + (t4 & 1) * 512); \
        bf16x8 a1 = *(const LAS bf16x8*)(sb + kb1 + (t4 >> 1) * 4096 + (t4 & 1) * 512); \
        _Pragma("unroll") for (int qt = 0; qt < 2; ++qt) { \
          f32x4 z = {0.f, 0.f, 0.f, 0.f}; \
          z = mfma16(a0, qf[qt][0], z); \
          st[qt][t4] = mfma16(a1, qf[qt][1], z); \
        } \
      } \
      _Pragma("unroll") for (int qt = 0; qt < 2; ++qt) { \
        float mx = st[qt][0][0]; \
        _Pragma("unroll") for (int t4 = 0; t4 < 4; ++t4) \
          _Pragma("unroll") for (int j = 0; j < 4; ++j) mx = fmaxf(mx, st[qt][t4][j]); \
          \
        if (__builtin_amdgcn_ballot_w64(mx - mrun[qt] > 8.f) != 0ull) { \
          mx = xmax_16_32(mx); \
          const float mnew = fmaxf(mrun[qt], mx); \
          const float alpha = __builtin_amdgcn_exp2f(mrun[qt] - mnew); \
          lrun[qt] *= alpha; \
          mrun[qt] = mnew; \
          _Pragma("unroll") for (int et = 0; et < 8; ++et) oacc[qt][et] *= alpha; \
        } \
        const f32x2 m2 = {mrun[qt], mrun[qt]}; \
        f32x2 ls2 = {0.f, 0.f}; \
        _Pragma("unroll") for (int t4 = 0; t4 < 4; ++t4) { \
          f32x2 lo = f32x2{st[qt][t4][0], st[qt][t4][1]} - m2, hi = f32x2{st[qt][t4][2], st[qt][t4][3]} - m2; \
          lo[0] = __builtin_amdgcn_exp2f(lo[0]); lo[1] = __builtin_amdgcn_exp2f(lo[1]); \
          hi[0] = __builtin_amdgcn_exp2f(hi[0]); hi[1] = __builtin_amdgcn_exp2f(hi[1]); \
          ls2 += lo; ls2 += hi; \
          st[qt][t4] = f32x4{lo[0], lo[1], hi[0], hi[1]}; \
        } \
        lrun[qt] += ls2[0] + ls2[1]; \
        _Pragma("unroll") for (int kk = 0; kk < 2; ++kk) { \
          u32x4 pk; \
          pk[0] = cvt_pk_bf16(st[qt][2 * kk][0], st[qt][2 * kk][1]); \
          pk[1] = cvt_pk_bf16(st[qt][2 * kk][2], st[qt][2 * kk][3]); \
          pk[2] = cvt_pk_bf16(st[qt][2 * kk + 1][0], st[qt][2 * kk + 1][1]); \
          pk[3] = cvt_pk_bf16(st[qt][2 * kk + 1][2], st[qt][2 * kk + 1][3]); \
          pb[qt][kk] = __builtin_bit_cast(bf16x8, pk); \
        } \
      } \
    } while (0)
#define ATT_PV(stage_) do { \
      LAS unsigned char* sb = lds + (stage_) * A_STAGE; \
      __builtin_amdgcn_s_setprio(1); \
      _Pragma("unroll") for (int kk = 0; kk < 2; ++kk) \
        _Pragma("unroll") for (int et = 0; et < 8; ++et) { \
          bf16x8 a = *(const LAS bf16x8*)(sb + (kk ? vb1 : vb0) + et * 2048); \
          oacc[0][et] = mfma16(a, pb[0][kk], oacc[0][et]); \
          oacc[1][et] = mfma16(a, pb[1][kk], oacc[1][et]); \
        } \
      __builtin_amdgcn_s_setprio(0); \
    } while (0)

    __syncthreads();
    ATT_STAGE(0, 0);
    if (nkt > 1) ATT_STAGE(1, 1);
    if (nkt > 1) asm volatile("s_waitcnt vmcnt(4)" ::: "memory");
    else asm volatile("s_waitcnt vmcnt(0)" ::: "memory");
    if (cm == 1) lds_barrier();
    bf16x8 pb[2][2];
#pragma unroll 1
    for (int kt = 0; kt < nkt; ++kt) {
      const bool act = wave_valid && kt < my_nkt;
      lds_barrier();
      if (kt + 2 < nkt) ATT_STAGE((kt + 2) & 3, kt + 2);
      if (act) ATT_S_SOFTMAX(kt & 3);
      if (kt + 1 < nkt) {
        if (kt + 2 < nkt) asm volatile("s_waitcnt vmcnt(4)" ::: "memory");
        else asm volatile("s_waitcnt vmcnt(0)" ::: "memory");
      }
      lds_barrier();
      if (act) ATT_PV(kt & 3);
    }
    if (cm == 0) lds_barrier();
#undef ATT_S_SOFTMAX
#undef ATT_PV
#undef ATT_STAGE
    lrun[0] = xsum_16_32(lrun[0]);
    lrun[1] = xsum_16_32(lrun[1]);
    __syncthreads();
    if (cm == 1 && wave_valid) {
#pragma unroll
      for (int qt = 0; qt < 2; ++qt) {
        float rl = 1.f / lrun[qt];
#pragma unroll
        for (int et = 0; et < 8; ++et) *(f32x4*)(sO + (rg * 32 + qt * 16 + fr) * A_LDO + et * 16 + fq * 4) = oacc[qt][et] * rl;
      }
    }
    __syncthreads();
    if (cm == 0 && wave_valid) {
#pragma unroll
      for (int qt = 0; qt < 2; ++qt) {
        float rl = 1.f / lrun[qt];
        float ss = 0.f;
#pragma unroll
        for (int et = 0; et < 8; ++et) {
          f32x4 o1 = *(const f32x4*)(sO + (rg * 32 + qt * 16 + fr) * A_LDO + et * 16 + fq * 4);
          f32x4 o = oacc[qt][et] * rl - o1 * lam;
          oacc[qt][et] = o;
          ss += o[0] * o[0] + o[1] * o[1] + o[2] * o[2] + o[3] * o[3];
        }
        ss = xsum_16_32(ss);
        float rstd = rsqrtf(ss * (1.f / 128.f) + EPS) * (1.f - LAMBDA_INIT);
        bfu* dst = ao + (size_t)(qrow0 + rg * 32 + qt * 16 + fr) * 1024 + h * 128;
        int fqe = fq;
        asm volatile("" : "+v"(fqe));
#pragma unroll
        for (int et = 0; et < 8; ++et) {
          int e0 = et * 16 + fqe * 4;
          f32x4 sw = *(const f32x4*)(subln + e0);
          uint2 pk;
          pk.x = cvt_pk_bf16(oacc[qt][et][0] * rstd * sw[0], oacc[qt][et][1] * rstd * sw[1]);
          pk.y = cvt_pk_bf16(oacc[qt][et][2] * rstd * sw[2], oacc[qt][et][3] * rstd * sw[3]);
          *(uint2*)(dst + e0) = pk;
        }
      }
    }
  }
}

#define XB_TMO      128
#define XB_XCNT(j)  (256  + 64 * (j))
#define XB_XSUB(j)  (1280 + 64 * (j))
#define XB_XGEN(j)  (2304 + 64 * (j))
#define XB_TOP      3328
#define XB_TOPGEN   3392
#define XCD_BAR_WORDS 3456
#define XB_SPIN_CAP (1u << 22)
__device__ __forceinline__ unsigned xb_ld(unsigned* p)              { return __hip_atomic_load(p, __ATOMIC_RELAXED, __HIP_MEMORY_SCOPE_AGENT); }
__device__ __forceinline__ unsigned xb_add(unsigned* p, unsigned v) { return __hip_atomic_fetch_add(p, v, __ATOMIC_RELAXED, __HIP_MEMORY_SCOPE_AGENT); }
__device__ __forceinline__ unsigned xb_xcc_id() { return (unsigned)__builtin_amdgcn_s_getreg((3 << 11) | 20) & 0xFu; }
#define XB_SPIN(cond, bar) do { unsigned _sp = 0; while (cond) { __builtin_amdgcn_s_sleep(1); \
    if ((++_sp & 255u) == 0u) { if (xb_ld(&(bar)[XB_TMO])) break; if (_sp > XB_SPIN_CAP) { atomicAdd(&(bar)[XB_TMO], 1u); break; } } } } while (0)
__device__ __forceinline__ void xcd_barrier_complete(unsigned* bar, unsigned x, unsigned& nloc, unsigned& nx) {
  const unsigned G = gridDim.x;
  unsigned sum, cnt, mine, sp = 0u;
  for (;;) {
    sum = 0u; cnt = 0u; mine = 0u;
#pragma unroll
    for (unsigned j = 0; j < 16; ++j) { const unsigned c = xb_ld(&bar[XB_XCNT(j)]); sum += c; cnt += (c > 0u) ? 1u : 0u; mine = (j == x) ? c : mine; }
    if (sum == G) break;
    __builtin_amdgcn_s_sleep(1);
    if ((++sp & 255u) == 0u) { if (xb_ld(&bar[XB_TMO])) break; if (sp > XB_SPIN_CAP) { atomicAdd(&bar[XB_TMO], 1u); break; } }
  }
  nloc = mine > 0u ? mine : 1u; nx = cnt > 0u ? cnt : 1u;
}
__device__ __forceinline__ void xcd_barrier(unsigned* bar, volatile __attribute__((address_space(3))) unsigned* st, const int tid) {
  asm volatile("s_waitcnt vmcnt(0)" ::: "memory");
  __syncthreads();
  if (tid == 0) {
    const unsigned x = xb_xcc_id();
    __builtin_amdgcn_s_waitcnt(0);
    unsigned nloc = st[0], nx = st[1];
    if (nloc == 0u) { xcd_barrier_complete(bar, x, nloc, nx); st[0] = nloc; st[1] = nx; }
    const unsigned old = xb_add(&bar[XB_XSUB(x)], 1u);
    const unsigned gen = old / nloc;
    if (old + 1u == (gen + 1u) * nloc) {
      __builtin_amdgcn_fence(__ATOMIC_RELEASE, "agent");
      asm volatile("s_waitcnt vmcnt(0)" ::: "memory");
      const unsigned og = xb_add(&bar[XB_TOP], 1u);
      const unsigned tg = og / nx;
      if (og + 1u == (tg + 1u) * nx) xb_add(&bar[XB_TOPGEN], 1u);
      else XB_SPIN(xb_ld(&bar[XB_TOPGEN]) == tg, bar);
      __builtin_amdgcn_fence(__ATOMIC_ACQUIRE, "agent");
      xb_add(&bar[XB_XGEN(x)], 1u);
      asm volatile("s_waitcnt vmcnt(0)" ::: "memory");
    } else {
      XB_SPIN(xb_ld(&bar[XB_XGEN(x)]) == gen, bar);
      __builtin_amdgcn_fence(__ATOMIC_ACQUIRE, "agent");
      asm volatile("s_waitcnt vmcnt(0)" ::: "memory");
    }
  }
  __syncthreads();
}

__global__ void __launch_bounds__(512) fwd_kernel(Params Pk) {
  extern __shared__ __attribute__((aligned(16))) char smem_base[];
  const int wv = __builtin_amdgcn_readfirstlane((int)(threadIdx.x >> 6));
  volatile __attribute__((address_space(3))) unsigned* xst = (volatile __attribute__((address_space(3))) unsigned*)(smem_base + LDS_BYTES - 16);
  if (threadIdx.x == 0) {
    xst[0] = 0u; xst[1] = 0u;
    (void)xb_add(&((unsigned*)(Pk.ws + WS_BAR))[XB_XCNT(xb_xcc_id())], 1u);
  }
  __syncthreads();
  for (int ph = Pk.ph_lo; ph < Pk.ph_hi; ++ph) {
    int zoff = 0;
    asm volatile("" : "+s"(zoff));
    char* smem = smem_base + zoff;
    KP P = (KP)__builtin_amdgcn_kernarg_segment_ptr();
    asm volatile("" : "+s"(P));
#ifdef PROBE_DUP
    for (int rep = 0; rep < (((PROBE_DUP >> ph) & 1) ? 2 : 1); ++rep)
#endif
    switch (ph) {
      case 0: case 4: case 7: case 11: {
        const float* w = ph == 0 ? P->in[6] : (ph == 4 ? P->in[7] : (ph == 7 ? P->in[6] + D : P->in[7] + D));
        if (ph == 0) phase_norm<false, false>(P->in[0], P->in[1], nullptr, w, (bfu*)(P->ws + WS_XN), nullptr, wv);
        else phase_norm<false, true>(nullptr, nullptr, (const bfu*)(P->ws + WS_XR), w, (bfu*)(P->ws + WS_XN), nullptr, wv);
        if (ph == 0) phase_convert_weights(P, smem, wv);
        if (ph == 7) phase_convert_cache(P, smem, wv);
      } break;
      case 1: gemm_phase<EPI_INPROJ>(P, (const bfu*)(P->ws + WS_XN), (const bfu*)(P->ws + WS_W_INP), 1024, INP_NP / 256, smem, wv); break;
      case 2: phase_ssd(P, smem, wv); break;
      case 3: gemm_phase<EPI_OUTPROJ>(P, (const bfu*)(P->out + O_KP), (const bfu*)(P->ws + WS_W_OUTP), 2048, 4, smem, wv); break;
      case 5: case 12:
        gemm_phase<EPI_GU>(P, (const bfu*)(P->ws + WS_XN), (const bfu*)(P->ws + (ph == 5 ? WS_W_GU0 : WS_W_GU1)), 1024, 22, smem, wv);
        break;
      case 6: case 10: case 13: {
        const bfu* A = (const bfu*)(P->ws + (ph == 10 ? WS_AO : WS_BIG));
        const bfu* Bt = (const bfu*)(P->ws + (ph == 6 ? WS_W_DN0 : (ph == 10 ? WS_W_AO : WS_W_DN1)));
        gemm_phase<EPI_RES>(P, A, Bt, ph == 10 ? 1024 : DFF, 4, smem, wv);
      } break;
      case 8: gemm_phase<EPI_QKV>(P, (const bfu*)(P->ws + WS_XN), (const bfu*)(P->ws + WS_W_QKV), 1024, 12, smem, wv); break;
      case 9: phase_attn(P, smem, wv); break;
      case 14: phase_norm<true, true>(nullptr, nullptr, (const bfu*)(P->ws + WS_XR), P->in[8], nullptr, P->out, wv); break;
    }
    if (ph + 1 < Pk.ph_hi) {
      if (ph == Pk.ph_lo) cg::this_grid().sync();
      else xcd_barrier((unsigned*)(P->ws + WS_BAR), xst, opaque_tid(wv));
    }
  }
}

extern "C" void kernel_launch(void* const* d_in, const int* in_sizes, int n_in, void* d_out, int out_size, void* d_ws, size_t ws_size,
                              hipStream_t stream) {
  static int grid = 0;
  if (grid == 0) {
    if (n_in != 27 || ws_size < WS_END || out_size != 209412096) {
      fprintf(stderr, "kernel_launch: unexpected sizes n_in=%d ws=%zu (need %zu) out=%d\n", n_in, ws_size, (size_t)WS_END, out_size);
    }
    int dev = 0, cus = 0, per_cu = 0;
    (void)hipGetDevice(&dev);
    (void)hipDeviceGetAttribute(&cus, hipDeviceAttributeMultiprocessorCount, dev);
    (void)hipFuncSetAttribute((const void*)fwd_kernel, hipFuncAttributeMaxDynamicSharedMemorySize, LDS_BYTES);
    (void)hipOccupancyMaxActiveBlocksPerMultiprocessor(&per_cu, (const void*)fwd_kernel, 512, LDS_BYTES);
    if (per_cu < 1) { fprintf(stderr, "kernel_launch: occupancy query returned %d\n", per_cu); per_cu = 1; }
    grid = cus * per_cu;
    fprintf(stderr, "kernel_launch: grid=%d (cus=%d per_cu=%d) ws=%zu need=%zu\n", grid, cus, per_cu, ws_size, (size_t)WS_END);
  }
  Params p{};
  for (int i = 0; i < 27; ++i) p.in[i] = (const float*)d_in[i];
  p.out = (float*)d_out;
  p.ws = (unsigned char*)d_ws;
#if COOP
  (void)hipMemsetAsync((char*)d_ws + WS_BAR, 0, 16384, stream);
  p.ph_lo = 0; p.ph_hi = NPH;
  void* args[] = {&p};
  hipError_t e = hipLaunchCooperativeKernel((const void*)fwd_kernel, dim3(grid), dim3(512), args, LDS_BYTES, stream);
  if (e != hipSuccess) fprintf(stderr, "cooperative launch failed: %s (grid %d)\n", hipGetErrorString(e), grid);
#else
  for (int ph = 0; ph < NPH; ++ph) {
    p.ph_lo = ph; p.ph_hi = ph + 1;
    hipLaunchKernelGGL(fwd_kernel, dim3(grid), dim3(512), LDS_BYTES, stream, p);
  }
#endif
}
```

```cpp
#include <hip/hip_runtime.h>
#include <hip/hip_cooperative_groups.h>
#include <cmath>
#include <cstdio>
namespace cg = cooperative_groups;

#ifndef COOP
#define COOP 1
#endif

typedef unsigned short bfu;
using bf16x8 = __attribute__((ext_vector_type(8))) short;
using f32x4 = __attribute__((ext_vector_type(4))) float;
using u32x4 = __attribute__((ext_vector_type(4))) unsigned;
using f32x2 = __attribute__((ext_vector_type(2))) float;

constexpr int D = 1024;
constexpr int MP = 65536;
constexpr int MS = 512;
constexpr int MT = MP + MS;
constexpr int DI = 2048;
constexpr int CONVD = 3072;
constexpr int ZXW = 5120;
constexpr int INP_N = 5152;
constexpr int INP_NP = 5376;
constexpr int DFF = 2816;
constexpr int SKV = 1088;
constexpr float EPS = 1e-6f;
constexpr float LAMBDA_INIT = 0.35550906759f;
constexpr float QSCALE = 0.125f * 1.4426950408889634f;

constexpr size_t O_Y = 0;
constexpr size_t O_CONVP = 67633152;
constexpr size_t O_SSMP = 67780608;
constexpr size_t O_KP = 71974912;
constexpr size_t O_VP = 139083776;
constexpr size_t O_CONVS = 206192640;
constexpr size_t O_SSMS = 206266368;
constexpr size_t O_KS = 208363520;
constexpr size_t O_VS = 208887808;

constexpr size_t WS_W_INP = 0;
constexpr size_t WS_W_OUTP = WS_W_INP + (size_t)INP_NP * 1024 * 2;
constexpr size_t WS_W_GU0 = WS_W_OUTP + (size_t)1024 * 2048 * 2;
constexpr size_t WS_W_DN0 = WS_W_GU0 + (size_t)5632 * 1024 * 2;
constexpr size_t WS_W_QKV = WS_W_DN0 + (size_t)1024 * 2816 * 2;
constexpr size_t WS_W_AO = WS_W_QKV + (size_t)3072 * 1024 * 2;
constexpr size_t WS_W_GU1 = WS_W_AO + (size_t)1024 * 1024 * 2;
constexpr size_t WS_W_DN1 = WS_W_GU1 + (size_t)5632 * 1024 * 2;
constexpr size_t WS_XN = WS_W_DN1 + (size_t)1024 * 2816 * 2;
constexpr size_t WS_DT = WS_XN + (size_t)MT * 1024 * 2;
constexpr size_t WS_SSQ = WS_DT + (size_t)MT * 32 * 4;
constexpr size_t WS_BIG = WS_SSQ + (size_t)MT * 16 * 4;
constexpr size_t WS_BAR = WS_BIG + (size_t)MT * ZXW * 2;
constexpr size_t WS_XR = WS_BAR + 16384;
constexpr size_t WS_END = WS_XR + (size_t)MT * 1024 * 2;
constexpr size_t WS_Q = WS_BIG;
constexpr size_t WS_KP = WS_Q + (size_t)MT * 1024 * 2;
constexpr size_t WS_VTP = WS_KP + (size_t)MP * 1024 * 2;
constexpr size_t WS_KSM = WS_VTP + (size_t)MP * 1024 * 2;
constexpr size_t WS_VTS = WS_KSM + (size_t)8 * SKV * 1024 * 2;
constexpr size_t WS_AO = WS_VTS + (size_t)8 * SKV * 1024 * 2;
static_assert(WS_AO + (size_t)MT * 1024 * 2 <= WS_BAR, "layer-1 aliases overflow");
static_assert((size_t)MT * DFF * 2 <= WS_KSM - WS_BIG, "ffn h overlaps sample K");

constexpr int LDS_BYTES = 159744;
constexpr int NPH = 15;

struct Params {
  const float* in[27];
  float* out;
  unsigned char* ws;
  int ph_lo, ph_hi;
};
typedef const __attribute__((address_space(4))) Params* KP;

__device__ __forceinline__ bfu f2bf(float f) {
  unsigned u = __float_as_uint(f);
  u += 0x7fffu + ((u >> 16) & 1u);
  return (bfu)(u >> 16);
}
__device__ __forceinline__ float bf2f(bfu h) { return __uint_as_float(((unsigned)h) << 16); }
__device__ __forceinline__ unsigned pack2(float a, float b) { return (unsigned)f2bf(a) | ((unsigned)f2bf(b) << 16); }
__device__ __forceinline__ unsigned cvt_pk_bf16(float lo, float hi) {
  unsigned r;
  asm volatile("v_cvt_pk_bf16_f32 %0, %1, %2" : "=v"(r) : "v"(lo), "v"(hi));
  return r;
}
__device__ __forceinline__ float silu_f(float x) { return x * __builtin_amdgcn_rcpf(1.f + __expf(-x)); }
__device__ __forceinline__ float shx(float v, int mask, int lane) {
  return __int_as_float(__builtin_amdgcn_ds_bpermute((lane ^ mask) << 2, __float_as_int(v)));
}
__device__ __forceinline__ float shup(float v, int d, int lane) {
  return __int_as_float(__builtin_amdgcn_ds_bpermute((lane - d) << 2, __float_as_int(v)));
}
__device__ __forceinline__ float shidx(float v, int src) {
  return __int_as_float(__builtin_amdgcn_ds_bpermute(src << 2, __float_as_int(v)));
}
__device__ __forceinline__ float wave_sum(float v, int lane) {
#pragma unroll
  for (int o = 32; o >= 1; o >>= 1) v += shx(v, o, lane);
  return v;
}
__device__ __forceinline__ f32x4 mfma16(bf16x8 a, bf16x8 b, f32x4 c) {
  return __builtin_amdgcn_mfma_f32_16x16x32_bf16(a, b, c, 0, 0, 0);
}
__device__ __forceinline__ int opaque_tid(int wv) {
  int lane;
  asm volatile("v_mbcnt_lo_u32_b32 %0, -1, 0\n\tv_mbcnt_hi_u32_b32 %0, -1, %0" : "=v"(lane));
  return wv * 64 + lane;
}
__device__ __forceinline__ float xmax_16_32(float v) {
  auto a = __builtin_amdgcn_permlane16_swap(__float_as_uint(v), __float_as_uint(v), false, false);
  v = fmaxf(__uint_as_float(a[0]), __uint_as_float(a[1]));
  auto b = __builtin_amdgcn_permlane32_swap(__float_as_uint(v), __float_as_uint(v), false, false);
  return fmaxf(__uint_as_float(b[0]), __uint_as_float(b[1]));
}
__device__ __forceinline__ float xsum_16_32(float v) {
  auto a = __builtin_amdgcn_permlane16_swap(__float_as_uint(v), __float_as_uint(v), false, false);
  v = __uint_as_float(a[0]) + __uint_as_float(a[1]);
  auto b = __builtin_amdgcn_permlane32_swap(__float_as_uint(v), __float_as_uint(v), false, false);
  return __uint_as_float(b[0]) + __uint_as_float(b[1]);
}
__device__ __forceinline__ float row16_sum(float v) {
  v += __int_as_float(__builtin_amdgcn_update_dpp(0, __float_as_int(v), 0xB1, 0xf, 0xf, true));
  v += __int_as_float(__builtin_amdgcn_update_dpp(0, __float_as_int(v), 0x4E, 0xf, 0xf, true));
  v += __int_as_float(__builtin_amdgcn_update_dpp(0, __float_as_int(v), 0x141, 0xf, 0xf, true));
  v += __int_as_float(__builtin_amdgcn_update_dpp(0, __float_as_int(v), 0x140, 0xf, 0xf, true));
  return v;
}
__device__ __forceinline__ f32x4 bf4_to_f32(uint2 u) {
  return f32x4{__uint_as_float(u.x << 16), __uint_as_float(u.x & 0xffff0000u), __uint_as_float(u.y << 16), __uint_as_float(u.y & 0xffff0000u)};
}
__device__ __forceinline__ void lds_barrier() {
  asm volatile("s_waitcnt lgkmcnt(0)" ::: "memory");
  __builtin_amdgcn_s_barrier();
  asm volatile("" ::: "memory");
}
__device__ __forceinline__ bf16x8 lds_b128(const bfu* p) { return *reinterpret_cast<const bf16x8*>(p); }

__device__ __forceinline__ void conv_tile(const float* __restrict__ src, const float* __restrict__ src2, const float* __restrict__ scale,
                                          bfu* __restrict__ dst, int Nsrc, int mode, int dstStride, int kt, int nt, float* sT, const int tid) {
  __syncthreads();
#pragma unroll
  for (int i = 0; i < 8; ++i) {
    int idx = tid + i * 512;
    int kk = idx >> 6, rr = idx & 63;
    int r = nt * 64 + rr;
    size_t k = (size_t)(kt * 64 + kk);
    float v = 0.f;
    if (mode == 0) {
      if (r < Nsrc) v = src[k * Nsrc + r];
    } else if (mode == 1) {
      int blk = r >> 5, w = r & 31;
      int sc = blk * 16 + (w & 15);
      v = (w < 16 ? src : src2)[k * Nsrc + sc];
    } else {
      int sc = r;
      if (r < 2048) {
        int pos = r & 63, pb = pos >> 4;
        int tb = (pb == 1) ? 2 : ((pb == 2) ? 1 : pb);
        sc = (r & ~63) + tb * 16 + (pos & 15);
      }
      v = src[k * Nsrc + sc];
    }
    sT[kk * 65 + rr] = v;
  }
  __syncthreads();
#pragma unroll
  for (int i = 0; i < 8; ++i) {
    int idx = tid + i * 512;
    int rr = idx >> 6, kk = idx & 63;
    float v = sT[kk * 65 + rr];
    if (scale) v *= scale[kt * 64 + kk];
    dst[(size_t)(nt * 64 + rr) * dstStride + kt * 64 + kk] = f2bf(v);
  }
}

__device__ __forceinline__ void phase_convert_weights(KP P, char* smem, const int wv) {
  float* sT = (float*)smem;
  const int tid = opaque_tid(wv);
  for (int t = blockIdx.x; t < 7104; t += gridDim.x) {
    const float *src, *src2 = nullptr, *scale = nullptr;
    bfu* dst;
    int K, Nsrc, mode = 0, lt;
    if (t < 1344) { lt = t; src = P->in[9]; dst = (bfu*)(P->ws + WS_W_INP); K = 1024; Nsrc = INP_N; }
    else if (t < 1856) { lt = t - 1344; src = P->in[16]; scale = P->in[15]; dst = (bfu*)(P->ws + WS_W_OUTP); K = 2048; Nsrc = 1024; }
    else if (t < 3264) { lt = t - 1856; src = P->in[24]; src2 = P->in[25]; dst = (bfu*)(P->ws + WS_W_GU0); K = 1024; Nsrc = DFF; mode = 1; }
    else if (t < 3968) { lt = t - 3264; src = P->in[26]; dst = (bfu*)(P->ws + WS_W_DN0); K = 2816; Nsrc = 1024; }
    else if (t < 4736) { lt = t - 3968; src = P->in[17]; dst = (bfu*)(P->ws + WS_W_QKV); K = 1024; Nsrc = 3072; mode = 2; }
    else if (t < 4992) { lt = t - 4736; src = P->in[23]; dst = (bfu*)(P->ws + WS_W_AO); K = 1024; Nsrc = 1024; }
    else if (t < 6400) { lt = t - 4992; src = P->in[24] + (size_t)1024 * DFF; src2 = P->in[25] + (size_t)1024 * DFF; dst = (bfu*)(P->ws + WS_W_GU1); K = 1024; Nsrc = DFF; mode = 1; }
    else { lt = t - 6400; src = P->in[26] + (size_t)DFF * 1024; dst = (bfu*)(P->ws + WS_W_DN1); K = 2816; Nsrc = 1024; }
    int nkt = K / 64;
    int kt = lt % nkt, nt = lt / nkt;
    conv_tile(src, src2, scale, dst, Nsrc, mode, K, kt, nt, sT, tid);
  }
}

__device__ __forceinline__ void phase_convert_cache(KP P, char* smem, const int wv) {
  float* sT = (float*)smem;
  const int tid = opaque_tid(wv);
  bfu* ks = (bfu*)(P->ws + WS_KSM);
  bfu* vts = (bfu*)(P->ws + WS_VTS);
  const float* ck = P->in[4];
  const float* cv = P->in[5];
  for (size_t i = (size_t)blockIdx.x * 512 + tid; i < (size_t)8 * 1024 * 256; i += (size_t)gridDim.x * 512) {
    size_t e = i * 4;
    int b = (int)(e >> 20);
    size_t rem = e & ((1u << 20) - 1);
    float4 v = *(const float4*)(ck + e);
    uint2 o; o.x = pack2(v.x, v.y); o.y = pack2(v.z, v.w);
    *(uint2*)(ks + (size_t)b * SKV * 1024 + rem) = o;
  }
  for (int t = blockIdx.x; t < 8 * 256; t += gridDim.x) {
    int b = t >> 8, lt = t & 255;
    int kt = lt & 15, nt = lt >> 4;
    conv_tile(cv + (size_t)b * 1024 * 1024, nullptr, nullptr, vts + (size_t)b * 1024 * SKV, 1024, 0, SKV, kt, nt, sT, tid);
  }
}

template <bool FINAL, bool SRCB>
__device__ __forceinline__ void phase_norm(const float* xa, const float* xb, const bfu* xr, const float* w, bfu* dst, float* fdst, const int wv) {
  const int tid_ = opaque_tid(wv);
  const int lane = tid_ & 63, wid = tid_ >> 6;
  f32x4 w4[4];
#pragma unroll
  for (int i = 0; i < 4; ++i) w4[i] = ((const f32x4*)w)[i * 64 + lane];
  for (int row = blockIdx.x * 8 + wid; row < MT / 2; row += gridDim.x * 8) {
    f32x4 v[2][4];
    float ss[2] = {0.f, 0.f};
#pragma unroll
    for (int h = 0; h < 2; ++h) {
      const int r = row + h * (MT / 2);
      if (SRCB) {
#pragma unroll
        for (int i = 0; i < 4; ++i) v[h][i] = bf4_to_f32(((const uint2*)(xr + (size_t)r * D))[i * 64 + lane]);
      } else {
        const float* x = r < MP ? xa + (size_t)r * D : xb + (size_t)(r - MP) * D;
#pragma unroll
        for (int i = 0; i < 4; ++i) v[h][i] = ((const f32x4*)x)[i * 64 + lane];
      }
    }
#pragma unroll
    for (int h = 0; h < 2; ++h) {
#pragma unroll
      for (int i = 0; i < 4; ++i) ss[h] += v[h][i][0] * v[h][i][0] + v[h][i][1] * v[h][i][1] + v[h][i][2] * v[h][i][2] + v[h][i][3] * v[h][i][3];
      ss[h] = wave_sum(ss[h], lane);
    }
#pragma unroll
    for (int h = 0; h < 2; ++h) {
      const int r = row + h * (MT / 2);
      const float rstd = rsqrtf(ss[h] * (1.f / D) + EPS);
#pragma unroll
      for (int i = 0; i < 4; ++i) {
        f32x4 o = v[h][i] * rstd * w4[i];
        if (FINAL) {
          ((f32x4*)(fdst + (size_t)r * D))[i * 64 + lane] = o;
        } else {
          uint2 pk; pk.x = cvt_pk_bf16(o[0], o[1]); pk.y = cvt_pk_bf16(o[2], o[3]);
          ((uint2*)(dst + (size_t)r * D))[i * 64 + lane] = pk;
        }
      }
    }
  }
}

enum { EPI_INPROJ = 0, EPI_OUTPROJ = 1, EPI_RES = 2, EPI_GU = 3, EPI_QKV = 4 };
#define LAS __attribute__((address_space(3)))
constexpr int HT_B = 128 * 64 * 2;
__device__ __forceinline__ int lds_byte(int r, int c) {
  int st = (r >> 4) * 2 + (c >> 5), rr = r & 15, cc = c & 31, ob = rr * 64 + cc * 2;
  return st * 1024 + (ob ^ (((ob >> 9) & 1) << 5));
}
__device__ __forceinline__ void stage_rc(int b, int& R, int& C) {
  int st = b / 1024, sb = b % 1024, swz = sb ^ (((sb >> 9) & 1) << 5);
  R = (st >> 1) * 16 + swz / 64;
  C = (st & 1) * 32 + (swz % 64) / 2;
}
__device__ __forceinline__ float softplus_f(float x) { return x > 20.f ? x : log1pf(__expf(x)); }

__device__ __forceinline__ float ssd_rstd(const float* __restrict__ ssq, int row) {
  const f32x4* p = (const f32x4*)(ssq + (size_t)row * 16);
  f32x4 a = p[0], b = p[1], c = p[2], d = p[3];
  float sm = (a[0] + a[1]) + (a[2] + a[3]) + (b[0] + b[1]) + (b[2] + b[3]) + (c[0] + c[1]) + (c[2] + c[3]) + (d[0] + d[1]) + (d[2] + d[3]);
  return rsqrtf(sm * (1.f / DI) + EPS);
}

template <int EPI>
__device__ __forceinline__ void gemm_acc_init(KP P, f32x4 (&acc)[2][2][4][2], int brow, int bcol, int wr, int wc, int fr_, int fq_, const float* sRu) {
  if (EPI == EPI_OUTPROJ || EPI == EPI_RES) {
    int fr = fr_, fq = fq_;
    asm volatile("" : "+v"(fr), "+v"(fq));
    const float* xin = (brow < MP ? P->in[0] + (size_t)brow * D : P->in[1] + (size_t)(brow - MP) * D) + bcol;
    const bfu* xrb = (const bfu*)(P->ws + WS_XR) + (size_t)brow * D + bcol;
#pragma unroll
    for (int ai = 0; ai < 2; ++ai)
#pragma unroll
      for (int m = 0; m < 4; ++m) {
        __builtin_amdgcn_sched_barrier(0);
        unsigned lr = ai * 128 + wr * 64 + m * 16 + fr;
        unsigned o = lr * D + wc * 32 + fq * 4;
        float sc = 1.f;
        if (EPI == EPI_OUTPROJ) sc = 1.f / sRu[lr];
#pragma unroll
        for (int bj = 0; bj < 2; ++bj)
#pragma unroll
          for (int n = 0; n < 2; ++n) {
            if (EPI == EPI_RES) acc[ai][bj][m][n] = bf4_to_f32(*(const uint2*)(xrb + o + bj * 128 + n * 16));
            else acc[ai][bj][m][n] = *(const f32x4*)(xin + o + bj * 128 + n * 16) * sc;
          }
      }
  } else {
#pragma unroll
    for (int ai = 0; ai < 2; ++ai)
#pragma unroll
      for (int bj = 0; bj < 2; ++bj)
#pragma unroll
        for (int m = 0; m < 4; ++m)
#pragma unroll
          for (int n = 0; n < 2; ++n) acc[ai][bj][m][n] = f32x4{0.f, 0.f, 0.f, 0.f};
  }
}

template <int EPI>
__device__ __forceinline__ void gemm_epilogue(KP P, f32x4 (&acc)[2][2][4][2], int brow, int bcol, int wr, int wc, int fr_, int fq_, const float* sRu) {
  int fr = fr_, fq = fq_;
  asm volatile("" : "+v"(fr), "+v"(fq));
  const unsigned lrow0 = wr * 64 + fr;
  const unsigned lcol0 = wc * 32 + fq * 4;
  if (EPI == EPI_INPROJ) {
    if (bcol < ZXW) {
      bfu* zxb = (bfu*)(P->ws + WS_BIG) + (size_t)brow * ZXW + bcol;
#pragma unroll
      for (int ai = 0; ai < 2; ++ai)
#pragma unroll
        for (int m = 0; m < 4; ++m) {
          __builtin_amdgcn_sched_barrier(0);
          unsigned o = (lrow0 + ai * 128 + m * 16) * ZXW + lcol0;
#pragma unroll
          for (int bj = 0; bj < 2; ++bj)
#pragma unroll
            for (int n = 0; n < 2; ++n) {
              f32x4 v = acc[ai][bj][m][n];
              uint2 pk; pk.x = cvt_pk_bf16(v[0], v[1]); pk.y = cvt_pk_bf16(v[2], v[3]);
              *(uint2*)(zxb + o + bj * 128 + n * 16) = pk;
            }
        }
      const bool has_tail = (brow >= MP) || (((brow + 256) & 4095) == 0);
      if (has_tail && bcol >= DI) {
#pragma unroll
        for (int ai = 0; ai < 2; ++ai)
#pragma unroll
          for (int m = 0; m < 4; ++m) {
            __builtin_amdgcn_sched_barrier(0);
            int row = brow + lrow0 + ai * 128 + m * 16;
            float* dst = nullptr;
            if (row < MP) {
              int t = row & 4095;
              if (t >= 4093) dst = P->out + O_CONVP + ((size_t)(row >> 12) * 3 + (t - 4093)) * CONVD;
            } else {
              int rs = row - MP, t = rs & 63;
              if (t >= 61) dst = P->out + O_CONVS + ((size_t)(rs >> 6) * 3 + (t - 61)) * CONVD;
            }
            if (dst) {
              unsigned o = bcol - DI + lcol0;
#pragma unroll
              for (int bj = 0; bj < 2; ++bj)
#pragma unroll
                for (int n = 0; n < 2; ++n) *(f32x4*)(dst + o + bj * 128 + n * 16) = acc[ai][bj][m][n];
            }
          }
      }
    } else {
      if (wc == 0) {
        float* dtb = (float*)(P->ws + WS_DT) + (size_t)brow * 32;
        const float* dtbias = P->in[12];
        const f32x4 b0 = *(const f32x4*)(dtbias + fq * 4), b1 = *(const f32x4*)(dtbias + 16 + fq * 4);
#pragma unroll
        for (int ai = 0; ai < 2; ++ai)
#pragma unroll
          for (int m = 0; m < 4; ++m) {
            __builtin_amdgcn_sched_barrier(0);
            unsigned o = (lrow0 + ai * 128 + m * 16) * 32 + fq * 4;
            f32x4 x0 = acc[ai][0][m][0] + b0, x1 = acc[ai][0][m][1] + b1;
            f32x4 d0, d1;
#pragma unroll
            for (int j = 0; j < 4; ++j) { d0[j] = softplus_f(x0[j]); d1[j] = softplus_f(x1[j]); }
            *(f32x4*)(dtb + o) = d0;
            *(f32x4*)(dtb + o + 16) = d1;
          }
      }
    }
  } else if (EPI == EPI_OUTPROJ || EPI == EPI_RES) {
    bfu* xo = (bfu*)(P->ws + WS_XR) + (size_t)brow * D + bcol;
#pragma unroll
    for (int ai = 0; ai < 2; ++ai)
#pragma unroll
      for (int m = 0; m < 4; ++m) {
        __builtin_amdgcn_sched_barrier(0);
        unsigned lr = lrow0 + ai * 128 + m * 16;
        unsigned o = lr * D + lcol0;
        float rsd = 1.f;
        if (EPI == EPI_OUTPROJ) rsd = sRu[lr];
#pragma unroll
        for (int bj = 0; bj < 2; ++bj)
#pragma unroll
          for (int n = 0; n < 2; ++n) {
            f32x4 v = acc[ai][bj][m][n] * rsd;
            uint2 pk; pk.x = cvt_pk_bf16(v[0], v[1]); pk.y = cvt_pk_bf16(v[2], v[3]);
            *(uint2*)(xo + o + bj * 128 + n * 16) = pk;
          }
      }
  } else if (EPI == EPI_GU) {
    bfu* hb = (bfu*)(P->ws + WS_BIG) + (size_t)brow * DFF + (bcol >> 1);
#pragma unroll
    for (int ai = 0; ai < 2; ++ai)
#pragma unroll
      for (int m = 0; m < 4; ++m) {
        __builtin_amdgcn_sched_barrier(0);
        unsigned o = (lrow0 + ai * 128 + m * 16) * DFF + wc * 16 + fq * 4;
#pragma unroll
        for (int bj = 0; bj < 2; ++bj) {
          f32x4 g = acc[ai][bj][m][0], u = acc[ai][bj][m][1];
          uint2 pk;
          pk.x = cvt_pk_bf16(silu_f(g[0]) * u[0], silu_f(g[1]) * u[1]);
          pk.y = cvt_pk_bf16(silu_f(g[2]) * u[2], silu_f(g[3]) * u[3]);
          *(uint2*)(hb + o + bj * 64) = pk;
        }
      }
  } else if (EPI == EPI_QKV) {
    const bool prompt = brow < MP;
    if (bcol < 2048) {
      const bool isq = bcol < 1024;
#pragma unroll
      for (int bj = 0; bj < 2; ++bj) {
        const int col32 = bcol + bj * 128 + wc * 32;
        int frb = fr, fqb = fq;
        asm volatile("" : "+v"(frb), "+v"(fqb));
        const unsigned lrow0b = wr * 64 + frb;
        const int d0 = ((col32 >> 5) & 1) * 16 + fqb * 4;
        float inv[4];
#pragma unroll
        for (int j = 0; j < 4; ++j) inv[j] = exp2f(-(float)(d0 + j) * (13.287712379549449f / 32.f)) * 0.15915494309189535f;
        const unsigned c1 = (col32 & ~63 & 1023) + d0;
        bfu* bdst;
        float* fdst = nullptr;
        if (isq) bdst = (bfu*)(P->ws + WS_Q) + (size_t)brow * 1024;
        else if (prompt) { bdst = (bfu*)(P->ws + WS_KP) + (size_t)brow * 1024; fdst = P->out + O_KP + (size_t)brow * 1024; }
        else { bdst = (bfu*)(P->ws + WS_KSM); fdst = P->out + O_KS + (size_t)(brow - MP) * 1024; }
#pragma unroll
        for (int ai = 0; ai < 2; ++ai)
#pragma unroll
          for (int m = 0; m < 4; ++m) {
            __builtin_amdgcn_sched_barrier(0);
            unsigned lr = lrow0b + ai * 128 + m * 16;
            int row = brow + lr;
            int pos = prompt ? (row & 4095) : 1024 + ((row - MP) & 63);
            f32x4 x1 = acc[ai][bj][m][0], x2 = acc[ai][bj][m][1], o1, o2;
#pragma unroll
            for (int j = 0; j < 4; ++j) {
              float rev = (float)pos * inv[j];
              rev -= floorf(rev);
              float sn = __builtin_amdgcn_sinf(rev), cs = __builtin_amdgcn_cosf(rev);
              o1[j] = x1[j] * cs - x2[j] * sn;
              o2[j] = x2[j] * cs + x1[j] * sn;
            }
            if (isq) {
              uint2 p1, p2;
              p1.x = cvt_pk_bf16(o1[0] * QSCALE, o1[1] * QSCALE); p1.y = cvt_pk_bf16(o1[2] * QSCALE, o1[3] * QSCALE);
              p2.x = cvt_pk_bf16(o2[0] * QSCALE, o2[1] * QSCALE); p2.y = cvt_pk_bf16(o2[2] * QSCALE, o2[3] * QSCALE);
              *(uint2*)(bdst + lr * 1024 + c1) = p1;
              *(uint2*)(bdst + lr * 1024 + c1 + 32) = p2;
            } else {
              *(f32x4*)(fdst + lr * 1024 + c1) = o1;
              *(f32x4*)(fdst + lr * 1024 + c1 + 32) = o2;
              unsigned bo;
              if (prompt) bo = lr * 1024 + c1;
              else { int rs = row - MP; bo = ((rs >> 6) * SKV + 1024 + (rs & 63)) * 1024 + c1; }
              uint2 p1, p2;
              p1.x = cvt_pk_bf16(o1[0], o1[1]); p1.y = cvt_pk_bf16(o1[2], o1[3]);
              p2.x = cvt_pk_bf16(o2[0], o2[1]); p2.y = cvt_pk_bf16(o2[2], o2[3]);
              *(uint2*)(bdst + bo) = p1;
              *(uint2*)(bdst + bo + 32) = p2;
            }
          }
      }
    } else {
      float* fdst = prompt ? P->out + O_VP + (size_t)brow * 1024 + (bcol - 2048) : P->out + O_VS + (size_t)(brow - MP) * 1024 + (bcol - 2048);
      bfu* vt = prompt ? (bfu*)(P->ws + WS_VTP) : (bfu*)(P->ws + WS_VTS);
#pragma unroll
      for (int ai = 0; ai < 2; ++ai)
#pragma unroll
        for (int m = 0; m < 4; ++m) {
          __builtin_amdgcn_sched_barrier(0);
          unsigned lr = lrow0 + ai * 128 + m * 16;
          int row = brow + lr;
          size_t tb;
          unsigned tstr;
          if (prompt) { tb = (size_t)(row >> 12) * 1024 * 4096 + (row & 4095); tstr = 4096; }
          else { int rs = row - MP; tb = (size_t)(rs >> 6) * 1024 * SKV + 1024 + (rs & 63); tstr = SKV; }
#pragma unroll
          for (int bj = 0; bj < 2; ++bj)
#pragma unroll
            for (int n = 0; n < 2; ++n) {
              f32x4 v = acc[ai][bj][m][n];
              unsigned lc = lcol0 + bj * 128 + n * 16;
              *(f32x4*)(fdst + lr * 1024 + lc) = v;
              unsigned c = bcol - 2048 + lc;
#pragma unroll
              for (int j = 0; j < 4; ++j) vt[tb + (size_t)(c + j) * tstr] = f2bf(v[j]);
            }
        }
    }
  }
}

template <int EPI>
__device__ __forceinline__ void gemm_phase(KP P, const bfu* __restrict__ A, const bfu* __restrict__ Bt, int K, int ntn, char* smem, const int wv) {
  const int tid = opaque_tid(wv), wid = wv, lane = tid & 63, wr = wid >> 2, wc = wid & 3, fr = lane & 15, fq = lane >> 4;
  LAS unsigned char* lds = (LAS unsigned char*)smem;
  constexpr bool SPLIT_SAMPLE = (EPI == EPI_OUTPROJ || EPI == EPI_RES);
  const int ntm = SPLIT_SAMPLE ? MP / 256 : MT / 256;
  const int ntiles = ntm * ntn;
  const int nig = 8 * ntn;
  const int nt = K / 64;
  const int G = gridDim.x, xper = G >> 3;
  const int vb = ((G & 7) == 0) ? (int)(blockIdx.x & 7) * xper + (int)(blockIdx.x >> 3) : (int)blockIdx.x;
  if (!SPLIT_SAMPLE && vb >= ntiles) return;
  unsigned voff[2];
#pragma unroll
  for (int i = 0; i < 2; ++i) { int R, C; stage_rc(tid * 16 + i * 8192, R, C); voff[i] = (unsigned)(R * K + C) * 2u; }
  const size_t kstep = (size_t)(64 * 2);
  const size_t hstep = (size_t)128 * K * 2;
  const size_t tstep = 2 * hstep;
  const unsigned ldsw = (unsigned)wid * 1024u;
  const int aoff = lds_byte(wr * 64 + fr, fq * 8), boff = lds_byte(wc * 32 + fr, fq * 8);
#define PG8_SA(b, h) (((b) * 2 + (h)) * HT_B)
#define PG8_SB(b, h) ((4 + (b) * 2 + (h)) * HT_B)
#define PG8_STAGE(bufoff, gbase) do { _Pragma("unroll") for (int _i = 0; _i < 2; ++_i) \
    __builtin_amdgcn_global_load_lds((const unsigned*)((const char*)(gbase) + voff[_i]), (LAS unsigned*)(lds + (bufoff) + ldsw + _i * 8192), 16, 0, 0); } while (0)
#define PG8_LDA(dst, b, h) do { _Pragma("unroll") for (int m = 0; m < 4; ++m) _Pragma("unroll") for (int k = 0; k < 2; ++k) dst[m][k] = *(const LAS bf16x8*)(lds + PG8_SA(b, h) + aoff + m * 2048 + k * 1024); } while (0)
#define PG8_LDB(dst, b, h) do { _Pragma("unroll") for (int n = 0; n < 2; ++n) _Pragma("unroll") for (int k = 0; k < 2; ++k) dst[n][k] = *(const LAS bf16x8*)(lds + PG8_SB(b, h) + boff + n * 2048 + k * 1024); } while (0)
#define PG8_MMA(ai, bj, At, Bt_) do { __builtin_amdgcn_s_setprio(1); _Pragma("unroll") for (int m = 0; m < 4; ++m) _Pragma("unroll") for (int n = 0; n < 2; ++n) _Pragma("unroll") for (int k = 0; k < 2; ++k) \
    acc[ai][bj][m][n] = __builtin_amdgcn_mfma_f32_16x16x32_bf16(Bt_[n][k], At[m][k], acc[ai][bj][m][n], 0, 0, 0); __builtin_amdgcn_s_setprio(0); } while (0)
#define PG8_WAIT_V(n) asm volatile("s_waitcnt vmcnt(" #n ")" ::: "memory")
#define PG8_WAIT_L(n) asm volatile("s_waitcnt lgkmcnt(" #n ")" ::: "memory")
#define PG8_BAR __builtin_amdgcn_s_barrier()
#define PG8_SCHED __builtin_amdgcn_sched_barrier(0)
#define TILE_PMPN(t, pm, pn) do { int gid_ = (t) / nig, fm_ = gid_ * 8, gsz_ = min(ntm - fm_, 8); pm = fm_ + ((t) % nig) % gsz_; pn = ((t) % nig) / gsz_; } while (0)
  int ctile = vb, cpm, cpn;
  TILE_PMPN(ctile, cpm, cpn);
  f32x4 acc[2][2][4][2];
  __syncthreads();
  const float* sRu = (const float*)(smem + 131072);
  if (EPI == EPI_OUTPROJ) {
    float* sR = (float*)(smem + 131072);
    const float* ssq = (const float*)(P->ws + WS_SSQ);
    int ui = 0;
    for (int t = vb; t < ntiles && ui < 8; t += G, ++ui) {
      int pm, pn;
      TILE_PMPN(t, pm, pn);
      if (tid < 256) sR[ui * 256 + tid] = ssd_rstd(ssq, pm * 256 + tid);
    }
    __syncthreads();
  }
  gemm_acc_init<EPI>(P, acc, cpm * 256, cpn * 256, wr, wc, fr, fq, sRu);
  bf16x8 At[4][2], B0[2][2], B1[2][2];
  const char* cA = (const char*)A + (size_t)cpm * tstep;
  const char* cB = (const char*)Bt + (size_t)cpn * tstep;
  PG8_STAGE(PG8_SB(0, 0), cB); PG8_STAGE(PG8_SA(0, 0), cA); PG8_STAGE(PG8_SB(0, 1), cB + hstep); PG8_STAGE(PG8_SA(0, 1), cA + hstep);
  if (wr == 1) PG8_BAR;
  PG8_WAIT_V(4); PG8_BAR;
  PG8_STAGE(PG8_SB(1, 0), cB + kstep); PG8_STAGE(PG8_SA(1, 0), cA + kstep); PG8_STAGE(PG8_SB(1, 1), cB + hstep + kstep);
  PG8_WAIT_V(6); PG8_BAR;
  for (;;) {
    const int ntile = ctile + G;
    const bool has_next = ntile < ntiles;
    int npm = cpm, npn = cpn;
    if (has_next) TILE_PMPN(ntile, npm, npn);
    const char* nA = (const char*)A + (size_t)npm * tstep;
    const char* nB = (const char*)Bt + (size_t)npn * tstep;
    for (int t = 0; t < nt; t += 2) {
      const bool last = (t == nt - 2);
      const char* a1 = cA + (size_t)(t + 1) * kstep;
      const char* a2 = last ? nA : cA + (size_t)(t + 2) * kstep;
      const char* b2 = last ? nB : cB + (size_t)(t + 2) * kstep;
      const char* a3 = a2 + kstep;
      const char* b3 = b2 + kstep;
      PG8_LDB(B0, 0, 0); PG8_SCHED; PG8_LDA(At, 0, 0); PG8_STAGE(PG8_SA(1, 1), a1 + hstep);
      PG8_WAIT_L(8); PG8_BAR; PG8_WAIT_L(0); PG8_MMA(0, 0, At, B0); PG8_BAR; PG8_SCHED;
      PG8_LDB(B1, 0, 1); PG8_STAGE(PG8_SB(0, 0), b2);
      PG8_BAR; PG8_WAIT_L(0); PG8_MMA(0, 1, At, B1); PG8_BAR;
      PG8_LDA(At, 0, 1); PG8_STAGE(PG8_SA(0, 0), a2);
      PG8_BAR; PG8_WAIT_L(0); PG8_MMA(1, 0, At, B0); PG8_BAR; PG8_SCHED;
      PG8_STAGE(PG8_SB(0, 1), b2 + hstep);
      PG8_WAIT_V(6); PG8_BAR; PG8_MMA(1, 1, At, B1); PG8_BAR;
      PG8_LDB(B0, 1, 0); PG8_SCHED; PG8_LDA(At, 1, 0); PG8_STAGE(PG8_SA(0, 1), a2 + hstep);
      PG8_WAIT_L(8); PG8_BAR; PG8_WAIT_L(0); PG8_MMA(0, 0, At, B0); PG8_BAR; PG8_SCHED;
      PG8_LDB(B1, 1, 1); PG8_STAGE(PG8_SB(1, 0), b3);
      PG8_BAR; PG8_WAIT_L(0); PG8_MMA(0, 1, At, B1); PG8_BAR;
      PG8_LDA(At, 1, 1); PG8_STAGE(PG8_SA(1, 0), a3);
      PG8_BAR; PG8_WAIT_L(0); PG8_MMA(1, 0, At, B0); PG8_BAR; PG8_SCHED;
      PG8_STAGE(PG8_SB(1, 1), b3 + hstep);
      PG8_WAIT_V(6); PG8_BAR; PG8_MMA(1, 1, At, B1); PG8_BAR;
    }
    gemm_epilogue<EPI>(P, acc, cpm * 256, cpn * 256, wr, wc, fr, fq, sRu);
    if (!has_next) break;
    sRu += 256;
    gemm_acc_init<EPI>(P, acc, npm * 256, npn * 256, wr, wc, fr, fq, sRu);
    ctile = ntile; cpm = npm; cpn = npn; cA = nA; cB = nB;
  }
  PG8_WAIT_V(0);
  if (wr == 0) PG8_BAR;
  PG8_BAR;
  if (SPLIT_SAMPLE) {
    float* sRed = (float*)smem;
    const int kw = K >> 3;
    for (int task = blockIdx.x; task < 256; task += G) {
      const int rb = task >> 4, cb = task & 15;
      const bfu* ap = A + (size_t)(MP + rb * 32 + fr) * K + wid * kw + fq * 8;
      const bfu* bp = Bt + (size_t)(cb * 64 + fr) * K + wid * kw + fq * 8;
      f32x4 pacc[2][4];
#pragma unroll
      for (int rt = 0; rt < 2; ++rt)
#pragma unroll
        for (int ct = 0; ct < 4; ++ct) pacc[rt][ct] = f32x4{0.f, 0.f, 0.f, 0.f};
      for (int ks = 0; ks < kw; ks += 32) {
        bf16x8 af[2], bf[4];
#pragma unroll
        for (int rt = 0; rt < 2; ++rt) af[rt] = *(const bf16x8*)(ap + (size_t)rt * 16 * K + ks);
#pragma unroll
        for (int ct = 0; ct < 4; ++ct) bf[ct] = *(const bf16x8*)(bp + (size_t)ct * 16 * K + ks);
#pragma unroll
        for (int rt = 0; rt < 2; ++rt)
#pragma unroll
          for (int ct = 0; ct < 4; ++ct) pacc[rt][ct] = mfma16(af[rt], bf[ct], pacc[rt][ct]);
      }
      __syncthreads();
#pragma unroll
      for (int rt = 0; rt < 2; ++rt)
#pragma unroll
        for (int ct = 0; ct < 4; ++ct) *(f32x4*)(sRed + ((wid * 8 + rt * 4 + ct) * 64 + lane) * 4) = pacc[rt][ct];
      __syncthreads();
      {
        f32x4 sum = {0.f, 0.f, 0.f, 0.f};
#pragma unroll
        for (int ww = 0; ww < 8; ++ww) sum += *(const f32x4*)(sRed + ((ww * 8 + wid) * 64 + lane) * 4);
        const int col = cb * 64 + (wid & 3) * 16 + fr;
#pragma unroll
        for (int j = 0; j < 4; ++j) {
          const int srow = rb * 32 + (wid >> 2) * 16 + fq * 4 + j;
          bfu* op = (bfu*)(P->ws + WS_XR) + (size_t)(MP + srow) * D + col;
          if (EPI == EPI_OUTPROJ) {
            const float rs = ssd_rstd((const float*)(P->ws + WS_SSQ), MP + srow);
            *op = f2bf(P->in[1][(size_t)srow * D + col] + rs * sum[j]);
          } else {
            *op = f2bf(bf2f(*op) + sum[j]);
          }
        }
      }
    }
  }
#undef PG8_SA
#undef PG8_SB
#undef PG8_STAGE
#undef PG8_LDA
#undef PG8_LDB
#undef PG8_MMA
#undef PG8_WAIT_V
#undef PG8_WAIT_L
#undef PG8_BAR
#undef PG8_SCHED
#undef TILE_PMPN
}

constexpr int S_LDB = 136;
constexpr int S_LDT = 72;
constexpr int S_LDCB = 68;
__device__ __forceinline__ void phase_ssd(KP P, char* smem, const int wv) {
  bfu* sB = (bfu*)smem;
  bfu* sC = sB + 64 * S_LDB;
  bfu* sBT = sC + 64 * S_LDB;
  bfu* sXT = sBT + 128 * S_LDT;
  bfu* sG = sXT + 128 * S_LDT;
  bfu* sH = sG + 2 * 64 * S_LDT;
  float* sAc = (float*)(sH + 8 * 16 * S_LDB);
  float* sDt = sAc + 512;
  float* sW = sDt + 512;
  float* sSq = sW + 512;
  bfu* sZ = (bfu*)(sSq + 512);
  float* sWc = (float*)(sZ + 64 * S_LDB);
  const int tid = opaque_tid(wv), w = wv, lane = tid & 63, fr = lane & 15, fq = lane >> 4;
  const int hl = w >> 2, ps = w & 3;
  const bfu* zx = (const bfu*)(P->ws + WS_BIG);
  const float* dtb = (const float*)(P->ws + WS_DT);
  float* ssqp = (float*)(P->ws + WS_SSQ);
  bfu* yg = (bfu*)(P->out + O_KP);
  const float* convw = P->in[10];
  const float* convb = P->in[11];
  bfu* myH = sH + w * 16 * S_LDB;
  float* myAc = sAc + w * 64;
  float* myDt = sDt + w * 64;
  float* myW = sW + w * 64;
  float* mySq = sSq + w * 64;
  const bool conv_role = w < 6;

  for (int unit = blockIdx.x; unit < 384; unit += gridDim.x) {
    int seq, g, hp, row0, nch;
    const float* hist = nullptr;
    const float* h0 = nullptr;
    float* hT;
    if (unit < 256) {
      seq = unit >> 4; g = (unit >> 2) & 3; hp = unit & 3;
      row0 = seq * 4096; nch = 64;
      hT = P->out + O_SSMP + (size_t)seq * 32 * 8192;
    } else {
      int u = unit - 256;
      seq = u >> 4; g = (u >> 2) & 3; hp = u & 3;
      row0 = MP + seq * 64; nch = 1;
      hist = P->in[2] + (size_t)seq * 3 * CONVD;
      h0 = P->in[3] + (size_t)seq * 32 * 8192;
      hT = P->out + O_SSMS + (size_t)seq * 32 * 8192;
    }
    const int head = g * 8 + hp * 2 + hl;
    const float A_h = -__expf(P->in[13][head]);
    const float D_h = P->in[14][head];
    f32x4 hacc[8];
    if (h0) {
#pragma unroll
      for (int nt = 0; nt < 8; ++nt)
#pragma unroll
        for (int j = 0; j < 4; ++j) hacc[nt][j] = h0[((size_t)head * 64 + ps * 16 + fq * 4 + j) * 128 + nt * 16 + fr];
    } else {
#pragma unroll
      for (int nt = 0; nt < 8; ++nt) hacc[nt] = f32x4{0.f, 0.f, 0.f, 0.f};
    }
    __syncthreads();
#pragma unroll
    for (int nt = 0; nt < 8; ++nt)
#pragma unroll
      for (int j = 0; j < 4; ++j) myH[(fq * 4 + j) * S_LDB + nt * 16 + fr] = f2bf(hacc[nt][j]);
    const int cgp = tid % 48, rs = tid / 48;
    int cc;
    if (cgp < 16) cc = (g * 8 + hp * 2) * 64 + cgp * 8;
    else if (cgp < 32) cc = DI + g * 128 + (cgp - 16) * 8;
    else cc = DI + 512 + g * 128 + (cgp - 32) * 8;
    if (tid < 384) {
      if (rs < 5) {
        const float* src = (rs < 4) ? convw + rs * CONVD + cc : convb + cc;
        f32x4 a = *(const f32x4*)src, bq = *(const f32x4*)(src + 4);
        *(f32x4*)(sWc + rs * 384 + cgp * 8) = a;
        *(f32x4*)(sWc + rs * 384 + cgp * 8 + 4) = bq;
      }
    }
    const int zt = tid - 384;
    const int zrow = (zt >> 1) & 63, zhalf = zt & 1;

    u32x4 pre[11];
    float dtv;
    {
      const int r0 = row0;
      if (conv_role) {
        const bfu* zxc = zx + ((size_t)r0 - 3) * ZXW + DI;
#pragma unroll
        for (int k = 0; k < 11; ++k) {
          int rr = rs * 8 - 3 + k;
          if (rr < 0) {
            if (hist) {
              f32x4 a = *(const f32x4*)(hist + (3 + rr) * CONVD + cc), bq = *(const f32x4*)(hist + (3 + rr) * CONVD + cc + 4);
              pre[k] = u32x4{pack2(a[0], a[1]), pack2(a[2], a[3]), pack2(bq[0], bq[1]), pack2(bq[2], bq[3])};
            } else {
              pre[k] = u32x4{0u, 0u, 0u, 0u};
            }
          } else {
            pre[k] = *(const u32x4*)(zxc + (unsigned)((rs * 8 + k) * ZXW + cc));
          }
        }
      } else {
        const bfu* zsrc = zx + (size_t)(r0 + zrow) * ZXW + (g * 8 + hp * 2) * 64 + zhalf * 64;
#pragma unroll
        for (int k = 0; k < 8; ++k) pre[k] = *(const u32x4*)(zsrc + k * 8);
#pragma unroll
        for (int k = 8; k < 11; ++k) pre[k] = u32x4{0u, 0u, 0u, 0u};
      }
      dtv = dtb[(size_t)(r0 + lane) * 32 + head];
    }

    for (int c = 0; c < nch; ++c) {
      const int r0 = row0 + c * 64;
      lds_barrier();
      if (conv_role) {
        const float* wcol = sWc + cgp * 8;
        u32x4 ovr[8];
#pragma unroll
        for (int e2 = 0; e2 < 4; ++e2) {
          __builtin_amdgcn_sched_barrier(0);
          float w0[4], w1[4];
#pragma unroll
          for (int tap = 0; tap < 4; ++tap) { w0[tap] = wcol[tap * 384 + 2 * e2]; w1[tap] = wcol[tap * 384 + 2 * e2 + 1]; }
          const float bl = wcol[4 * 384 + 2 * e2], bh = wcol[4 * 384 + 2 * e2 + 1];
#pragma unroll
          for (int i = 0; i < 8; ++i) {
            float ylo = bl, yhi = bh;
#pragma unroll
            for (int tap = 0; tap < 4; ++tap) {
              unsigned rw = pre[i + tap][e2];
              ylo += w0[tap] * __uint_as_float(rw << 16);
              yhi += w1[tap] * __uint_as_float(rw & 0xffff0000u);
            }
            ovr[i][e2] = cvt_pk_bf16(silu_f(ylo), silu_f(yhi));
          }
        }
        if (cgp >= 16) {
          bfu* rowdst = (cgp < 32) ? (sB + (cgp - 16) * 8) : (sC + (cgp - 32) * 8);
#pragma unroll
          for (int i = 0; i < 8; ++i) *(u32x4*)(rowdst + (rs * 8 + i) * S_LDB) = ovr[i];
        }
        if (cgp < 32) {
          bfu* coldst = (cgp < 16) ? (sXT + (cgp * 8) * S_LDT + rs * 8) : (sBT + ((cgp - 16) * 8) * S_LDT + rs * 8);
#pragma unroll
          for (int e = 0; e < 8; ++e) {
            const int e2 = e >> 1, sh = (e & 1) * 16;
            u32x4 o;
            o[0] = ((ovr[0][e2] >> sh) & 0xffffu) | ((ovr[1][e2] >> sh) << 16);
            o[1] = ((ovr[2][e2] >> sh) & 0xffffu) | ((ovr[3][e2] >> sh) << 16);
            o[2] = ((ovr[4][e2] >> sh) & 0xffffu) | ((ovr[5][e2] >> sh) << 16);
            o[3] = ((ovr[6][e2] >> sh) & 0xffffu) | ((ovr[7][e2] >> sh) << 16);
            *(u32x4*)(coldst + e * S_LDT) = o;
          }
        }
      } else {
#pragma unroll
        for (int k = 0; k < 8; ++k) *(u32x4*)(sZ + zrow * S_LDB + zhalf * 64 + k * 8) = pre[k];
      }
      float a63;
      {
        float ac = dtv * A_h;
#pragma unroll
        for (int o = 1; o < 64; o <<= 1) {
          float t = shup(ac, o, lane);
          if (lane >= o) ac += t;
        }
        a63 = shidx(ac, 63);
        myAc[lane] = ac;
        myDt[lane] = dtv;
        myW[lane] = __expf(a63 - ac) * dtv;
      }
      lds_barrier();
      if (c + 1 < nch) {
        const int r1 = r0 + 64;
        int rsl = rs;
        asm volatile("" : "+v"(rsl));
        if (conv_role) {
          const bfu* zxc = zx + ((size_t)r1 - 3) * ZXW + DI;
#pragma unroll
          for (int k = 0; k < 11; ++k) pre[k] = *(const u32x4*)(zxc + (unsigned)((rsl * 8 + k) * ZXW + cc));
        } else {
          const bfu* zsrc = zx + (size_t)(r1 + zrow) * ZXW + (g * 8 + hp * 2) * 64 + zhalf * 64;
#pragma unroll
          for (int k = 0; k < 8; ++k) pre[k] = *(const u32x4*)(zsrc + k * 8);
        }
        dtv = dtb[(size_t)(r1 + lane) * 32 + head];
      }
      int frc = fr, fqc = fq;
      asm volatile("" : "+v"(frc), "+v"(fqc));
      {
        const int it = w >> 1, jt0 = (w & 1) * 2;
        f32x4 cb[2] = {{0.f, 0.f, 0.f, 0.f}, {0.f, 0.f, 0.f, 0.f}};
#pragma unroll
        for (int ks = 0; ks < 4; ++ks) {
          bf16x8 a = lds_b128(sC + (it * 16 + frc) * S_LDB + ks * 32 + fqc * 8);
          bf16x8 b0 = lds_b128(sB + (jt0 * 16 + frc) * S_LDB + ks * 32 + fqc * 8);
          bf16x8 b1 = lds_b128(sB + ((jt0 + 1) * 16 + frc) * S_LDB + ks * 32 + fqc * 8);
          cb[0] = mfma16(a, b0, cb[0]);
          cb[1] = mfma16(a, b1, cb[1]);
        }
        const int i0 = it * 16 + fqc * 4;
#pragma unroll
        for (int hh = 0; hh < 2; ++hh) {
          const float* hAc = sAc + hh * 256;
          const float* hDt = sDt + hh * 256;
          const f32x4 aci = *(const f32x4*)(hAc + i0);
#pragma unroll
          for (int t = 0; t < 2; ++t) {
            const int jj = (jt0 + t) * 16 + frc;
            const float acj = hAc[jj], dtj = hDt[jj];
#pragma unroll
            for (int j = 0; j < 4; ++j) {
              const float gv = (jj <= i0 + j) ? cb[t][j] * __expf(aci[j] - acj) * dtj : 0.f;
              sG[(hh * 64 + i0 + j) * S_LDT + jj] = f2bf(gv);
            }
          }
        }
      }
      lds_barrier();
      const bfu* xrow = sXT + (hl * 64 + ps * 16 + frc) * S_LDT;
#pragma unroll 1
      for (int it = 0; it < 4; ++it) {
        f32x4 yacc = {0.f, 0.f, 0.f, 0.f}, oacc = {0.f, 0.f, 0.f, 0.f};
        const bfu* grow = sG + (hl * 64 + it * 16 + frc) * S_LDT;
#pragma unroll
        for (int ks = 0; ks < 2; ++ks) {
          if (ks * 32 <= it * 16 + 15) {
            const int j0 = ks * 32 + fqc * 8;
            bf16x8 gfr = lds_b128(grow + j0);
            bf16x8 bfv = lds_b128(xrow + j0);
            yacc = mfma16(gfr, bfv, yacc);
          }
        }
#pragma unroll
        for (int ks = 0; ks < 4; ++ks) {
          bf16x8 a = lds_b128(sC + (it * 16 + frc) * S_LDB + ks * 32 + fqc * 8);
          bf16x8 b = lds_b128(myH + frc * S_LDB + ks * 32 + fqc * 8);
          oacc = mfma16(a, b, oacc);
        }
#pragma unroll
        for (int j = 0; j < 4; ++j) {
          int ii = it * 16 + fqc * 4 + j;
          float xv = bf2f(xrow[ii]);
          float y = yacc[j] + __expf(myAc[ii]) * oacc[j] + D_h * xv;
          float zv = bf2f(sZ[ii * S_LDB + hl * 64 + ps * 16 + frc]);
          float ygv = y * silu_f(zv);
          yg[(size_t)(r0 + ii) * DI + head * 64 + ps * 16 + frc] = f2bf(ygv);
          float sq = ygv * ygv;
          sq = row16_sum(sq);
          if (frc == 0) mySq[ii] = sq;
        }
      }
      {
        const float dec = __expf(a63);
#pragma unroll
        for (int nt = 0; nt < 8; ++nt) hacc[nt] *= dec;
#pragma unroll
        for (int ks = 0; ks < 2; ++ks) {
          const int j0 = ks * 32 + fqc * 8;
          bf16x8 xr = lds_b128(xrow + j0);
          f32x4 w0 = *(const f32x4*)(myW + j0), w1 = *(const f32x4*)(myW + j0 + 4);
          u32x4 xu = __builtin_bit_cast(u32x4, xr);
          u32x4 pk;
          pk[0] = cvt_pk_bf16(__uint_as_float(xu[0] << 16) * w0[0], __uint_as_float(xu[0] & 0xffff0000u) * w0[1]);
          pk[1] = cvt_pk_bf16(__uint_as_float(xu[1] << 16) * w0[2], __uint_as_float(xu[1] & 0xffff0000u) * w0[3]);
          pk[2] = cvt_pk_bf16(__uint_as_float(xu[2] << 16) * w1[0], __uint_as_float(xu[2] & 0xffff0000u) * w1[1]);
          pk[3] = cvt_pk_bf16(__uint_as_float(xu[3] << 16) * w1[2], __uint_as_float(xu[3] & 0xffff0000u) * w1[3]);
          bf16x8 af = __builtin_bit_cast(bf16x8, pk);
#pragma unroll
          for (int nt = 0; nt < 8; ++nt) {
            bf16x8 b = lds_b128(sBT + (nt * 16 + frc) * S_LDT + j0);
            hacc[nt] = mfma16(af, b, hacc[nt]);
          }
        }
#pragma unroll
        for (int nt = 0; nt < 8; ++nt)
#pragma unroll
          for (int j = 0; j < 4; ++j) myH[(fqc * 4 + j) * S_LDB + nt * 16 + frc] = f2bf(hacc[nt][j]);
      }
      lds_barrier();
      if (tid < 64) {
        float sm = 0.f;
#pragma unroll
        for (int ww = 0; ww < 8; ++ww) sm += sSq[ww * 64 + tid];
        ssqp[(size_t)(r0 + tid) * 16 + g * 4 + hp] = sm;
      }
    }
#pragma unroll
    for (int nt = 0; nt < 8; ++nt)
#pragma unroll
      for (int j = 0; j < 4; ++j) hT[((size_t)head * 64 + ps * 16 + fq * 4 + j) * 128 + nt * 16 + fr] = hacc[nt][j];
  }
}

constexpr int A_STAGE = 32768;
constexpr int A_LDO = 132;
__device__ __forceinline__ int kswz(int key) { return ((key >> 1) & 1) | (((key >> 3) & 3) << 1); }
__device__ __forceinline__ void phase_attn(KP P, char* smem, const int wv) {
  LAS unsigned char* lds = (LAS unsigned char*)smem;
  float* sO = (float*)smem;
  const int tid = opaque_tid(wv), w = wv, lane = tid & 63, fr = lane & 15, fq = lane >> 4;
  const int cm = w >> 2, rg = w & 3;
  const bfu* qb = (const bfu*)(P->ws + WS_Q);
  bfu* ao = (bfu*)(P->ws + WS_AO);
  float lam;
  {
    float a = P->in[18][lane] * P->in[19][lane];
    float b = P->in[20][lane] * P->in[21][lane];
    a = wave_sum(a, lane); b = wave_sum(b, lane);
    lam = __expf(a) - __expf(b) + LAMBDA_INIT;
  }
  const float* subln = P->in[22];
  unsigned ksrc[2], vsrc_row[2], vsrc_col[2];
#pragma unroll
  for (int i = 0; i < 2; ++i) {
    int p = (2 * w + i) * 64 + lane;
    int row = p >> 3, phys = p & 7;
    int map = row >> 6, key = row & 63;
    ksrc[i] = (unsigned)(key * 1024 + map * 64 + ((phys ^ kswz(key)) << 3));
    vsrc_row[i] = (unsigned)row;
    vsrc_col[i] = (unsigned)((phys ^ (row & 7)) << 3);
  }
  unsigned koff[4];
#pragma unroll
  for (int t4 = 0; t4 < 4; ++t4) {
    int key = (t4 >> 1) * 32 + (fr >> 2) * 8 + (t4 & 1) * 4 + (fr & 3);
    koff[t4] = (unsigned)((cm * 64 + key) * 128 + ((fq ^ kswz(key)) << 4));
  }
  const unsigned voff0 = 16384u + (unsigned)(fr * 128 + ((fq ^ (fr & 7)) << 4));
  const unsigned kb0 = koff[0], kb1 = koff[0] ^ 64u, vb0 = voff0, vb1 = voff0 ^ 64u;

  const int G = gridDim.x;
  const bool xcd_order = (G == 256);
  const int nrounds = xcd_order ? 17 : (4096 + 64 + G - 1) / G;
  for (int r = 0; r < nrounds; ++r) {
    int b, h, pc;
    bool sample = false;
    if (xcd_order) {
      int x = blockIdx.x & 7, j = blockIdx.x >> 3;
      if (r < 16) { int bh = r * 8 + x; b = bh >> 3; h = bh & 7; pc = (r & 1) ? 31 - j : j; }
      else { if (j >= 8) break; int sidx = x * 8 + j; b = sidx >> 3; h = sidx & 7; pc = 0; sample = true; }
    } else {
      int u = blockIdx.x + r * G;
      if (u >= 4096 + 64) break;
      if (u < 4096) { pc = 31 - (u >> 7); int bh = u & 127; b = bh >> 3; h = bh & 7; }
      else { int sidx = u - 4096; b = sidx >> 3; h = sidx & 7; pc = 0; sample = true; }
    }
    int qrow0, nkt, Tstr;
    const bfu* kbase;
    const bfu* vtbase;
    if (!sample) {
      qrow0 = b * 4096 + pc * 128;
      nkt = 2 * pc + 2;
      Tstr = 4096;
      kbase = (const bfu*)(P->ws + WS_KP) + (size_t)b * 4096 * 1024 + h * 128;
      vtbase = (const bfu*)(P->ws + WS_VTP) + (size_t)(b * 8 + h) * 128 * 4096;
    } else {
      qrow0 = MP + b * 64;
      nkt = 17;
      Tstr = SKV;
      kbase = (const bfu*)(P->ws + WS_KSM) + (size_t)b * SKV * 1024 + h * 128;
      vtbase = (const bfu*)(P->ws + WS_VTS) + (size_t)(b * 8 + h) * 128 * SKV;
    }
    const bool wave_valid = !sample || rg < 2;
    const int my_nkt = sample ? nkt : (rg < 2 ? nkt - 1 : nkt);
    bf16x8 qf[2][2];
    {
      const int qr = wave_valid ? (qrow0 + rg * 32 + fr) : qrow0;
      const bfu* qp = qb + (size_t)qr * 1024 + h * 128 + cm * 64 + fq * 8;
#pragma unroll
      for (int qt = 0; qt < 2; ++qt) {
        qf[qt][0] = *(const bf16x8*)(qp + (wave_valid ? qt * 16 * 1024 : 0));
        qf[qt][1] = *(const bf16x8*)(qp + (wave_valid ? qt * 16 * 1024 : 0) + 32);
      }
    }
    float mrun[2] = {-INFINITY, -INFINITY}, lrun[2] = {0.f, 0.f};
    f32x4 oacc[2][8];
#pragma unroll
    for (int qt = 0; qt < 2; ++qt)
#pragma unroll
      for (int et = 0; et < 8; ++et) oacc[qt][et] = f32x4{0.f, 0.f, 0.f, 0.f};

#define ATT_STAGE(stage, kt_) do { \
      const bfu* kt_base = kbase + (size_t)(kt_) * 64 * 1024; \
      const bfu* vt_base = vtbase + (size_t)(kt_) * 64; \
      _Pragma("unroll") for (int _i = 0; _i < 2; ++_i) \
        __builtin_amdgcn_global_load_lds((const unsigned*)(kt_base + ksrc[_i]), (LAS unsigned*)(lds + (stage) * A_STAGE + (2 * w + _i) * 1024), 16, 0, 0); \
      _Pragma("unroll") for (int _i = 0; _i < 2; ++_i) \
        __builtin_amdgcn_global_load_lds((const unsigned*)(vt_base + (size_t)vsrc_row[_i] * Tstr + vsrc_col[_i]), (LAS unsigned*)(lds + (stage) * A_STAGE + 16384 + (2 * w + _i) * 1024), 16, 0, 0); \
    } while (0)

#define ATT_S_SOFTMAX(stage_) do { \
      LAS unsigned char* sb = lds + (stage_) * A_STAGE; \
      f32x4 st[2][4]; \
      __builtin_amdgcn_s_setprio(1); \
      _Pragma("unroll") for (int t4 = 0; t4 < 4; ++t4) { \
        bf16x8 a0 = *(const LAS bf16x8*)(sb + kb0 + (t4 >> 1) * 4096 + (t4 & 1) * 512); \
        bf16x8 a1 = *(const LAS bf16x8*)(sb + kb1 + (t4 >> 1) * 4096 + (t4 & 1) * 512); \
        _Pragma("unroll") for (int qt = 0; qt < 2; ++qt) { \
          f32x4 z = {0.f, 0.f, 0.f, 0.f}; \
          z = mfma16(a0, qf[qt][0], z); \
          st[qt][t4] = mfma16(a1, qf[qt][1], z); \
        } \
      } \
      __builtin_amdgcn_s_setprio(0); \
      _Pragma("unroll") for (int qt = 0; qt < 2; ++qt) { \
        float mx = st[qt][0][0]; \
        _Pragma("unroll") for (int t4 = 0; t4 < 4; ++t4) \
          _Pragma("unroll") for (int j = 0; j < 4; ++j) mx = fmaxf(mx, st[qt][t4][j]); \
          \
        if (__builtin_amdgcn_ballot_w64(mx - mrun[qt] > 8.f) != 0ull) { \
          mx = xmax_16_32(mx); \
          const float mnew = fmaxf(mrun[qt], mx); \
          const float alpha = __builtin_amdgcn_exp2f(mrun[qt] - mnew); \
          lrun[qt] *= alpha; \
          mrun[qt] = mnew; \
          _Pragma("unroll") for (int et = 0; et < 8; ++et) oacc[qt][et] *= alpha; \
        } \
        const f32x2 m2 = {mrun[qt], mrun[qt]}; \
        f32x2 ls2 = {0.f, 0.f}; \
        _Pragma("unroll") for (int t4 = 0; t4 < 4; ++t4) { \
          f32x2 lo = f32x2{st[qt][t4][0], st[qt][t4][1]} - m2, hi = f32x2{st[qt][t4][2], st[qt][t4][3]} - m2; \
          lo[0] = __builtin_amdgcn_exp2f(lo[0]); lo[1] = __builtin_amdgcn_exp2f(lo[1]); \
          hi[0] = __builtin_amdgcn_exp2f(hi[0]); hi[1] = __builtin_amdgcn_exp2f(hi[1]); \
          ls2 += lo; ls2 += hi; \
          st[qt][t4] = f32x4{lo[0], lo[1], hi[0], hi[1]}; \
        } \
        lrun[qt] += ls2[0] + ls2[1]; \
        _Pragma("unroll") for (int kk = 0; kk < 2; ++kk) { \
          u32x4 pk; \
          pk[0] = cvt_pk_bf16(st[qt][2 * kk][0], st[qt][2 * kk][1]); \
          pk[1] = cvt_pk_bf16(st[qt][2 * kk][2], st[qt][2 * kk][3]); \
          pk[2] = cvt_pk_bf16(st[qt][2 * kk + 1][0], st[qt][2 * kk + 1][1]); \
          pk[3] = cvt_pk_bf16(st[qt][2 * kk + 1][2], st[qt][2 * kk + 1][3]); \
          pb[qt][kk] = __builtin_bit_cast(bf16x8, pk); \
        } \
      } \
    } while (0)
#define ATT_PV(stage_) do { \
      LAS unsigned char* sb = lds + (stage_) * A_STAGE; \
      __builtin_amdgcn_s_setprio(1); \
      _Pragma("unroll") for (int kk = 0; kk < 2; ++kk) \
        _Pragma("unroll") for (int et = 0; et < 8; ++et) { \
          bf16x8 a = *(const LAS bf16x8*)(sb + (kk ? vb1 : vb0) + et * 2048); \
          oacc[0][et] = mfma16(a, pb[0][kk], oacc[0][et]); \
          oacc[1][et] = mfma16(a, pb[1][kk], oacc[1][et]); \
        } \
      __builtin_amdgcn_s_setprio(0); \
    } while (0)

    __syncthreads();
    ATT_STAGE(0, 0);
    if (nkt > 1) ATT_STAGE(1, 1);
    if (nkt > 1) asm volatile("s_waitcnt vmcnt(4)" ::: "memory");
    else asm volatile("s_waitcnt vmcnt(0)" ::: "memory");
    if (cm == 1) lds_barrier();
    bf16x8 pb[2][2];
#pragma unroll 1
    for (int kt = 0; kt < nkt; ++kt) {
      const bool act = wave_valid && kt < my_nkt;
      lds_barrier();
      if (kt + 2 < nkt) ATT_STAGE((kt + 2) & 3, kt + 2);
      if (act) ATT_S_SOFTMAX(kt & 3);
      if (kt + 1 < nkt) {
        if (kt + 2 < nkt) asm volatile("s_waitcnt vmcnt(4)" ::: "memory");
        else asm volatile("s_waitcnt vmcnt(0)" ::: "memory");
      }
      lds_barrier();
      if (act) ATT_PV(kt & 3);
    }
    if (cm == 0) lds_barrier();
#undef ATT_S_SOFTMAX
#undef ATT_PV
#undef ATT_STAGE
    lrun[0] = xsum_16_32(lrun[0]);
    lrun[1] = xsum_16_32(lrun[1]);
    __syncthreads();
    if (cm == 1 && wave_valid) {
#pragma unroll
      for (int qt = 0; qt < 2; ++qt) {
        float rl = 1.f / lrun[qt];
#pragma unroll
        for (int et = 0; et < 8; ++et) *(f32x4*)(sO + (rg * 32 + qt * 16 + fr) * A_LDO + et * 16 + fq * 4) = oacc[qt][et] * rl;
      }
    }
    __syncthreads();
    if (cm == 0 && wave_valid) {
#pragma unroll
      for (int qt = 0; qt < 2; ++qt) {
        float rl = 1.f / lrun[qt];
        float ss = 0.f;
#pragma unroll
        for (int et = 0; et < 8; ++et) {
          f32x4 o1 = *(const f32x4*)(sO + (rg * 32 + qt * 16 + fr) * A_LDO + et * 16 + fq * 4);
          f32x4 o = oacc[qt][et] * rl - o1 * lam;
          oacc[qt][et] = o;
          ss += o[0] * o[0] + o[1] * o[1] + o[2] * o[2] + o[3] * o[3];
        }
        ss = xsum_16_32(ss);
        float rstd = rsqrtf(ss * (1.f / 128.f) + EPS) * (1.f - LAMBDA_INIT);
        bfu* dst = ao + (size_t)(qrow0 + rg * 32 + qt * 16 + fr) * 1024 + h * 128;
        int fqe = fq;
        asm volatile("" : "+v"(fqe));
#pragma unroll
        for (int et = 0; et < 8; ++et) {
          int e0 = et * 16 + fqe * 4;
          f32x4 sw = *(const f32x4*)(subln + e0);
          uint2 pk;
          pk.x = cvt_pk_bf16(oacc[qt][et][0] * rstd * sw[0], oacc[qt][et][1] * rstd * sw[1]);
          pk.y = cvt_pk_bf16(oacc[qt][et][2] * rstd * sw[2], oacc[qt][et][3] * rstd * sw[3]);
          *(uint2*)(dst + e0) = pk;
        }
      }
    }
  }
}

#define XB_TMO      128
#define XB_XCNT(j)  (256  + 64 * (j))
#define XB_XSUB(j)  (1280 + 64 * (j))
#define XB_XGEN(j)  (2304 + 64 * (j))
#define XB_TOP      3328
#define XB_TOPGEN   3392
#define XCD_BAR_WORDS 3456
#define XB_SPIN_CAP (1u << 22)
__device__ __forceinline__ unsigned xb_ld(unsigned* p)              { return __hip_atomic_load(p, __ATOMIC_RELAXED, __HIP_MEMORY_SCOPE_AGENT); }
__device__ __forceinline__ unsigned xb_add(unsigned* p, unsigned v) { return __hip_atomic_fetch_add(p, v, __ATOMIC_RELAXED, __HIP_MEMORY_SCOPE_AGENT); }
__device__ __forceinline__ unsigned xb_xcc_id() { return (unsigned)__builtin_amdgcn_s_getreg((3 << 11) | 20) & 0xFu; }
#define XB_SPIN(cond, bar) do { unsigned _sp = 0; while (cond) { __builtin_amdgcn_s_sleep(1); \
    if ((++_sp & 255u) == 0u) { if (xb_ld(&(bar)[XB_TMO])) break; if (_sp > XB_SPIN_CAP) { atomicAdd(&(bar)[XB_TMO], 1u); break; } } } } while (0)
__device__ __forceinline__ void xcd_barrier_complete(unsigned* bar, unsigned x, unsigned& nloc, unsigned& nx) {
  const unsigned G = gridDim.x;
  unsigned sum, cnt, mine, sp = 0u;
  for (;;) {
    sum = 0u; cnt = 0u; mine = 0u;
#pragma unroll
    for (unsigned j = 0; j < 16; ++j) { const unsigned c = xb_ld(&bar[XB_XCNT(j)]); sum += c; cnt += (c > 0u) ? 1u : 0u; mine = (j == x) ? c : mine; }
    if (sum == G) break;
    __builtin_amdgcn_s_sleep(1);
    if ((++sp & 255u) == 0u) { if (xb_ld(&bar[XB_TMO])) break; if (sp > XB_SPIN_CAP) { atomicAdd(&bar[XB_TMO], 1u); break; } }
  }
  nloc = mine > 0u ? mine : 1u; nx = cnt > 0u ? cnt : 1u;
}
__device__ __forceinline__ void xcd_barrier(unsigned* bar, volatile __attribute__((address_space(3))) unsigned* st, const int tid) {
  asm volatile("s_waitcnt vmcnt(0)" ::: "memory");
  __syncthreads();
  if (tid == 0) {
    const unsigned x = xb_xcc_id();
    __builtin_amdgcn_s_waitcnt(0);
    unsigned nloc = st[0], nx = st[1];
    if (nloc == 0u) { xcd_barrier_complete(bar, x, nloc, nx); st[0] = nloc; st[1] = nx; }
    const unsigned old = xb_add(&bar[XB_XSUB(x)], 1u);
    const unsigned gen = old / nloc;
    if (old + 1u == (gen + 1u) * nloc) {
      __builtin_amdgcn_fence(__ATOMIC_RELEASE, "agent");
      asm volatile("s_waitcnt vmcnt(0)" ::: "memory");
      const unsigned og = xb_add(&bar[XB_TOP], 1u);
      const unsigned tg = og / nx;
      if (og + 1u == (tg + 1u) * nx) xb_add(&bar[XB_TOPGEN], 1u);
      else XB_SPIN(xb_ld(&bar[XB_TOPGEN]) == tg, bar);
      __builtin_amdgcn_fence(__ATOMIC_ACQUIRE, "agent");
      xb_add(&bar[XB_XGEN(x)], 1u);
      asm volatile("s_waitcnt vmcnt(0)" ::: "memory");
    } else {
      XB_SPIN(xb_ld(&bar[XB_XGEN(x)]) == gen, bar);
      __builtin_amdgcn_fence(__ATOMIC_ACQUIRE, "agent");
      asm volatile("s_waitcnt vmcnt(0)" ::: "memory");
    }
  }
  __syncthreads();
}

__global__ void __launch_bounds__(512) fwd_kernel(Params Pk) {
  extern __shared__ __attribute__((aligned(16))) char smem_base[];
  const int wv = __builtin_amdgcn_readfirstlane((int)(threadIdx.x >> 6));
  volatile __attribute__((address_space(3))) unsigned* xst = (volatile __attribute__((address_space(3))) unsigned*)(smem_base + LDS_BYTES - 16);
  if (threadIdx.x == 0) {
    xst[0] = 0u; xst[1] = 0u;
    (void)xb_add(&((unsigned*)(Pk.ws + WS_BAR))[XB_XCNT(xb_xcc_id())], 1u);
  }
  __syncthreads();
  for (int ph = Pk.ph_lo; ph < Pk.ph_hi; ++ph) {
    int zoff = 0;
    asm volatile("" : "+s"(zoff));
    char* smem = smem_base + zoff;
    KP P = (KP)__builtin_amdgcn_kernarg_segment_ptr();
    asm volatile("" : "+s"(P));
#ifdef PROBE_DUP
    for (int rep = 0; rep < (((PROBE_DUP >> ph) & 1) ? 2 : 1); ++rep)
#endif
    switch (ph) {
      case 0: case 4: case 7: case 11: {
        const float* w = ph == 0 ? P->in[6] : (ph == 4 ? P->in[7] : (ph == 7 ? P->in[6] + D : P->in[7] + D));
        if (ph == 0) phase_norm<false, false>(P->in[0], P->in[1], nullptr, w, (bfu*)(P->ws + WS_XN), nullptr, wv);
        else phase_norm<false, true>(nullptr, nullptr, (const bfu*)(P->ws + WS_XR), w, (bfu*)(P->ws + WS_XN), nullptr, wv);
        if (ph == 0) phase_convert_weights(P, smem, wv);
        if (ph == 7) phase_convert_cache(P, smem, wv);
      } break;
      case 1: gemm_phase<EPI_INPROJ>(P, (const bfu*)(P->ws + WS_XN), (const bfu*)(P->ws + WS_W_INP), 1024, INP_NP / 256, smem, wv); break;
      case 2: phase_ssd(P, smem, wv); break;
      case 3: gemm_phase<EPI_OUTPROJ>(P, (const bfu*)(P->out + O_KP), (const bfu*)(P->ws + WS_W_OUTP), 2048, 4, smem, wv); break;
      case 5: case 12:
        gemm_phase<EPI_GU>(P, (const bfu*)(P->ws + WS_XN), (const bfu*)(P->ws + (ph == 5 ? WS_W_GU0 : WS_W_GU1)), 1024, 22, smem, wv);
        break;
      case 6: case 10: case 13: {
        const bfu* A = (const bfu*)(P->ws + (ph == 10 ? WS_AO : WS_BIG));
        const bfu* Bt = (const bfu*)(P->ws + (ph == 6 ? WS_W_DN0 : (ph == 10 ? WS_W_AO : WS_W_DN1)));
        gemm_phase<EPI_RES>(P, A, Bt, ph == 10 ? 1024 : DFF, 4, smem, wv);
      } break;
      case 8: gemm_phase<EPI_QKV>(P, (const bfu*)(P->ws + WS_XN), (const bfu*)(P->ws + WS_W_QKV), 1024, 12, smem, wv); break;
      case 9: phase_attn(P, smem, wv); break;
      case 14: phase_norm<true, true>(nullptr, nullptr, (const bfu*)(P->ws + WS_XR), P->in[8], nullptr, P->out, wv); break;
    }
    if (ph + 1 < Pk.ph_hi) {
      if (ph == Pk.ph_lo) cg::this_grid().sync();
      else xcd_barrier((unsigned*)(P->ws + WS_BAR), xst, opaque_tid(wv));
    }
  }
}

extern "C" void kernel_launch(void* const* d_in, const int* in_sizes, int n_in, void* d_out, int out_size, void* d_ws, size_t ws_size,
                              hipStream_t stream) {
  static int grid = 0;
  if (grid == 0) {
    if (n_in != 27 || ws_size < WS_END || out_size != 209412096) {
      fprintf(stderr, "kernel_launch: unexpected sizes n_in=%d ws=%zu (need %zu) out=%d\n", n_in, ws_size, (size_t)WS_END, out_size);
    }
    int dev = 0, cus = 0, per_cu = 0;
    (void)hipGetDevice(&dev);
    (void)hipDeviceGetAttribute(&cus, hipDeviceAttributeMultiprocessorCount, dev);
    (void)hipFuncSetAttribute((const void*)fwd_kernel, hipFuncAttributeMaxDynamicSharedMemorySize, LDS_BYTES);
    (void)hipOccupancyMaxActiveBlocksPerMultiprocessor(&per_cu, (const void*)fwd_kernel, 512, LDS_BYTES);
    if (per_cu < 1) { fprintf(stderr, "kernel_launch: occupancy query returned %d\n", per_cu); per_cu = 1; }
    grid = cus * per_cu;
    fprintf(stderr, "kernel_launch: grid=%d (cus=%d per_cu=%d) ws=%zu need=%zu\n", grid, cus, per_cu, ws_size, (size_t)WS_END);
  }
  Params p{};
  for (int i = 0; i < 27; ++i) p.in[i] = (const float*)d_in[i];
  p.out = (float*)d_out;
  p.ws = (unsigned char*)d_ws;
#if COOP
  (void)hipMemsetAsync((char*)d_ws + WS_BAR, 0, 16384, stream);
  p.ph_lo = 0; p.ph_hi = NPH;
  void* args[] = {&p};
  hipError_t e = hipLaunchCooperativeKernel((const void*)fwd_kernel, dim3(grid), dim3(512), args, LDS_BYTES, stream);
  if (e != hipSuccess) fprintf(stderr, "cooperative launch failed: %s (grid %d)\n", hipGetErrorString(e), grid);
#else
  for (int ph = 0; ph < NPH; ++ph) {
    p.ph_lo = ph; p.ph_hi = ph + 1;
    hipLaunchKernelGGL(fwd_kernel, dim3(grid), dim3(512), LDS_BYTES, stream, p);
  }
#endif
}
```

```cpp
#include <hip/hip_runtime.h>
#include <hip/hip_cooperative_groups.h>
#include <cmath>
#include <cstdio>
namespace cg = cooperative_groups;

#ifndef COOP
#define COOP 1
#endif

typedef unsigned short bfu;
using bf16x8 = __attribute__((ext_vector_type(8))) short;
using f32x4 = __attribute__((ext_vector_type(4))) float;
using u32x4 = __attribute__((ext_vector_type(4))) unsigned;
using f32x2 = __attribute__((ext_vector_type(2))) float;

constexpr int D = 1024;
constexpr int MP = 65536;
constexpr int MS = 512;
constexpr int MT = MP + MS;
constexpr int DI = 2048;
constexpr int CONVD = 3072;
constexpr int ZXW = 5120;
constexpr int INP_N = 5152;
constexpr int INP_NP = 5376;
constexpr int DFF = 2816;
constexpr int SKV = 1088;
constexpr float EPS = 1e-6f;
constexpr float LAMBDA_INIT = 0.35550906759f;
constexpr float QSCALE = 0.125f * 1.4426950408889634f;

constexpr size_t O_Y = 0;
constexpr size_t O_CONVP = 67633152;
constexpr size_t O_SSMP = 67780608;
constexpr size_t O_KP = 71974912;
constexpr size_t O_VP = 139083776;
constexpr size_t O_CONVS = 206192640;
constexpr size_t O_SSMS = 206266368;
constexpr size_t O_KS = 208363520;
constexpr size_t O_VS = 208887808;

constexpr size_t WS_W_INP = 0;
constexpr size_t WS_W_OUTP = WS_W_INP + (size_t)INP_NP * 1024 * 2;
constexpr size_t WS_W_GU0 = WS_W_OUTP + (size_t)1024 * 2048 * 2;
constexpr size_t WS_W_DN0 = WS_W_GU0 + (size_t)5632 * 1024 * 2;
constexpr size_t WS_W_QKV = WS_W_DN0 + (size_t)1024 * 2816 * 2;
constexpr size_t WS_W_AO = WS_W_QKV + (size_t)3072 * 1024 * 2;
constexpr size_t WS_W_GU1 = WS_W_AO + (size_t)1024 * 1024 * 2;
constexpr size_t WS_W_DN1 = WS_W_GU1 + (size_t)5632 * 1024 * 2;
constexpr size_t WS_XN = WS_W_DN1 + (size_t)1024 * 2816 * 2;
constexpr size_t WS_DT = WS_XN + (size_t)MT * 1024 * 2;
constexpr size_t WS_SSQ = WS_DT + (size_t)MT * 32 * 4;
constexpr size_t WS_BIG = WS_SSQ + (size_t)MT * 16 * 4;
constexpr size_t WS_BAR = WS_BIG + (size_t)MT * ZXW * 2;
constexpr size_t WS_XR = WS_BAR + 16384;
constexpr size_t WS_END = WS_XR + (size_t)MT * 1024 * 2;
constexpr size_t WS_Q = WS_BIG;
constexpr size_t WS_KP = WS_Q + (size_t)MT * 1024 * 2;
constexpr size_t WS_VTP = WS_KP + (size_t)MP * 1024 * 2;
constexpr size_t WS_KSM = WS_VTP + (size_t)MP * 1024 * 2;
constexpr size_t WS_VTS = WS_KSM + (size_t)8 * SKV * 1024 * 2;
constexpr size_t WS_AO = WS_VTS + (size_t)8 * SKV * 1024 * 2;
static_assert(WS_AO + (size_t)MT * 1024 * 2 <= WS_BAR, "layer-1 aliases overflow");
static_assert((size_t)MT * DFF * 2 <= WS_KSM - WS_BIG, "ffn h overlaps sample K");

constexpr int LDS_BYTES = 159744;
constexpr int NPH = 15;

struct Params {
  const float* in[27];
  float* out;
  unsigned char* ws;
  int ph_lo, ph_hi;
};
typedef const __attribute__((address_space(4))) Params* KP;

__device__ __forceinline__ bfu f2bf(float f) {
  unsigned u = __float_as_uint(f);
  u += 0x7fffu + ((u >> 16) & 1u);
  return (bfu)(u >> 16);
}
__device__ __forceinline__ float bf2f(bfu h) { return __uint_as_float(((unsigned)h) << 16); }
__device__ __forceinline__ unsigned pack2(float a, float b) { return (unsigned)f2bf(a) | ((unsigned)f2bf(b) << 16); }
__device__ __forceinline__ unsigned cvt_pk_bf16(float lo, float hi) {
  unsigned r;
  asm volatile("v_cvt_pk_bf16_f32 %0, %1, %2" : "=v"(r) : "v"(lo), "v"(hi));
  return r;
}
__device__ __forceinline__ float silu_f(float x) { return x * __builtin_amdgcn_rcpf(1.f + __expf(-x)); }
__device__ __forceinline__ float shx(float v, int mask, int lane) {
  return __int_as_float(__builtin_amdgcn_ds_bpermute((lane ^ mask) << 2, __float_as_int(v)));
}
__device__ __forceinline__ float shup(float v, int d, int lane) {
  return __int_as_float(__builtin_amdgcn_ds_bpermute((lane - d) << 2, __float_as_int(v)));
}
__device__ __forceinline__ float shidx(float v, int src) {
  return __int_as_float(__builtin_amdgcn_ds_bpermute(src << 2, __float_as_int(v)));
}
__device__ __forceinline__ float wave_sum(float v, int lane) {
#pragma unroll
  for (int o = 32; o >= 1; o >>= 1) v += shx(v, o, lane);
  return v;
}
__device__ __forceinline__ f32x4 mfma16(bf16x8 a, bf16x8 b, f32x4 c) {
  return __builtin_amdgcn_mfma_f32_16x16x32_bf16(a, b, c, 0, 0, 0);
}
__device__ __forceinline__ int opaque_tid(int wv) {
  int lane;
  asm volatile("v_mbcnt_lo_u32_b32 %0, -1, 0\n\tv_mbcnt_hi_u32_b32 %0, -1, %0" : "=v"(lane));
  return wv * 64 + lane;
}
__device__ __forceinline__ float xmax_16_32(float v) {
  auto a = __builtin_amdgcn_permlane16_swap(__float_as_uint(v), __float_as_uint(v), false, false);
  v = fmaxf(__uint_as_float(a[0]), __uint_as_float(a[1]));
  auto b = __builtin_amdgcn_permlane32_swap(__float_as_uint(v), __float_as_uint(v), false, false);
  return fmaxf(__uint_as_float(b[0]), __uint_as_float(b[1]));
}
__device__ __forceinline__ float xsum_16_32(float v) {
  auto a = __builtin_amdgcn_permlane16_swap(__float_as_uint(v), __float_as_uint(v), false, false);
  v = __uint_as_float(a[0]) + __uint_as_float(a[1]);
  auto b = __builtin_amdgcn_permlane32_swap(__float_as_uint(v), __float_as_uint(v), false, false);
  return __uint_as_float(b[0]) + __uint_as_float(b[1]);
}
__device__ __forceinline__ float row16_sum(float v) {
  v += __int_as_float(__builtin_amdgcn_update_dpp(0, __float_as_int(v), 0xB1, 0xf, 0xf, true));
  v += __int_as_float(__builtin_amdgcn_update_dpp(0, __float_as_int(v), 0x4E, 0xf, 0xf, true));
  v += __int_as_float(__builtin_amdgcn_update_dpp(0, __float_as_int(v), 0x141, 0xf, 0xf, true));
  v += __int_as_float(__builtin_amdgcn_update_dpp(0, __float_as_int(v), 0x140, 0xf, 0xf, true));
  return v;
}
__device__ __forceinline__ f32x4 bf4_to_f32(uint2 u) {
  return f32x4{__uint_as_float(u.x << 16), __uint_as_float(u.x & 0xffff0000u), __uint_as_float(u.y << 16), __uint_as_float(u.y & 0xffff0000u)};
}
__device__ __forceinline__ void lds_barrier() {
  asm volatile("s_waitcnt lgkmcnt(0)" ::: "memory");
  __builtin_amdgcn_s_barrier();
  asm volatile("" ::: "memory");
}
__device__ __forceinline__ bf16x8 lds_b128(const bfu* p) { return *reinterpret_cast<const bf16x8*>(p); }

__device__ __forceinline__ void conv_tile(const float* __restrict__ src, const float* __restrict__ src2, const float* __restrict__ scale,
                                          bfu* __restrict__ dst, int Nsrc, int mode, int dstStride, int kt, int nt, float* sT, const int tid) {
  __syncthreads();
#pragma unroll
  for (int i = 0; i < 8; ++i) {
    int idx = tid + i * 512;
    int kk = idx >> 6, rr = idx & 63;
    int r = nt * 64 + rr;
    size_t k = (size_t)(kt * 64 + kk);
    float v = 0.f;
    if (mode == 0) {
      if (r < Nsrc) v = src[k * Nsrc + r];
    } else if (mode == 1) {
      int blk = r >> 5, w = r & 31;
      int sc = blk * 16 + (w & 15);
      v = (w < 16 ? src : src2)[k * Nsrc + sc];
    } else {
      int sc = r;
      if (r < 2048) {
        int pos = r & 63, pb = pos >> 4;
        int tb = (pb == 1) ? 2 : ((pb == 2) ? 1 : pb);
        sc = (r & ~63) + tb * 16 + (pos & 15);
      }
      v = src[k * Nsrc + sc];
    }
    sT[kk * 65 + rr] = v;
  }
  __syncthreads();
#pragma unroll
  for (int i = 0; i < 8; ++i) {
    int idx = tid + i * 512;
    int rr = idx >> 6, kk = idx & 63;
    float v = sT[kk * 65 + rr];
    if (scale) v *= scale[kt * 64 + kk];
    dst[(size_t)(nt * 64 + rr) * dstStride + kt * 64 + kk] = f2bf(v);
  }
}

__device__ __forceinline__ void phase_convert_weights(KP P, char* smem, const int wv) {
  float* sT = (float*)smem;
  const int tid = opaque_tid(wv);
  for (int t = blockIdx.x; t < 7104; t += gridDim.x) {
    const float *src, *src2 = nullptr, *scale = nullptr;
    bfu* dst;
    int K, Nsrc, mode = 0, lt;
    if (t < 1344) { lt = t; src = P->in[9]; dst = (bfu*)(P->ws + WS_W_INP); K = 1024; Nsrc = INP_N; }
    else if (t < 1856) { lt = t - 1344; src = P->in[16]; scale = P->in[15]; dst = (bfu*)(P->ws + WS_W_OUTP); K = 2048; Nsrc = 1024; }
    else if (t < 3264) { lt = t - 1856; src = P->in[24]; src2 = P->in[25]; dst = (bfu*)(P->ws + WS_W_GU0); K = 1024; Nsrc = DFF; mode = 1; }
    else if (t < 3968) { lt = t - 3264; src = P->in[26]; dst = (bfu*)(P->ws + WS_W_DN0); K = 2816; Nsrc = 1024; }
    else if (t < 4736) { lt = t - 3968; src = P->in[17]; dst = (bfu*)(P->ws + WS_W_QKV); K = 1024; Nsrc = 3072; mode = 2; }
    else if (t < 4992) { lt = t - 4736; src = P->in[23]; dst = (bfu*)(P->ws + WS_W_AO); K = 1024; Nsrc = 1024; }
    else if (t < 6400) { lt = t - 4992; src = P->in[24] + (size_t)1024 * DFF; src2 = P->in[25] + (size_t)1024 * DFF; dst = (bfu*)(P->ws + WS_W_GU1); K = 1024; Nsrc = DFF; mode = 1; }
    else { lt = t - 6400; src = P->in[26] + (size_t)DFF * 1024; dst = (bfu*)(P->ws + WS_W_DN1); K = 2816; Nsrc = 1024; }
    int nkt = K / 64;
    int kt = lt % nkt, nt = lt / nkt;
    conv_tile(src, src2, scale, dst, Nsrc, mode, K, kt, nt, sT, tid);
  }
}

__device__ __forceinline__ void phase_convert_cache(KP P, char* smem, const int wv) {
  float* sT = (float*)smem;
  const int tid = opaque_tid(wv);
  bfu* ks = (bfu*)(P->ws + WS_KSM);
  bfu* vts = (bfu*)(P->ws + WS_VTS);
  const float* ck = P->in[4];
  const float* cv = P->in[5];
  for (size_t i = (size_t)blockIdx.x * 512 + tid; i < (size_t)8 * 1024 * 256; i += (size_t)gridDim.x * 512) {
    size_t e = i * 4;
    int b = (int)(e >> 20);
    size_t rem = e & ((1u << 20) - 1);
    float4 v = *(const float4*)(ck + e);
    uint2 o; o.x = pack2(v.x, v.y); o.y = pack2(v.z, v.w);
    *(uint2*)(ks + (size_t)b * SKV * 1024 + rem) = o;
  }
  for (int t = blockIdx.x; t < 8 * 256; t += gridDim.x) {
    int b = t >> 8, lt = t & 255;
    int kt = lt & 15, nt = lt >> 4;
    conv_tile(cv + (size_t)b * 1024 * 1024, nullptr, nullptr, vts + (size_t)b * 1024 * SKV, 1024, 0, SKV, kt, nt, sT, tid);
  }
}

template <bool FINAL, bool SRCB>
__device__ __forceinline__ void phase_norm(const float* xa, const float* xb, const bfu* xr, const float* w, bfu* dst, float* fdst, const int wv) {
  const int tid_ = opaque_tid(wv);
  const int lane = tid_ & 63, wid = tid_ >> 6;
  f32x4 w4[4];
#pragma unroll
  for (int i = 0; i < 4; ++i) w4[i] = ((const f32x4*)w)[i * 64 + lane];
  for (int row = blockIdx.x * 8 + wid; row < MT / 2; row += gridDim.x * 8) {
    f32x4 v[2][4];
    float ss[2] = {0.f, 0.f};
#pragma unroll
    for (int h = 0; h < 2; ++h) {
      const int r = row + h * (MT / 2);
      if (SRCB) {
#pragma unroll
        for (int i = 0; i < 4; ++i) v[h][i] = bf4_to_f32(((const uint2*)(xr + (size_t)r * D))[i * 64 + lane]);
      } else {
        const float* x = r < MP ? xa + (size_t)r * D : xb + (size_t)(r - MP) * D;
#pragma unroll
        for (int i = 0; i < 4; ++i) v[h][i] = ((const f32x4*)x)[i * 64 + lane];
      }
    }
#pragma unroll
    for (int h = 0; h < 2; ++h) {
#pragma unroll
      for (int i = 0; i < 4; ++i) ss[h] += v[h][i][0] * v[h][i][0] + v[h][i][1] * v[h][i][1] + v[h][i][2] * v[h][i][2] + v[h][i][3] * v[h][i][3];
      ss[h] = wave_sum(ss[h], lane);
    }
#pragma unroll
    for (int h = 0; h < 2; ++h) {
      const int r = row + h * (MT / 2);
      const float rstd = rsqrtf(ss[h] * (1.f / D) + EPS);
#pragma unroll
      for (int i = 0; i < 4; ++i) {
        f32x4 o = v[h][i] * rstd * w4[i];
        if (FINAL) {
          ((f32x4*)(fdst + (size_t)r * D))[i * 64 + lane] = o;
        } else {
          uint2 pk; pk.x = cvt_pk_bf16(o[0], o[1]); pk.y = cvt_pk_bf16(o[2], o[3]);
          ((uint2*)(dst + (size_t)r * D))[i * 64 + lane] = pk;
        }
      }
    }
  }
}

enum { EPI_INPROJ = 0, EPI_OUTPROJ = 1, EPI_RES = 2, EPI_GU = 3, EPI_QKV = 4 };
#define LAS __attribute__((address_space(3)))
constexpr int HT_B = 128 * 64 * 2;
__device__ __forceinline__ int lds_byte(int r, int c) {
  int st = (r >> 4) * 2 + (c >> 5), rr = r & 15, cc = c & 31, ob = rr * 64 + cc * 2;
  return st * 1024 + (ob ^ (((ob >> 9) & 1) << 5));
}
__device__ __forceinline__ void stage_rc(int b, int& R, int& C) {
  int st = b / 1024, sb = b % 1024, swz = sb ^ (((sb >> 9) & 1) << 5);
  R = (st >> 1) * 16 + swz / 64;
  C = (st & 1) * 32 + (swz % 64) / 2;
}
__device__ __forceinline__ float softplus_f(float x) { return x > 20.f ? x : log1pf(__expf(x)); }

__device__ __forceinline__ float ssd_rstd(const float* __restrict__ ssq, int row) {
  const f32x4* p = (const f32x4*)(ssq + (size_t)row * 16);
  f32x4 a = p[0], b = p[1], c = p[2], d = p[3];
  float sm = (a[0] + a[1]) + (a[2] + a[3]) + (b[0] + b[1]) + (b[2] + b[3]) + (c[0] + c[1]) + (c[2] + c[3]) + (d[0] + d[1]) + (d[2] + d[3]);
  return rsqrtf(sm * (1.f / DI) + EPS);
}

template <int EPI>
__device__ __forceinline__ void gemm_acc_init(KP P, f32x4 (&acc)[2][2][4][2], int brow, int bcol, int wr, int wc, int fr_, int fq_, const float* sRu) {
  if (EPI == EPI_OUTPROJ || EPI == EPI_RES) {
    int fr = fr_, fq = fq_;
    asm volatile("" : "+v"(fr), "+v"(fq));
    const float* xin = (brow < MP ? P->in[0] + (size_t)brow * D : P->in[1] + (size_t)(brow - MP) * D) + bcol;
    const bfu* xrb = (const bfu*)(P->ws + WS_XR) + (size_t)brow * D + bcol;
#pragma unroll
    for (int ai = 0; ai < 2; ++ai)
#pragma unroll
      for (int m = 0; m < 4; ++m) {
        __builtin_amdgcn_sched_barrier(0);
        unsigned lr = ai * 128 + wr * 64 + m * 16 + fr;
        unsigned o = lr * D + wc * 32 + fq * 4;
        float sc = 1.f;
        if (EPI == EPI_OUTPROJ) sc = 1.f / sRu[lr];
#pragma unroll
        for (int bj = 0; bj < 2; ++bj)
#pragma unroll
          for (int n = 0; n < 2; ++n) {
            if (EPI == EPI_RES) acc[ai][bj][m][n] = bf4_to_f32(*(const uint2*)(xrb + o + bj * 128 + n * 16));
            else acc[ai][bj][m][n] = *(const f32x4*)(xin + o + bj * 128 + n * 16) * sc;
          }
      }
  } else {
#pragma unroll
    for (int ai = 0; ai < 2; ++ai)
#pragma unroll
      for (int bj = 0; bj < 2; ++bj)
#pragma unroll
        for (int m = 0; m < 4; ++m)
#pragma unroll
          for (int n = 0; n < 2; ++n) acc[ai][bj][m][n] = f32x4{0.f, 0.f, 0.f, 0.f};
  }
}

template <int EPI>
__device__ __forceinline__ void gemm_epilogue(KP P, f32x4 (&acc)[2][2][4][2], int brow, int bcol, int wr, int wc, int fr_, int fq_, const float* sRu) {
  int fr = fr_, fq = fq_;
  asm volatile("" : "+v"(fr), "+v"(fq));
  const unsigned lrow0 = wr * 64 + fr;
  const unsigned lcol0 = wc * 32 + fq * 4;
  if (EPI == EPI_INPROJ) {
    if (bcol < ZXW) {
      bfu* zxb = (bfu*)(P->ws + WS_BIG) + (size_t)brow * ZXW + bcol;
#pragma unroll
      for (int ai = 0; ai < 2; ++ai)
#pragma unroll
        for (int m = 0; m < 4; ++m) {
          __builtin_amdgcn_sched_barrier(0);
          unsigned o = (lrow0 + ai * 128 + m * 16) * ZXW + lcol0;
#pragma unroll
          for (int bj = 0; bj < 2; ++bj)
#pragma unroll
            for (int n = 0; n < 2; ++n) {
              f32x4 v = acc[ai][bj][m][n];
              uint2 pk; pk.x = cvt_pk_bf16(v[0], v[1]); pk.y = cvt_pk_bf16(v[2], v[3]);
              *(uint2*)(zxb + o + bj * 128 + n * 16) = pk;
            }
        }
      const bool has_tail = (brow >= MP) || (((brow + 256) & 4095) == 0);
      if (has_tail && bcol >= DI) {
#pragma unroll
        for (int ai = 0; ai < 2; ++ai)
#pragma unroll
          for (int m = 0; m < 4; ++m) {
            __builtin_amdgcn_sched_barrier(0);
            int row = brow + lrow0 + ai * 128 + m * 16;
            float* dst = nullptr;
            if (row < MP) {
              int t = row & 4095;
              if (t >= 4093) dst = P->out + O_CONVP + ((size_t)(row >> 12) * 3 + (t - 4093)) * CONVD;
            } else {
              int rs = row - MP, t = rs & 63;
              if (t >= 61) dst = P->out + O_CONVS + ((size_t)(rs >> 6) * 3 + (t - 61)) * CONVD;
            }
            if (dst) {
              unsigned o = bcol - DI + lcol0;
#pragma unroll
              for (int bj = 0; bj < 2; ++bj)
#pragma unroll
                for (int n = 0; n < 2; ++n) *(f32x4*)(dst + o + bj * 128 + n * 16) = acc[ai][bj][m][n];
            }
          }
      }
    } else {
      if (wc == 0) {
        float* dtb = (float*)(P->ws + WS_DT) + (size_t)brow * 32;
        const float* dtbias = P->in[12];
        const f32x4 b0 = *(const f32x4*)(dtbias + fq * 4), b1 = *(const f32x4*)(dtbias + 16 + fq * 4);
#pragma unroll
        for (int ai = 0; ai < 2; ++ai)
#pragma unroll
          for (int m = 0; m < 4; ++m) {
            __builtin_amdgcn_sched_barrier(0);
            unsigned o = (lrow0 + ai * 128 + m * 16) * 32 + fq * 4;
            f32x4 x0 = acc[ai][0][m][0] + b0, x1 = acc[ai][0][m][1] + b1;
            f32x4 d0, d1;
#pragma unroll
            for (int j = 0; j < 4; ++j) { d0[j] = softplus_f(x0[j]); d1[j] = softplus_f(x1[j]); }
            *(f32x4*)(dtb + o) = d0;
            *(f32x4*)(dtb + o + 16) = d1;
          }
      }
    }
  } else if (EPI == EPI_OUTPROJ || EPI == EPI_RES) {
    bfu* xo = (bfu*)(P->ws + WS_XR) + (size_t)brow * D + bcol;
#pragma unroll
    for (int ai = 0; ai < 2; ++ai)
#pragma unroll
      for (int m = 0; m < 4; ++m) {
        __builtin_amdgcn_sched_barrier(0);
        unsigned lr = lrow0 + ai * 128 + m * 16;
        unsigned o = lr * D + lcol0;
        float rsd = 1.f;
        if (EPI == EPI_OUTPROJ) rsd = sRu[lr];
#pragma unroll
        for (int bj = 0; bj < 2; ++bj)
#pragma unroll
          for (int n = 0; n < 2; ++n) {
            f32x4 v = acc[ai][bj][m][n] * rsd;
            uint2 pk; pk.x = cvt_pk_bf16(v[0], v[1]); pk.y = cvt_pk_bf16(v[2], v[3]);
            *(uint2*)(xo + o + bj * 128 + n * 16) = pk;
          }
      }
  } else if (EPI == EPI_GU) {
    bfu* hb = (bfu*)(P->ws + WS_BIG) + (size_t)brow * DFF + (bcol >> 1);
#pragma unroll
    for (int ai = 0; ai < 2; ++ai)
#pragma unroll
      for (int m = 0; m < 4; ++m) {
        __builtin_amdgcn_sched_barrier(0);
        unsigned o = (lrow0 + ai * 128 + m * 16) * DFF + wc * 16 + fq * 4;
#pragma unroll
        for (int bj = 0; bj < 2; ++bj) {
          f32x4 g = acc[ai][bj][m][0], u = acc[ai][bj][m][1];
          uint2 pk;
          pk.x = cvt_pk_bf16(silu_f(g[0]) * u[0], silu_f(g[1]) * u[1]);
          pk.y = cvt_pk_bf16(silu_f(g[2]) * u[2], silu_f(g[3]) * u[3]);
          *(uint2*)(hb + o + bj * 64) = pk;
        }
      }
  } else if (EPI == EPI_QKV) {
    const bool prompt = brow < MP;
    if (bcol < 2048) {
      const bool isq = bcol < 1024;
#pragma unroll
      for (int bj = 0; bj < 2; ++bj) {
        const int col32 = bcol + bj * 128 + wc * 32;
        int frb = fr, fqb = fq;
        asm volatile("" : "+v"(frb), "+v"(fqb));
        const unsigned lrow0b = wr * 64 + frb;
        const int d0 = ((col32 >> 5) & 1) * 16 + fqb * 4;
        float inv[4];
#pragma unroll
        for (int j = 0; j < 4; ++j) inv[j] = exp2f(-(float)(d0 + j) * (13.287712379549449f / 32.f)) * 0.15915494309189535f;
        const unsigned c1 = (col32 & ~63 & 1023) + d0;
        bfu* bdst;
        float* fdst = nullptr;
        if (isq) bdst = (bfu*)(P->ws + WS_Q) + (size_t)brow * 1024;
        else if (prompt) { bdst = (bfu*)(P->ws + WS_KP) + (size_t)brow * 1024; fdst = P->out + O_KP + (size_t)brow * 1024; }
        else { bdst = (bfu*)(P->ws + WS_KSM); fdst = P->out + O_KS + (size_t)(brow - MP) * 1024; }
#pragma unroll
        for (int ai = 0; ai < 2; ++ai)
#pragma unroll
          for (int m = 0; m < 4; ++m) {
            __builtin_amdgcn_sched_barrier(0);
            unsigned lr = lrow0b + ai * 128 + m * 16;
            int row = brow + lr;
            int pos = prompt ? (row & 4095) : 1024 + ((row - MP) & 63);
            f32x4 x1 = acc[ai][bj][m][0], x2 = acc[ai][bj][m][1], o1, o2;
#pragma unroll
            for (int j = 0; j < 4; ++j) {
              float rev = (float)pos * inv[j];
              rev -= floorf(rev);
              float sn = __builtin_amdgcn_sinf(rev), cs = __builtin_amdgcn_cosf(rev);
              o1[j] = x1[j] * cs - x2[j] * sn;
              o2[j] = x2[j] * cs + x1[j] * sn;
            }
            if (isq) {
              uint2 p1, p2;
              p1.x = cvt_pk_bf16(o1[0] * QSCALE, o1[1] * QSCALE); p1.y = cvt_pk_bf16(o1[2] * QSCALE, o1[3] * QSCALE);
              p2.x = cvt_pk_bf16(o2[0] * QSCALE, o2[1] * QSCALE); p2.y = cvt_pk_bf16(o2[2] * QSCALE, o2[3] * QSCALE);
              *(uint2*)(bdst + lr * 1024 + c1) = p1;
              *(uint2*)(bdst + lr * 1024 + c1 + 32) = p2;
            } else {
              *(f32x4*)(fdst + lr * 1024 + c1) = o1;
              *(f32x4*)(fdst + lr * 1024 + c1 + 32) = o2;
              unsigned bo;
              if (prompt) bo = lr * 1024 + c1;
              else { int rs = row - MP; bo = ((rs >> 6) * SKV + 1024 + (rs & 63)) * 1024 + c1; }
              uint2 p1, p2;
              p1.x = cvt_pk_bf16(o1[0], o1[1]); p1.y = cvt_pk_bf16(o1[2], o1[3]);
              p2.x = cvt_pk_bf16(o2[0], o2[1]); p2.y = cvt_pk_bf16(o2[2], o2[3]);
              *(uint2*)(bdst + bo) = p1;
              *(uint2*)(bdst + bo + 32) = p2;
            }
          }
      }
    } else {
      float* fdst = prompt ? P->out + O_VP + (size_t)brow * 1024 + (bcol - 2048) : P->out + O_VS + (size_t)(brow - MP) * 1024 + (bcol - 2048);
      bfu* vt = prompt ? (bfu*)(P->ws + WS_VTP) : (bfu*)(P->ws + WS_VTS);
#pragma unroll
      for (int ai = 0; ai < 2; ++ai)
#pragma unroll
        for (int m = 0; m < 4; ++m) {
          __builtin_amdgcn_sched_barrier(0);
          unsigned lr = lrow0 + ai * 128 + m * 16;
          int row = brow + lr;
          size_t tb;
          unsigned tstr;
          if (prompt) { tb = (size_t)(row >> 12) * 1024 * 4096 + (row & 4095); tstr = 4096; }
          else { int rs = row - MP; tb = (size_t)(rs >> 6) * 1024 * SKV + 1024 + (rs & 63); tstr = SKV; }
#pragma unroll
          for (int bj = 0; bj < 2; ++bj)
#pragma unroll
            for (int n = 0; n < 2; ++n) {
              f32x4 v = acc[ai][bj][m][n];
              unsigned lc = lcol0 + bj * 128 + n * 16;
              *(f32x4*)(fdst + lr * 1024 + lc) = v;
              unsigned c = bcol - 2048 + lc;
#pragma unroll
              for (int j = 0; j < 4; ++j) vt[tb + (size_t)(c + j) * tstr] = f2bf(v[j]);
            }
        }
    }
  }
}

template <int EPI>
__device__ __forceinline__ void gemm_phase(KP P, const bfu* __restrict__ A, const bfu* __restrict__ Bt, int K, int ntn, char* smem, const int wv) {
  const int tid = opaque_tid(wv), wid = wv, lane = tid & 63, wr = wid >> 2, wc = wid & 3, fr = lane & 15, fq = lane >> 4;
  LAS unsigned char* lds = (LAS unsigned char*)smem;
  constexpr bool SPLIT_SAMPLE = (EPI == EPI_OUTPROJ || EPI == EPI_RES);
  const int ntm = SPLIT_SAMPLE ? MP / 256 : MT / 256;
  const int ntiles = ntm * ntn;
  const int nig = 8 * ntn;
  const int nt = K / 64;
  const int G = gridDim.x, xper = G >> 3;
  const int vb = ((G & 7) == 0) ? (int)(blockIdx.x & 7) * xper + (int)(blockIdx.x >> 3) : (int)blockIdx.x;
  if (!SPLIT_SAMPLE && vb >= ntiles) return;
  unsigned voff[2];
#pragma unroll
  for (int i = 0; i < 2; ++i) { int R, C; stage_rc(tid * 16 + i * 8192, R, C); voff[i] = (unsigned)(R * K + C) * 2u; }
  const size_t kstep = (size_t)(64 * 2);
  const size_t hstep = (size_t)128 * K * 2;
  const size_t tstep = 2 * hstep;
  const unsigned ldsw = (unsigned)wid * 1024u;
  const int aoff = lds_byte(wr * 64 + fr, fq * 8), boff = lds_byte(wc * 32 + fr, fq * 8);
#define PG8_SA(b, h) (((b) * 2 + (h)) * HT_B)
#define PG8_SB(b, h) ((4 + (b) * 2 + (h)) * HT_B)
#define PG8_STAGE(bufoff, gbase) do { _Pragma("unroll") for (int _i = 0; _i < 2; ++_i) \
    __builtin_amdgcn_global_load_lds((const unsigned*)((const char*)(gbase) + voff[_i]), (LAS unsigned*)(lds + (bufoff) + ldsw + _i * 8192), 16, 0, 0); } while (0)
#define PG8_LDA(dst, b, h) do { _Pragma("unroll") for (int m = 0; m < 4; ++m) _Pragma("unroll") for (int k = 0; k < 2; ++k) dst[m][k] = *(const LAS bf16x8*)(lds + PG8_SA(b, h) + aoff + m * 2048 + k * 1024); } while (0)
#define PG8_LDB(dst, b, h) do { _Pragma("unroll") for (int n = 0; n < 2; ++n) _Pragma("unroll") for (int k = 0; k < 2; ++k) dst[n][k] = *(const LAS bf16x8*)(lds + PG8_SB(b, h) + boff + n * 2048 + k * 1024); } while (0)
#define PG8_MMA(ai, bj, At, Bt_) do { __builtin_amdgcn_s_setprio(1); _Pragma("unroll") for (int m = 0; m < 4; ++m) _Pragma("unroll") for (int n = 0; n < 2; ++n) _Pragma("unroll") for (int k = 0; k < 2; ++k) \
    acc[ai][bj][m][n] = __builtin_amdgcn_mfma_f32_16x16x32_bf16(Bt_[n][k], At[m][k], acc[ai][bj][m][n], 0, 0, 0); __builtin_amdgcn_s_setprio(0); } while (0)
#define PG8_WAIT_V(n) asm volatile("s_waitcnt vmcnt(" #n ")" ::: "memory")
#define PG8_WAIT_L(n) asm volatile("s_waitcnt lgkmcnt(" #n ")" ::: "memory")
#define PG8_BAR __builtin_amdgcn_s_barrier()
#define PG8_SCHED __builtin_amdgcn_sched_barrier(0)
#define TILE_PMPN(t, pm, pn) do { int gid_ = (t) / nig, fm_ = gid_ * 8, gsz_ = min(ntm - fm_, 8); pm = fm_ + ((t) % nig) % gsz_; pn = ((t) % nig) / gsz_; } while (0)
  int ctile = vb, cpm, cpn;
  TILE_PMPN(ctile, cpm, cpn);
  f32x4 acc[2][2][4][2];
  __syncthreads();
  const float* sRu = (const float*)(smem + 131072);
  if (EPI == EPI_OUTPROJ) {
    float* sR = (float*)(smem + 131072);
    const float* ssq = (const float*)(P->ws + WS_SSQ);
    int ui = 0;
    for (int t = vb; t < ntiles && ui < 8; t += G, ++ui) {
      int pm, pn;
      TILE_PMPN(t, pm, pn);
      if (tid < 256) sR[ui * 256 + tid] = ssd_rstd(ssq, pm * 256 + tid);
    }
    __syncthreads();
  }
  gemm_acc_init<EPI>(P, acc, cpm * 256, cpn * 256, wr, wc, fr, fq, sRu);
  bf16x8 At[4][2], B0[2][2], B1[2][2];
  const char* cA = (const char*)A + (size_t)cpm * tstep;
  const char* cB = (const char*)Bt + (size_t)cpn * tstep;
  PG8_STAGE(PG8_SB(0, 0), cB); PG8_STAGE(PG8_SA(0, 0), cA); PG8_STAGE(PG8_SB(0, 1), cB + hstep); PG8_STAGE(PG8_SA(0, 1), cA + hstep);
  if (wr == 1) PG8_BAR;
  PG8_WAIT_V(4); PG8_BAR;
  PG8_STAGE(PG8_SB(1, 0), cB + kstep); PG8_STAGE(PG8_SA(1, 0), cA + kstep); PG8_STAGE(PG8_SB(1, 1), cB + hstep + kstep);
  PG8_WAIT_V(6); PG8_BAR;
  for (;;) {
    const int ntile = ctile + G;
    const bool has_next = ntile < ntiles;
    int npm = cpm, npn = cpn;
    if (has_next) TILE_PMPN(ntile, npm, npn);
    const char* nA = (const char*)A + (size_t)npm * tstep;
    const char* nB = (const char*)Bt + (size_t)npn * tstep;
    for (int t = 0; t < nt; t += 2) {
      const bool last = (t == nt - 2);
      const char* a1 = cA + (size_t)(t + 1) * kstep;
      const char* a2 = last ? nA : cA + (size_t)(t + 2) * kstep;
      const char* b2 = last ? nB : cB + (size_t)(t + 2) * kstep;
      const char* a3 = a2 + kstep;
      const char* b3 = b2 + kstep;
      PG8_LDB(B0, 0, 0); PG8_SCHED; PG8_LDA(At, 0, 0); PG8_STAGE(PG8_SA(1, 1), a1 + hstep);
      PG8_WAIT_L(8); PG8_BAR; PG8_WAIT_L(0); PG8_MMA(0, 0, At, B0); PG8_BAR; PG8_SCHED;
      PG8_LDB(B1, 0, 1); PG8_STAGE(PG8_SB(0, 0), b2);
      PG8_BAR; PG8_WAIT_L(0); PG8_MMA(0, 1, At, B1); PG8_BAR;
      PG8_LDA(At, 0, 1); PG8_STAGE(PG8_SA(0, 0), a2);
      PG8_BAR; PG8_WAIT_L(0); PG8_MMA(1, 0, At, B0); PG8_BAR; PG8_SCHED;
      PG8_STAGE(PG8_SB(0, 1), b2 + hstep);
      PG8_WAIT_V(6); PG8_BAR; PG8_MMA(1, 1, At, B1); PG8_BAR;
      PG8_LDB(B0, 1, 0); PG8_SCHED; PG8_LDA(At, 1, 0); PG8_STAGE(PG8_SA(0, 1), a2 + hstep);
      PG8_WAIT_L(8); PG8_BAR; PG8_WAIT_L(0); PG8_MMA(0, 0, At, B0); PG8_BAR; PG8_SCHED;
      PG8_LDB(B1, 1, 1); PG8_STAGE(PG8_SB(1, 0), b3);
      PG8_BAR; PG8_WAIT_L(0); PG8_MMA(0, 1, At, B1); PG8_BAR;
      PG8_LDA(At, 1, 1); PG8_STAGE(PG8_SA(1, 0), a3);
      PG8_BAR; PG8_WAIT_L(0); PG8_MMA(1, 0, At, B0); PG8_BAR; PG8_SCHED;
      PG8_STAGE(PG8_SB(1, 1), b3 + hstep);
      PG8_WAIT_V(6); PG8_BAR; PG8_MMA(1, 1, At, B1); PG8_BAR;
    }
    gemm_epilogue<EPI>(P, acc, cpm * 256, cpn * 256, wr, wc, fr, fq, sRu);
    if (!has_next) break;
    sRu += 256;
    gemm_acc_init<EPI>(P, acc, npm * 256, npn * 256, wr, wc, fr, fq, sRu);
    ctile = ntile; cpm = npm; cpn = npn; cA = nA; cB = nB;
  }
  PG8_WAIT_V(0);
  if (wr == 0) PG8_BAR;
  PG8_BAR;
  if (SPLIT_SAMPLE) {
    float* sRed = (float*)smem;
    const int kw = K >> 3;
    for (int task = blockIdx.x; task < 256; task += G) {
      const int rb = task >> 4, cb = task & 15;
      const bfu* ap = A + (size_t)(MP + rb * 32 + fr) * K + wid * kw + fq * 8;
      const bfu* bp = Bt + (size_t)(cb * 64 + fr) * K + wid * kw + fq * 8;
      f32x4 pacc[2][4];
#pragma unroll
      for (int rt = 0; rt < 2; ++rt)
#pragma unroll
        for (int ct = 0; ct < 4; ++ct) pacc[rt][ct] = f32x4{0.f, 0.f, 0.f, 0.f};
      for (int ks = 0; ks < kw; ks += 32) {
        bf16x8 af[2], bf[4];
#pragma unroll
        for (int rt = 0; rt < 2; ++rt) af[rt] = *(const bf16x8*)(ap + (size_t)rt * 16 * K + ks);
#pragma unroll
        for (int ct = 0; ct < 4; ++ct) bf[ct] = *(const bf16x8*)(bp + (size_t)ct * 16 * K + ks);
#pragma unroll
        for (int rt = 0; rt < 2; ++rt)
#pragma unroll
          for (int ct = 0; ct < 4; ++ct) pacc[rt][ct] = mfma16(af[rt], bf[ct], pacc[rt][ct]);
      }
      __syncthreads();
#pragma unroll
      for (int rt = 0; rt < 2; ++rt)
#pragma unroll
        for (int ct = 0; ct < 4; ++ct) *(f32x4*)(sRed + ((wid * 8 + rt * 4 + ct) * 64 + lane) * 4) = pacc[rt][ct];
      __syncthreads();
      {
        f32x4 sum = {0.f, 0.f, 0.f, 0.f};
#pragma unroll
        for (int ww = 0; ww < 8; ++ww) sum += *(const f32x4*)(sRed + ((ww * 8 + wid) * 64 + lane) * 4);
        const int col = cb * 64 + (wid & 3) * 16 + fr;
#pragma unroll
        for (int j = 0; j < 4; ++j) {
          const int srow = rb * 32 + (wid >> 2) * 16 + fq * 4 + j;
          bfu* op = (bfu*)(P->ws + WS_XR) + (size_t)(MP + srow) * D + col;
          if (EPI == EPI_OUTPROJ) {
            const float rs = ssd_rstd((const float*)(P->ws + WS_SSQ), MP + srow);
            *op = f2bf(P->in[1][(size_t)srow * D + col] + rs * sum[j]);
          } else {
            *op = f2bf(bf2f(*op) + sum[j]);
          }
        }
      }
    }
  }
#undef PG8_SA
#undef PG8_SB
#undef PG8_STAGE
#undef PG8_LDA
#undef PG8_LDB
#undef PG8_MMA
#undef PG8_WAIT_V
#undef PG8_WAIT_L
#undef PG8_BAR
#undef PG8_SCHED
#undef TILE_PMPN
}

constexpr int S_LDB = 136;
constexpr int S_LDT = 72;
constexpr int S_LDCB = 68;
__device__ __forceinline__ void phase_ssd(KP P, char* smem, const int wv) {
  bfu* sB = (bfu*)smem;
  bfu* sC = sB + 64 * S_LDB;
  bfu* sBT = sC + 64 * S_LDB;
  bfu* sXT = sBT + 128 * S_LDT;
  bfu* sG = sXT + 128 * S_LDT;
  bfu* sH = sG + 2 * 64 * S_LDT;
  float* sAc = (float*)(sH + 8 * 16 * S_LDB);
  float* sDt = sAc + 512;
  float* sW = sDt + 512;
  float* sSq = sW + 512;
  bfu* sZ = (bfu*)(sSq + 512);
  float* sWc = (float*)(sZ + 64 * S_LDB);
  const int tid = opaque_tid(wv), w = wv, lane = tid & 63, fr = lane & 15, fq = lane >> 4;
  const int hl = w >> 2, ps = w & 3;
  const bfu* zx = (const bfu*)(P->ws + WS_BIG);
  const float* dtb = (const float*)(P->ws + WS_DT);
  float* ssqp = (float*)(P->ws + WS_SSQ);
  bfu* yg = (bfu*)(P->out + O_KP);
  const float* convw = P->in[10];
  const float* convb = P->in[11];
  bfu* myH = sH + w * 16 * S_LDB;
  float* myAc = sAc + w * 64;
  float* myDt = sDt + w * 64;
  float* myW = sW + w * 64;
  float* mySq = sSq + w * 64;
  const bool conv_role = w < 6;

  for (int unit = blockIdx.x; unit < 384; unit += gridDim.x) {
    int seq, g, hp, row0, nch;
    const float* hist = nullptr;
    const float* h0 = nullptr;
    float* hT;
    if (unit < 256) {
      seq = unit >> 4; g = (unit >> 2) & 3; hp = unit & 3;
      row0 = seq * 4096; nch = 64;
      hT = P->out + O_SSMP + (size_t)seq * 32 * 8192;
    } else {
      int u = unit - 256;
      seq = u >> 4; g = (u >> 2) & 3; hp = u & 3;
      row0 = MP + seq * 64; nch = 1;
      hist = P->in[2] + (size_t)seq * 3 * CONVD;
      h0 = P->in[3] + (size_t)seq * 32 * 8192;
      hT = P->out + O_SSMS + (size_t)seq * 32 * 8192;
    }
    const int head = g * 8 + hp * 2 + hl;
    const float A_h = -__expf(P->in[13][head]);
    const float D_h = P->in[14][head];
    f32x4 hacc[8];
    if (h0) {
#pragma unroll
      for (int nt = 0; nt < 8; ++nt)
#pragma unroll
        for (int j = 0; j < 4; ++j) hacc[nt][j] = h0[((size_t)head * 64 + ps * 16 + fq * 4 + j) * 128 + nt * 16 + fr];
    } else {
#pragma unroll
      for (int nt = 0; nt < 8; ++nt) hacc[nt] = f32x4{0.f, 0.f, 0.f, 0.f};
    }
    __syncthreads();
#pragma unroll
    for (int nt = 0; nt < 8; ++nt)
#pragma unroll
      for (int j = 0; j < 4; ++j) myH[(fq * 4 + j) * S_LDB + nt * 16 + fr] = f2bf(hacc[nt][j]);
    const int cgp = tid % 48, rs = tid / 48;
    int cc;
    if (cgp < 16) cc = (g * 8 + hp * 2) * 64 + cgp * 8;
    else if (cgp < 32) cc = DI + g * 128 + (cgp - 16) * 8;
    else cc = DI + 512 + g * 128 + (cgp - 32) * 8;
    if (tid < 384) {
      if (rs < 5) {
        const float* src = (rs < 4) ? convw + rs * CONVD + cc : convb + cc;
        f32x4 a = *(const f32x4*)src, bq = *(const f32x4*)(src + 4);
        *(f32x4*)(sWc + rs * 384 + cgp * 8) = a;
        *(f32x4*)(sWc + rs * 384 + cgp * 8 + 4) = bq;
      }
    }
    const int zt = tid - 384;
    const int zrow = (zt >> 1) & 63, zhalf = zt & 1;

    u32x4 pre[11];
    float dtv;
    {
      const int r0 = row0;
      if (conv_role) {
        const bfu* zxc = zx + ((size_t)r0 - 3) * ZXW + DI;
#pragma unroll
        for (int k = 0; k < 11; ++k) {
          int rr = rs * 8 - 3 + k;
          if (rr < 0) {
            if (hist) {
              f32x4 a = *(const f32x4*)(hist + (3 + rr) * CONVD + cc), bq = *(const f32x4*)(hist + (3 + rr) * CONVD + cc + 4);
              pre[k] = u32x4{pack2(a[0], a[1]), pack2(a[2], a[3]), pack2(bq[0], bq[1]), pack2(bq[2], bq[3])};
            } else {
              pre[k] = u32x4{0u, 0u, 0u, 0u};
            }
          } else {
            pre[k] = *(const u32x4*)(zxc + (unsigned)((rs * 8 + k) * ZXW + cc));
          }
        }
      } else {
        const bfu* zsrc = zx + (size_t)(r0 + zrow) * ZXW + (g * 8 + hp * 2) * 64 + zhalf * 64;
#pragma unroll
        for (int k = 0; k < 8; ++k) pre[k] = *(const u32x4*)(zsrc + k * 8);
#pragma unroll
        for (int k = 8; k < 11; ++k) pre[k] = u32x4{0u, 0u, 0u, 0u};
      }
      dtv = dtb[(size_t)(r0 + lane) * 32 + head];
    }

    for (int c = 0; c < nch; ++c) {
      const int r0 = row0 + c * 64;
      lds_barrier();
      if (conv_role) {
        const float* wcol = sWc + cgp * 8;
        u32x4 ovr[8];
#pragma unroll
        for (int e2 = 0; e2 < 4; ++e2) {
          __builtin_amdgcn_sched_barrier(0);
          float w0[4], w1[4];
#pragma unroll
          for (int tap = 0; tap < 4; ++tap) { w0[tap] = wcol[tap * 384 + 2 * e2]; w1[tap] = wcol[tap * 384 + 2 * e2 + 1]; }
          const float bl = wcol[4 * 384 + 2 * e2], bh = wcol[4 * 384 + 2 * e2 + 1];
#pragma unroll
          for (int i = 0; i < 8; ++i) {
            float ylo = bl, yhi = bh;
#pragma unroll
            for (int tap = 0; tap < 4; ++tap) {
              unsigned rw = pre[i + tap][e2];
              ylo += w0[tap] * __uint_as_float(rw << 16);
              yhi += w1[tap] * __uint_as_float(rw & 0xffff0000u);
            }
            ovr[i][e2] = cvt_pk_bf16(silu_f(ylo), silu_f(yhi));
          }
        }
        if (cgp >= 16) {
          bfu* rowdst = (cgp < 32) ? (sB + (cgp - 16) * 8) : (sC + (cgp - 32) * 8);
#pragma unroll
          for (int i = 0; i < 8; ++i) *(u32x4*)(rowdst + (rs * 8 + i) * S_LDB) = ovr[i];
        }
        if (cgp < 32) {
          bfu* coldst = (cgp < 16) ? (sXT + (cgp * 8) * S_LDT + rs * 8) : (sBT + ((cgp - 16) * 8) * S_LDT + rs * 8);
#pragma unroll
          for (int e = 0; e < 8; ++e) {
            const int e2 = e >> 1, sh = (e & 1) * 16;
            u32x4 o;
            o[0] = ((ovr[0][e2] >> sh) & 0xffffu) | ((ovr[1][e2] >> sh) << 16);
            o[1] = ((ovr[2][e2] >> sh) & 0xffffu) | ((ovr[3][e2] >> sh) << 16);
            o[2] = ((ovr[4][e2] >> sh) & 0xffffu) | ((ovr[5][e2] >> sh) << 16);
            o[3] = ((ovr[6][e2] >> sh) & 0xffffu) | ((ovr[7][e2] >> sh) << 16);
            *(u32x4*)(coldst + e * S_LDT) = o;
          }
        }
      } else {
#pragma unroll
        for (int k = 0; k < 8; ++k) *(u32x4*)(sZ + zrow * S_LDB + zhalf * 64 + k * 8) = pre[k];
      }
      float a63;
      {
        float ac = dtv * A_h;
#pragma unroll
        for (int o = 1; o < 64; o <<= 1) {
          float t = shup(ac, o, lane);
          if (lane >= o) ac += t;
        }
        a63 = shidx(ac, 63);
        myAc[lane] = ac;
        myDt[lane] = dtv;
        myW[lane] = __expf(a63 - ac) * dtv;
      }
      lds_barrier();
      if (c + 1 < nch) {
        const int r1 = r0 + 64;
        int rsl = rs;
        asm volatile("" : "+v"(rsl));
        if (conv_role) {
          const bfu* zxc = zx + ((size_t)r1 - 3) * ZXW + DI;
#pragma unroll
          for (int k = 0; k < 11; ++k) pre[k] = *(const u32x4*)(zxc + (unsigned)((rsl * 8 + k) * ZXW + cc));
        } else {
          const bfu* zsrc = zx + (size_t)(r1 + zrow) * ZXW + (g * 8 + hp * 2) * 64 + zhalf * 64;
#pragma unroll
          for (int k = 0; k < 8; ++k) pre[k] = *(const u32x4*)(zsrc + k * 8);
        }
        dtv = dtb[(size_t)(r1 + lane) * 32 + head];
      }
      int frc = fr, fqc = fq;
      asm volatile("" : "+v"(frc), "+v"(fqc));
      {
        const int it = w >> 1, jt0 = (w & 1) * 2;
        f32x4 cb[2] = {{0.f, 0.f, 0.f, 0.f}, {0.f, 0.f, 0.f, 0.f}};
        __builtin_amdgcn_s_setprio(1);
#pragma unroll
        for (int ks = 0; ks < 4; ++ks) {
          bf16x8 a = lds_b128(sC + (it * 16 + frc) * S_LDB + ks * 32 + fqc * 8);
          bf16x8 b0 = lds_b128(sB + (jt0 * 16 + frc) * S_LDB + ks * 32 + fqc * 8);
          bf16x8 b1 = lds_b128(sB + ((jt0 + 1) * 16 + frc) * S_LDB + ks * 32 + fqc * 8);
          cb[0] = mfma16(a, b0, cb[0]);
          cb[1] = mfma16(a, b1, cb[1]);
        }
        __builtin_amdgcn_s_setprio(0);
        const int i0 = it * 16 + fqc * 4;
#pragma unroll
        for (int hh = 0; hh < 2; ++hh) {
          const float* hAc = sAc + hh * 256;
          const float* hDt = sDt + hh * 256;
          const f32x4 aci = *(const f32x4*)(hAc + i0);
#pragma unroll
          for (int t = 0; t < 2; ++t) {
            const int jj = (jt0 + t) * 16 + frc;
            const float acj = hAc[jj], dtj = hDt[jj];
#pragma unroll
            for (int j = 0; j < 4; ++j) {
              const float gv = (jj <= i0 + j) ? cb[t][j] * __expf(aci[j] - acj) * dtj : 0.f;
              sG[(hh * 64 + i0 + j) * S_LDT + jj] = f2bf(gv);
            }
          }
        }
      }
      lds_barrier();
      const bfu* xrow = sXT + (hl * 64 + ps * 16 + frc) * S_LDT;
#pragma unroll 1
      for (int it = 0; it < 4; ++it) {
        f32x4 yacc = {0.f, 0.f, 0.f, 0.f}, oacc = {0.f, 0.f, 0.f, 0.f};
        const bfu* grow = sG + (hl * 64 + it * 16 + frc) * S_LDT;
#pragma unroll
        for (int ks = 0; ks < 2; ++ks) {
          if (ks * 32 <= it * 16 + 15) {
            const int j0 = ks * 32 + fqc * 8;
            bf16x8 gfr = lds_b128(grow + j0);
            bf16x8 bfv = lds_b128(xrow + j0);
            yacc = mfma16(gfr, bfv, yacc);
          }
        }
#pragma unroll
        for (int ks = 0; ks < 4; ++ks) {
          bf16x8 a = lds_b128(sC + (it * 16 + frc) * S_LDB + ks * 32 + fqc * 8);
          bf16x8 b = lds_b128(myH + frc * S_LDB + ks * 32 + fqc * 8);
          oacc = mfma16(a, b, oacc);
        }
#pragma unroll
        for (int j = 0; j < 4; ++j) {
          int ii = it * 16 + fqc * 4 + j;
          float xv = bf2f(xrow[ii]);
          float y = yacc[j] + __expf(myAc[ii]) * oacc[j] + D_h * xv;
          float zv = bf2f(sZ[ii * S_LDB + hl * 64 + ps * 16 + frc]);
          float ygv = y * silu_f(zv);
          yg[(size_t)(r0 + ii) * DI + head * 64 + ps * 16 + frc] = f2bf(ygv);
          float sq = ygv * ygv;
          sq = row16_sum(sq);
          if (frc == 0) mySq[ii] = sq;
        }
      }
      {
        const float dec = __expf(a63);
#pragma unroll
        for (int nt = 0; nt < 8; ++nt) hacc[nt] *= dec;
#pragma unroll
        for (int ks = 0; ks < 2; ++ks) {
          const int j0 = ks * 32 + fqc * 8;
          bf16x8 xr = lds_b128(xrow + j0);
          f32x4 w0 = *(const f32x4*)(myW + j0), w1 = *(const f32x4*)(myW + j0 + 4);
          u32x4 xu = __builtin_bit_cast(u32x4, xr);
          u32x4 pk;
          pk[0] = cvt_pk_bf16(__uint_as_float(xu[0] << 16) * w0[0], __uint_as_float(xu[0] & 0xffff0000u) * w0[1]);
          pk[1] = cvt_pk_bf16(__uint_as_float(xu[1] << 16) * w0[2], __uint_as_float(xu[1] & 0xffff0000u) * w0[3]);
          pk[2] = cvt_pk_bf16(__uint_as_float(xu[2] << 16) * w1[0], __uint_as_float(xu[2] & 0xffff0000u) * w1[1]);
          pk[3] = cvt_pk_bf16(__uint_as_float(xu[3] << 16) * w1[2], __uint_as_float(xu[3] & 0xffff0000u) * w1[3]);
          bf16x8 af = __builtin_bit_cast(bf16x8, pk);
          __builtin_amdgcn_s_setprio(1);
#pragma unroll
          for (int nt = 0; nt < 8; ++nt) {
            bf16x8 b = lds_b128(sBT + (nt * 16 + frc) * S_LDT + j0);
            hacc[nt] = mfma16(af, b, hacc[nt]);
          }
          __builtin_amdgcn_s_setprio(0);
        }
#pragma unroll
        for (int nt = 0; nt < 8; ++nt)
#pragma unroll
          for (int j = 0; j < 4; ++j) myH[(fqc * 4 + j) * S_LDB + nt * 16 + frc] = f2bf(hacc[nt][j]);
      }
      lds_barrier();
      if (tid < 64) {
        float sm = 0.f;
#pragma unroll
        for (int ww = 0; ww < 8; ++ww) sm += sSq[ww * 64 + tid];
        ssqp[(size_t)(r0 + tid) * 16 + g * 4 + hp] = sm;
      }
    }
#pragma unroll
    for (int nt = 0; nt < 8; ++nt)
#pragma unroll
      for (int j = 0; j < 4; ++j) hT[((size_t)head * 64 + ps * 16 + fq * 4 + j) * 128 + nt * 16 + fr] = hacc[nt][j];
  }
}

constexpr int A_STAGE = 32768;
constexpr int A_LDO = 132;
__device__ __forceinline__ int kswz(int key) { return ((key >> 1) & 1) | (((key >> 3) & 3) << 1); }
__device__ __forceinline__ void phase_attn(KP P, char* smem, const int wv) {
  LAS unsigned char* lds = (LAS unsigned char*)smem;
  float* sO = (float*)smem;
  const int tid = opaque_tid(wv), w = wv, lane = tid & 63, fr = lane & 15, fq = lane >> 4;
  const int cm = w >> 2, rg = w & 3;
  const bfu* qb = (const bfu*)(P->ws + WS_Q);
  bfu* ao = (bfu*)(P->ws + WS_AO);
  float lam;
  {
    float a = P->in[18][lane] * P->in[19][lane];
    float b = P->in[20][lane] * P->in[21][lane];
    a = wave_sum(a, lane); b = wave_sum(b, lane);
    lam = __expf(a) - __expf(b) + LAMBDA_INIT;
  }
  const float* subln = P->in[22];
  unsigned ksrc[2], vsrc_row[2], vsrc_col[2];
#pragma unroll
  for (int i = 0; i < 2; ++i) {
    int p = (2 * w + i) * 64 + lane;
    int row = p >> 3, phys = p & 7;
    int map = row >> 6, key = row & 63;
    ksrc[i] = (unsigned)(key * 1024 + map * 64 + ((phys ^ kswz(key)) << 3));
    vsrc_row[i] = (unsigned)row;
    vsrc_col[i] = (unsigned)((phys ^ (row & 7)) << 3);
  }
  unsigned koff[4];
#pragma unroll
  for (int t4 = 0; t4 < 4; ++t4) {
    int key = (t4 >> 1) * 32 + (fr >> 2) * 8 + (t4 & 1) * 4 + (fr & 3);
    koff[t4] = (unsigned)((cm * 64 + key) * 128 + ((fq ^ kswz(key)) << 4));
  }
  const unsigned voff0 = 16384u + (unsigned)(fr * 128 + ((fq ^ (fr & 7)) << 4));
  const unsigned kb0 = koff[0], kb1 = koff[0] ^ 64u, vb0 = voff0, vb1 = voff0 ^ 64u;

  const int G = gridDim.x;
  const bool xcd_order = (G == 256);
  const int nrounds = xcd_order ? 17 : (4096 + 64 + G - 1) / G;
  for (int r = 0; r < nrounds; ++r) {
    int b, h, pc;
    bool sample = false;
    if (xcd_order) {
      int x = blockIdx.x & 7, j = blockIdx.x >> 3;
      if (r < 16) { int bh = r * 8 + x; b = bh >> 3; h = bh & 7; pc = (r & 1) ? 31 - j : j; }
      else { if (j >= 8) break; int sidx = x * 8 + j; b = sidx >> 3; h = sidx & 7; pc = 0; sample = true; }
    } else {
      int u = blockIdx.x + r * G;
      if (u >= 4096 + 64) break;
      if (u < 4096) { pc = 31 - (u >> 7); int bh = u & 127; b = bh >> 3; h = bh & 7; }
      else { int sidx = u - 4096; b = sidx >> 3; h = sidx & 7; pc = 0; sample = true; }
    }
    int qrow0, nkt, Tstr;
    const bfu* kbase;
    const bfu* vtbase;
    if (!sample) {
      qrow0 = b * 4096 + pc * 128;
      nkt = 2 * pc + 2;
      Tstr = 4096;
      kbase = (const bfu*)(P->ws + WS_KP) + (size_t)b * 4096 * 1024 + h * 128;
      vtbase = (const bfu*)(P->ws + WS_VTP) + (size_t)(b * 8 + h) * 128 * 4096;
    } else {
      qrow0 = MP + b * 64;
      nkt = 17;
      Tstr = SKV;
      kbase = (const bfu*)(P->ws + WS_KSM) + (size_t)b * SKV * 1024 + h * 128;
      vtbase = (const bfu*)(P->ws + WS_VTS) + (size_t)(b * 8 + h) * 128 * SKV;
    }
    const bool wave_valid = !sample || rg < 2;
    const int my_nkt = sample ? nkt : (rg < 2 ? nkt - 1 : nkt);
    bf16x8 qf[2][2];
    {
      const int qr = wave_valid ? (qrow0 + rg * 32 + fr) : qrow0;
      const bfu* qp = qb + (size_t)qr * 1024 + h * 128 + cm * 64 + fq * 8;
#pragma unroll
      for (int qt = 0; qt < 2; ++qt) {
        qf[qt][0] = *(const bf16x8*)(qp + (wave_valid ? qt * 16 * 1024 : 0));
        qf[qt][1] = *(const bf16x8*)(qp + (wave_valid ? qt * 16 * 1024 : 0) + 32);
      }
    }
    float mrun[2] = {-INFINITY, -INFINITY}, lrun[2] = {0.f, 0.f};
    f32x4 oacc[2][8];
#pragma unroll
    for (int qt = 0; qt < 2; ++qt)
#pragma unroll
      for (int et = 0; et < 8; ++et) oacc[qt][et] = f32x4{0.f, 0.f, 0.f, 0.f};

#define ATT_STAGE(stage, kt_) do { \
      const bfu* kt_base = kbase + (size_t)(kt_) * 64 * 1024; \
      const bfu* vt_base = vtbase + (size_t)(kt_) * 64; \
      _Pragma("unroll") for (int _i = 0; _i < 2; ++_i) \
        __builtin_amdgcn_global_load_lds((const unsigned*)(kt_base + ksrc[_i]), (LAS unsigned*)(lds + (stage) * A_STAGE + (2 * w + _i) * 1024), 16, 0, 0); \
      _Pragma("unroll") for (int _i = 0; _i < 2; ++_i) \
        __builtin_amdgcn_global_load_lds((const unsigned*)(vt_base + (size_t)vsrc_row[_i] * Tstr + vsrc_col[_i]), (LAS unsigned*)(lds + (stage) * A_STAGE + 16384 + (2 * w + _i) * 1024), 16, 0, 0); \
    } while (0)

#define ATT_S_SOFTMAX(stage_) do { \
      LAS unsigned char* sb = lds + (stage_) * A_STAGE; \
      f32x4 st[2][4]; \
      __builtin_amdgcn_s_setprio(1); \
      _Pragma("unroll") for (int t4 = 0; t4 < 4; ++t4) { \
        bf16x8 a0 = *(const LAS bf16x8*)(sb + kb0 + (t4 >> 1) * 4096 + (t4 & 1) * 512); \
        bf16x8 a1 = *(const LAS bf16x8*)(sb + kb1 + (t4 >> 1) * 4096 + (t4 & 1) * 512); \
        _Pragma("unroll") for (int qt = 0; qt < 2; ++qt) { \
          f32x4 z = {0.f, 0.f, 0.f, 0.f}; \
          z = mfma16(a0, qf[qt][0], z); \
          st[qt][t4] = mfma16(a1, qf[qt][1], z); \
        } \
      } \
      __builtin_amdgcn_s_setprio(0); \
      _Pragma("unroll") for (int qt = 0; qt < 2; ++qt) { \
        float mx = st[qt][0][0]; \
        _Pragma("unroll") for (int t4 = 0; t4 < 4; ++t4) \
          _Pragma("unroll") for (int j = 0; j < 4; ++j) mx = fmaxf(mx, st[qt][t4][j]); \
          \
        if (__builtin_amdgcn_ballot_w64(mx - mrun[qt] > 8.f) != 0ull) { \
          mx = xmax_16_32(mx); \
          const float mnew = fmaxf(mrun[qt], mx); \
          const float alpha = __builtin_amdgcn_exp2f(mrun[qt] - mnew); \
          lrun[qt] *= alpha; \
          mrun[qt] = mnew; \
          _Pragma("unroll") for (int et = 0; et < 8; ++et) oacc[qt][et] *= alpha; \
        } \
        const f32x2 m2 = {mrun[qt], mrun[qt]}; \
        f32x2 ls2 = {0.f, 0.f}; \
        _Pragma("unroll") for (int t4 = 0; t4 < 4; ++t4) { \
          f32x2 lo = f32x2{st[qt][t4][0], st[qt][t4][1]} - m2, hi = f32x2{st[qt][t4][2], st[qt][t4][3]} - m2; \
          lo[0] = __builtin_amdgcn_exp2f(lo[0]); lo[1] = __builtin_amdgcn_exp2f(lo[1]); \
          hi[0] = __builtin_amdgcn_exp2f(hi[0]); hi[1] = __builtin_amdgcn_exp2f(hi[1]); \
          ls2 += lo; ls2 += hi; \
          st[qt][t4] = f32x4{lo[0], lo[1], hi[0], hi[1]}; \
        } \
        lrun[qt] += ls2[0] + ls2[1]; \
        _Pragma("unroll") for (int kk = 0; kk < 2; ++kk) { \
          u32x4 pk; \
          pk[0] = cvt_pk_bf16(st[qt][2 * kk][0], st[qt][2 * kk][1]); \
          pk[1] = cvt_pk_bf16(st[qt][2 * kk][2], st[qt][2 * kk][3]); \
          pk[2] = cvt_pk_bf16(st[qt][2 * kk + 1][0], st[qt][2 * kk + 1][1]); \
          pk[3] = cvt_pk_bf16(st[qt][2 * kk + 1][2], st[qt][2 * kk + 1][3]); \
          pb[qt][kk] = __builtin_bit_cast(bf16x8, pk); \
        } \
      } \
    } while (0)
#define ATT_PV(stage_) do { \
      LAS unsigned char* sb = lds + (stage_) * A_STAGE; \
      __builtin_amdgcn_s_setprio(1); \
      _Pragma("unroll") for (int kk = 0; kk < 2; ++kk) \
        _Pragma("unroll") for (int et = 0; et < 8; ++et) { \
          bf16x8 a = *(const LAS bf16x8*)(sb + (kk ? vb1 : vb0) + et * 2048); \
          oacc[0][et] = mfma16(a, pb[0][kk], oacc[0][et]); \
          oacc[1][et] = mfma16(a, pb[1][kk], oacc[1][et]); \
        } \
      __builtin_amdgcn_s_setprio(0); \
    } while (0)

    __syncthreads();
    ATT_STAGE(0, 0);
    if (nkt > 1) ATT_STAGE(1, 1);
    if (nkt > 1) asm volatile("s_waitcnt vmcnt(4)" ::: "memory");
    else asm volatile("s_waitcnt vmcnt(0)" ::: "memory");
    if (cm == 1) lds_barrier();
    bf16x8 pb[2][2];
#pragma unroll 1
    for (int kt = 0; kt < nkt; ++kt) {
      const bool act = wave_valid && kt < my_nkt;
      lds_barrier();
      if (kt + 2 < nkt) ATT_STAGE((kt + 2) & 3, kt + 2);
      if (act) ATT_S_SOFTMAX(kt & 3);
      if (kt + 1 < nkt) {
        if (kt + 2 < nkt) asm volatile("s_waitcnt vmcnt(4)" ::: "memory");
        else asm volatile("s_waitcnt vmcnt(0)" ::: "memory");
      }
      lds_barrier();
      if (act) ATT_PV(kt & 3);
    }
    if (cm == 0) lds_barrier();
#undef ATT_S_SOFTMAX
#undef ATT_PV
#undef ATT_STAGE
    lrun[0] = xsum_16_32(lrun[0]);
    lrun[1] = xsum_16_32(lrun[1]);
    __syncthreads();
    if (cm == 1 && wave_valid) {
#pragma unroll
      for (int qt = 0; qt < 2; ++qt) {
        float rl = 1.f / lrun[qt];
#pragma unroll
        for (int et = 0; et < 8; ++et) *(f32x4*)(sO + (rg * 32 + qt * 16 + fr) * A_LDO + et * 16 + fq * 4) = oacc[qt][et] * rl;
      }
    }
    __syncthreads();
    if (cm == 0 && wave_valid) {
#pragma unroll
      for (int qt = 0; qt < 2; ++qt) {
        float rl = 1.f / lrun[qt];
        float ss = 0.f;
#pragma unroll
        for (int et = 0; et < 8; ++et) {
          f32x4 o1 = *(const f32x4*)(sO + (rg * 32 + qt * 16 + fr) * A_LDO + et * 16 + fq * 4);
          f32x4 o = oacc[qt][et] * rl - o1 * lam;
          oacc[qt][et] = o;
          ss += o[0] * o[0] + o[1] * o[1] + o[2] * o[2] + o[3] * o[3];
        }
        ss = xsum_16_32(ss);
        float rstd = rsqrtf(ss * (1.f / 128.f) + EPS) * (1.f - LAMBDA_INIT);
        bfu* dst = ao + (size_t)(qrow0 + rg * 32 + qt * 16 + fr) * 1024 + h * 128;
        int fqe = fq;
        asm volatile("" : "+v"(fqe));
#pragma unroll
        for (int et = 0; et < 8; ++et) {
          int e0 = et * 16 + fqe * 4;
          f32x4 sw = *(const f32x4*)(subln + e0);
          uint2 pk;
          pk.x = cvt_pk_bf16(oacc[qt][et][0] * rstd * sw[0], oacc[qt][et][1] * rstd * sw[1]);
          pk.y = cvt_pk_bf16(oacc[qt][et][2] * rstd * sw[2], oacc[qt][et][3] * rstd * sw[3]);
          *(uint2*)(dst + e0) = pk;
        }
      }
    }
  }
}

#define XB_TMO      128
#define XB_XCNT(j)  (256  + 64 * (j))
#define XB_XSUB(j)  (1280 + 64 * (j))
#define XB_XGEN(j)  (2304 + 64 * (j))
#define XB_TOP      3328
#define XB_TOPGEN   3392
#define XCD_BAR_WORDS 3456
#define XB_SPIN_CAP (1u << 22)
__device__ __forceinline__ unsigned xb_ld(unsigned* p)              { return __hip_atomic_load(p, __ATOMIC_RELAXED, __HIP_MEMORY_SCOPE_AGENT); }
__device__ __forceinline__ unsigned xb_add(unsigned* p, unsigned v) { return __hip_atomic_fetch_add(p, v, __ATOMIC_RELAXED, __HIP_MEMORY_SCOPE_AGENT); }
__device__ __forceinline__ unsigned xb_xcc_id() { return (unsigned)__builtin_amdgcn_s_getreg((3 << 11) | 20) & 0xFu; }
#define XB_SPIN(cond, bar) do { unsigned _sp = 0; while (cond) { __builtin_amdgcn_s_sleep(1); \
    if ((++_sp & 255u) == 0u) { if (xb_ld(&(bar)[XB_TMO])) break; if (_sp > XB_SPIN_CAP) { atomicAdd(&(bar)[XB_TMO], 1u); break; } } } } while (0)
__device__ __forceinline__ void xcd_barrier_complete(unsigned* bar, unsigned x, unsigned& nloc, unsigned& nx) {
  const unsigned G = gridDim.x;
  unsigned sum, cnt, mine, sp = 0u;
  for (;;) {
    sum = 0u; cnt = 0u; mine = 0u;
#pragma unroll
    for (unsigned j = 0; j < 16; ++j) { const unsigned c = xb_ld(&bar[XB_XCNT(j)]); sum += c; cnt += (c > 0u) ? 1u : 0u; mine = (j == x) ? c : mine; }
    if (sum == G) break;
    __builtin_amdgcn_s_sleep(1);
    if ((++sp & 255u) == 0u) { if (xb_ld(&bar[XB_TMO])) break; if (sp > XB_SPIN_CAP) { atomicAdd(&bar[XB_TMO], 1u); break; } }
  }
  nloc = mine > 0u ? mine : 1u; nx = cnt > 0u ? cnt : 1u;
}
__device__ __forceinline__ void xcd_barrier(unsigned* bar, volatile __attribute__((address_space(3))) unsigned* st, const int tid) {
  asm volatile("s_waitcnt vmcnt(0)" ::: "memory");
  __syncthreads();
  if (tid == 0) {
    const unsigned x = xb_xcc_id();
    __builtin_amdgcn_s_waitcnt(0);
    unsigned nloc = st[0], nx = st[1];
    if (nloc == 0u) { xcd_barrier_complete(bar, x, nloc, nx); st[0] = nloc; st[1] = nx; }
    const unsigned old = xb_add(&bar[XB_XSUB(x)], 1u);
    const unsigned gen = old / nloc;
    if (old + 1u == (gen + 1u) * nloc) {
      __builtin_amdgcn_fence(__ATOMIC_RELEASE, "agent");
      asm volatile("s_waitcnt vmcnt(0)" ::: "memory");
      const unsigned og = xb_add(&bar[XB_TOP], 1u);
      const unsigned tg = og / nx;
      if (og + 1u == (tg + 1u) * nx) xb_add(&bar[XB_TOPGEN], 1u);
      else XB_SPIN(xb_ld(&bar[XB_TOPGEN]) == tg, bar);
      __builtin_amdgcn_fence(__ATOMIC_ACQUIRE, "agent");
      xb_add(&bar[XB_XGEN(x)], 1u);
      asm volatile("s_waitcnt vmcnt(0)" ::: "memory");
    } else {
      XB_SPIN(xb_ld(&bar[XB_XGEN(x)]) == gen, bar);
      __builtin_amdgcn_fence(__ATOMIC_ACQUIRE, "agent");
      asm volatile("s_waitcnt vmcnt(0)" ::: "memory");
    }
  }
  __syncthreads();
}

__global__ void __launch_bounds__(512) fwd_kernel(Params Pk) {
  extern __shared__ __attribute__((aligned(16))) char smem_base[];
  const int wv = __builtin_amdgcn_readfirstlane((int)(threadIdx.x >> 6));
  volatile __attribute__((address_space(3))) unsigned* xst = (volatile __attribute__((address_space(3))) unsigned*)(smem_base + LDS_BYTES - 16);
  if (threadIdx.x == 0) {
    xst[0] = 0u; xst[1] = 0u;
    (void)xb_add(&((unsigned*)(Pk.ws + WS_BAR))[XB_XCNT(xb_xcc_id())], 1u);
  }
  __syncthreads();
  for (int ph = Pk.ph_lo; ph < Pk.ph_hi; ++ph) {
    int zoff = 0;
    asm volatile("" : "+s"(zoff));
    char* smem = smem_base + zoff;
    KP P = (KP)__builtin_amdgcn_kernarg_segment_ptr();
    asm volatile("" : "+s"(P));
#ifdef PROBE_DUP
    for (int rep = 0; rep < (((PROBE_DUP >> ph) & 1) ? 2 : 1); ++rep)
#endif
    switch (ph) {
      case 0: case 4: case 7: case 11: {
        const float* w = ph == 0 ? P->in[6] : (ph == 4 ? P->in[7] : (ph == 7 ? P->in[6] + D : P->in[7] + D));
        if (ph == 0) phase_norm<false, false>(P->in[0], P->in[1], nullptr, w, (bfu*)(P->ws + WS_XN), nullptr, wv);
        else phase_norm<false, true>(nullptr, nullptr, (const bfu*)(P->ws + WS_XR), w, (bfu*)(P->ws + WS_XN), nullptr, wv);
        if (ph == 0) phase_convert_weights(P, smem, wv);
        if (ph == 7) phase_convert_cache(P, smem, wv);
      } break;
      case 1: gemm_phase<EPI_INPROJ>(P, (const bfu*)(P->ws + WS_XN), (const bfu*)(P->ws + WS_W_INP), 1024, INP_NP / 256, smem, wv); break;
      case 2: phase_ssd(P, smem, wv); break;
      case 3: gemm_phase<EPI_OUTPROJ>(P, (const bfu*)(P->out + O_KP), (const bfu*)(P->ws + WS_W_OUTP), 2048, 4, smem, wv); break;
      case 5: case 12:
        gemm_phase<EPI_GU>(P, (const bfu*)(P->ws + WS_XN), (const bfu*)(P->ws + (ph == 5 ? WS_W_GU0 : WS_W_GU1)), 1024, 22, smem, wv);
        break;
      case 6: case 10: case 13: {
        const bfu* A = (const bfu*)(P->ws + (ph == 10 ? WS_AO : WS_BIG));
        const bfu* Bt = (const bfu*)(P->ws + (ph == 6 ? WS_W_DN0 : (ph == 10 ? WS_W_AO : WS_W_DN1)));
        gemm_phase<EPI_RES>(P, A, Bt, ph == 10 ? 1024 : DFF, 4, smem, wv);
      } break;
      case 8: gemm_phase<EPI_QKV>(P, (const bfu*)(P->ws + WS_XN), (const bfu*)(P->ws + WS_W_QKV), 1024, 12, smem, wv); break;
      case 9: phase_attn(P, smem, wv); break;
      case 14: phase_norm<true, true>(nullptr, nullptr, (const bfu*)(P->ws + WS_XR), P->in[8], nullptr, P->out, wv); break;
    }
    if (ph + 1 < Pk.ph_hi) {
      if (ph == Pk.ph_lo) cg::this_grid().sync();
      else xcd_barrier((unsigned*)(P->ws + WS_BAR), xst, opaque_tid(wv));
    }
  }
}

extern "C" void kernel_launch(void* const* d_in, const int* in_sizes, int n_in, void* d_out, int out_size, void* d_ws, size_t ws_size,
                              hipStream_t stream) {
  static int grid = 0;
  if (grid == 0) {
    if (n_in != 27 || ws_size < WS_END || out_size != 209412096) {
      fprintf(stderr, "kernel_launch: unexpected sizes n_in=%d ws=%zu (need %zu) out=%d\n", n_in, ws_size, (size_t)WS_END, out_size);
    }
    int dev = 0, cus = 0, per_cu = 0;
    (void)hipGetDevice(&dev);
    (void)hipDeviceGetAttribute(&cus, hipDeviceAttributeMultiprocessorCount, dev);
    (void)hipFuncSetAttribute((const void*)fwd_kernel, hipFuncAttributeMaxDynamicSharedMemorySize, LDS_BYTES);
    (void)hipOccupancyMaxActiveBlocksPerMultiprocessor(&per_cu, (const void*)fwd_kernel, 512, LDS_BYTES);
    if (per_cu < 1) { fprintf(stderr, "kernel_launch: occupancy query returned %d\n", per_cu); per_cu = 1; }
    grid = cus * per_cu;
    fprintf(stderr, "kernel_launch: grid=%d (cus=%d per_cu=%d) ws=%zu need=%zu\n", grid, cus, per_cu, ws_size, (size_t)WS_END);
  }
  Params p{};
  for (int i = 0; i < 27; ++i) p.in[i] = (const float*)d_in[i];
  p.out = (float*)d_out;
  p.ws = (unsigned char*)d_ws;
#if COOP
  (void)hipMemsetAsync((char*)d_ws + WS_BAR, 0, 16384, stream);
  p.ph_lo = 0; p.ph_hi = NPH;
  void* args[] = {&p};
  hipError_t e = hipLaunchCooperativeKernel((const void*)fwd_kernel, dim3(grid), dim3(512), args, LDS_BYTES, stream);
  if (e != hipSuccess) fprintf(stderr, "cooperative launch failed: %s (grid %d)\n", hipGetErrorString(e), grid);
#else
  for (int ph = 0; ph < NPH; ++ph) {
    p.ph_lo = ph; p.ph_hi = ph + 1;
    hipLaunchKernelGGL(fwd_kernel, dim3(grid), dim3(512), LDS_BYTES, stream, p);
  }
#endif
}
```
